# Optimizing an MI355X kernel written in HIP

```python
import jax, jax.numpy as jnp
from jax import lax
import numpy as np


D_MODEL = 1024
BATCH = 2
SEQ = 8192
DEPTH = 2

MIX_WIDTH = D_MODEL
N_BRANCHES = 4
BRANCH_WIDTH = MIX_WIDTH // N_BRANCHES
HEAD_DIM = 64
N_HEADS_A = BRANCH_WIDTH // HEAD_DIM
N_HEADS_B = BRANCH_WIDTH // HEAD_DIM
MOBA_BLOCK = 256
MOBA_TOPK = 3
Q_BLOCK = 128
DIL_PATTERNS = ((128, 1), (512, 4), (2048, 16))
CONV_WIDTH = 31
GLA_HEADS = 4
GLA_DV = BRANCH_WIDTH // GLA_HEADS
GLA_DK = GLA_DV // 2
GLA_RANK = 16
GLA_TAU = 16.0
GLA_CHUNK = 64
EPS = 1e-6
NEG = -1e30
IN_SIZES = (BRANCH_WIDTH,) * 4 + (BRANCH_WIDTH,) * 4 + (BRANCH_WIDTH,) * 3 + (GLA_HEADS * GLA_DK, GLA_HEADS * GLA_DK, BRANCH_WIDTH, GLA_RANK, BRANCH_WIDTH)
IN_COLS = sum(IN_SIZES)

kernel_name = 'hybrid_moba_dilated_conformer_gla'


def rms_norm(x, g):
    xf = x.astype(jnp.float32)
    y = xf * lax.rsqrt(jnp.mean(xf * xf, axis=-1, keepdims=True) + EPS)
    return (y * g.astype(jnp.float32)).astype(x.dtype)


def alibi_slopes():
    n = N_HEADS_A + N_HEADS_B
    s = 2.0 ** (-8.0 * np.arange(1, n + 1) / n)
    return jnp.asarray(s[0::2], jnp.float32), jnp.asarray(s[1::2], jnp.float32)


def moba_attention(q, k, v, slopes):
    Bsz, S, H, hd = q.shape
    f32 = jnp.float32
    scale = hd ** -0.5
    nb = -(-S // MOBA_BLOCK)
    pad = nb * MOBA_BLOCK - S
    n_sel = min(MOBA_TOPK, nb)
    n_s = n_sel * MOBA_BLOCK

    def blocks(t):
        t = jnp.pad(t, ((0, 0), (0, pad), (0, 0), (0, 0)))
        return t.reshape(Bsz, nb, MOBA_BLOCK, H, hd).transpose(0, 3, 1, 2, 4)

    kb, vb = blocks(k), blocks(v)
    k_mean = jnp.mean(kb.astype(f32), axis=3).astype(q.dtype)
    n_q = S // Q_BLOCK
    q_chunks = q.reshape(Bsz, n_q, Q_BLOCK, H, hd).transpose(1, 0, 3, 2, 4)
    b_idx = jnp.arange(Bsz)[:, None, None, None]
    h_idx = jnp.arange(H)[None, :, None, None]
    blk_pos = jnp.arange(MOBA_BLOCK)
    blk_ids = jnp.arange(nb)

    def attend(args):
        c, qc = args
        pos = c * Q_BLOCK + jnp.arange(Q_BLOCK)
        own = (c * Q_BLOCK) // MOBA_BLOCK
        gate = jnp.einsum('bhqd,bhnd->bhqn', qc, k_mean).astype(f32)
        gate = jnp.where(blk_ids < own, gate, -jnp.inf)
        _, idx = lax.top_k(gate, n_sel)
        k_sel = kb[b_idx, h_idx, idx]
        v_sel = vb[b_idx, h_idx, idx]
        s_sel = jnp.einsum('bhqd,bhqnkd->bhqnk', qc, k_sel).astype(f32) * scale
        dist_sel = pos[:, None, None] - (idx[..., None] * MOBA_BLOCK + blk_pos)
        s_sel = s_sel - slopes[:, None, None, None] * dist_sel.astype(f32)
        s_sel = jnp.where((idx < own)[..., None], s_sel, NEG)
        k_own = lax.dynamic_index_in_dim(kb, own, axis=2, keepdims=False)
        v_own = lax.dynamic_index_in_dim(vb, own, axis=2, keepdims=False)
        s_own = jnp.einsum('bhqd,bhkd->bhqk', qc, k_own).astype(f32) * scale
        dist_own = pos[:, None] - (own * MOBA_BLOCK + blk_pos)[None, :]
        s_own = s_own - slopes[:, None, None] * dist_own.astype(f32)
        s_own = jnp.where(dist_own >= 0, s_own, NEG)
        s = jnp.concatenate([s_sel.reshape(Bsz, H, Q_BLOCK, n_s), s_own], axis=-1)
        p = jax.nn.softmax(s, axis=-1).astype(v.dtype)
        o = jnp.einsum('bhqnk,bhqnkd->bqhd', p[..., :n_s].reshape(Bsz, H, Q_BLOCK, n_sel, MOBA_BLOCK), v_sel)
        o = o + jnp.einsum('bhqk,bhkd->bqhd', p[..., n_s:], v_own)
        return o

    out = lax.map(attend, (jnp.arange(n_q), q_chunks))
    return out.transpose(1, 0, 2, 3, 4).reshape(Bsz, S, H, hd)


def banded_window_attention(q, k, v, span, slope):
    Bsz, G, H, L, hd = q.shape
    f32 = jnp.float32
    nbk = -(-L // span)
    pad = nbk * span - L

    def blocks(t):
        t = jnp.pad(t, ((0, 0), (0, 0), (0, 0), (0, pad), (0, 0)))
        return t.reshape(Bsz, G, H, nbk, span, hd)

    def band(t):
        prev = jnp.pad(t, ((0, 0), (0, 0), (0, 0), (1, 0), (0, 0), (0, 0)))[:, :, :, :-1]
        return jnp.concatenate([prev, t], axis=4)

    qb = blocks(q)
    kband, vband = band(blocks(k)), band(blocks(v))
    s = jnp.einsum('bghnqd,bghnkd->bghnqk', qb, kband).astype(f32) * hd ** -0.5
    qi = jnp.arange(span)
    kr = jnp.arange(2 * span) - span
    dist = qi[:, None] - kr[None, :]
    kglob = jnp.arange(nbk)[:, None] * span + kr[None, :]
    valid = ((dist >= 0) & (dist <= span))[None] & (kglob >= 0)[:, None, :]
    s = s - slope[:, None, None, None] * dist.astype(f32)
    s = jnp.where(valid, s, NEG)
    m = jnp.max(s, axis=-1, keepdims=True)
    p = jnp.exp(s - m)
    l = jnp.sum(p, axis=-1)
    o = jnp.einsum('bghnqk,bghnkd->bghnqd', p, vband.astype(f32)) / l[..., None]
    o = o.reshape(Bsz, G, H, nbk * span, hd)[:, :, :, :L]
    m = m.reshape(Bsz, G, H, nbk * span)[..., :L]
    l = l.reshape(Bsz, G, H, nbk * span)[..., :L]
    return o, m, l


def dilated_attention(q, k, v, slopes):
    Bsz, S, H, hd = q.shape
    outs, maxes, dens = [], [], []
    for window, dil in DIL_PATTERNS:
        span = window // dil
        L = S // dil

        def sub(t):
            return t.reshape(Bsz, L, dil, H, hd).transpose(0, 2, 3, 1, 4)

        o, m, l = banded_window_attention(sub(q), sub(k), sub(v), span, slopes * dil)
        outs.append(o.transpose(0, 3, 1, 2, 4).reshape(Bsz, S, H, hd))
        maxes.append(m.transpose(0, 3, 1, 2).reshape(Bsz, S, H))
        dens.append(l.transpose(0, 3, 1, 2).reshape(Bsz, S, H))
    o = jnp.stack(outs)
    m = jnp.stack(maxes)
    l = jnp.stack(dens)
    w = l * jnp.exp(m - jnp.max(m, axis=0))
    out = jnp.sum(w[..., None] * o, axis=0) / jnp.sum(w, axis=0)[..., None]
    return out.astype(v.dtype)


def conformer_conv(a, b, w_dw, b_dw, ln_g, ln_b, w_pw, b_pw):
    u = a * jax.nn.sigmoid(b)
    C = u.shape[-1]
    u = lax.conv_general_dilated(u, w_dw[:, None, :].astype(u.dtype), window_strides=(1,), padding=((CONV_WIDTH - 1, 0),), dimension_numbers=('NWC', 'WIO', 'NWC'), feature_group_count=C) + b_dw
    uf = u.astype(jnp.float32)
    mu = jnp.mean(uf, axis=-1, keepdims=True)
    var = jnp.mean(jnp.square(uf - mu), axis=-1, keepdims=True)
    un = (uf - mu) * lax.rsqrt(var + EPS) * ln_g + ln_b
    return jax.nn.silu(un).astype(u.dtype) @ w_pw + b_pw


def gla_mixer(q, k, v, gate_lr, w_g, b_g, g_norm):
    Bsz, S = q.shape[:2]
    f32 = jnp.float32
    log_a = jax.nn.log_sigmoid((gate_lr @ w_g + b_g).astype(f32)) / GLA_TAU
    log_a = log_a.reshape(Bsz, S, GLA_HEADS, GLA_DK)
    nC = S // GLA_CHUNK

    def chunks(t):
        return t.astype(f32).reshape(Bsz, nC, GLA_CHUNK, GLA_HEADS, -1).transpose(0, 3, 1, 2, 4)

    qc = chunks(q) * GLA_DK ** -0.5
    kc = chunks(k)
    vc = chunks(v)
    bc = jnp.cumsum(chunks(log_a), axis=3)
    causal = jnp.tril(jnp.ones((GLA_CHUNK, GLA_CHUNK), dtype=bool))
    diff = bc[..., :, None, :] - bc[..., None, :, :]
    decay = jnp.exp(jnp.where(causal[:, :, None], diff, -jnp.inf))
    attn = jnp.einsum('bhcid,bhcjd,bhcijd->bhcij', qc, kc, decay)
    o_intra = jnp.einsum('bhcij,bhcjv->bhciv', attn, vc)
    b_last = bc[..., -1, :]
    kv = jnp.einsum('bhcjd,bhcjv->bhcdv', kc * jnp.exp(b_last[..., None, :] - bc), vc)

    def step(state, inp):
        dec, kv_c = inp
        return dec[..., None] * state + kv_c, state

    init = jnp.zeros((Bsz, GLA_HEADS, GLA_DK, GLA_DV), f32)
    _, prev = lax.scan(step, init, (jnp.moveaxis(jnp.exp(b_last), 2, 0), jnp.moveaxis(kv, 2, 0)))
    prev = jnp.moveaxis(prev, 0, 2)
    o_inter = jnp.einsum('bhcid,bhcdv->bhciv', qc * jnp.exp(bc), prev)
    o = (o_intra + o_inter).transpose(0, 2, 3, 1, 4).reshape(Bsz, S, GLA_HEADS, GLA_DV)
    o = rms_norm(o, g_norm)
    return o.reshape(Bsz, S, GLA_HEADS * GLA_DV).astype(v.dtype)


def hybrid_layer(x, norm_g, w_in, q_gain_a, k_gain_a, q_gain_b, k_gain_b, conv_w, conv_b, conv_ln_g, conv_ln_b, conv_pw_w, conv_pw_b, gla_gate_w, gla_gate_b, gla_norm_g, w_out):
    Bsz, S, _ = x.shape
    h = rms_norm(x, norm_g)
    z = h @ w_in
    splits = np.cumsum(IN_SIZES)[:-1].tolist()
    (qa, ka, va, ga, qb, kb, vb, gb, ca, cg, gc, qd, kd, vd, lr, gd) = jnp.split(z, splits, axis=-1)
    slopes_a, slopes_b = alibi_slopes()

    def heads(t, n):
        return t.reshape(Bsz, S, n, -1)

    ya = moba_attention(rms_norm(heads(qa, N_HEADS_A), q_gain_a), rms_norm(heads(ka, N_HEADS_A), k_gain_a), heads(va, N_HEADS_A), slopes_a)
    ya = ya.reshape(Bsz, S, BRANCH_WIDTH) * jax.nn.silu(ga)
    yb = dilated_attention(rms_norm(heads(qb, N_HEADS_B), q_gain_b), rms_norm(heads(kb, N_HEADS_B), k_gain_b), heads(vb, N_HEADS_B), slopes_b)
    yb = yb.reshape(Bsz, S, BRANCH_WIDTH) * jax.nn.silu(gb)
    yc = conformer_conv(ca, cg, conv_w, conv_b, conv_ln_g, conv_ln_b, conv_pw_w, conv_pw_b) * jax.nn.silu(gc)
    yd = gla_mixer(heads(qd, GLA_HEADS), heads(kd, GLA_HEADS), heads(vd, GLA_HEADS), lr, gla_gate_w, gla_gate_b, gla_norm_g) * jax.nn.silu(gd)
    y = jnp.concatenate([ya, yb, yc, yd], axis=-1) @ w_out
    return x + y


def setup_inputs(seed: int = 0) -> dict:
    key = jax.random.key(seed)
    ks = jax.random.split(key, 17)
    f32 = jnp.float32

    def nrm(k, shape, scale):
        return jax.random.normal(k, shape, f32) * scale

    BW = BRANCH_WIDTH
    return {
        'x': nrm(ks[0], (BATCH, SEQ, D_MODEL), 1.0),
        'norm_g': 1.0 + nrm(ks[1], (DEPTH, D_MODEL), 0.02),
        'w_in': nrm(ks[2], (DEPTH, D_MODEL, IN_COLS), D_MODEL ** -0.5),
        'q_gain_a': 1.0 + nrm(ks[3], (DEPTH, HEAD_DIM), 0.02),
        'k_gain_a': 1.0 + nrm(ks[4], (DEPTH, HEAD_DIM), 0.02),
        'q_gain_b': 1.0 + nrm(ks[5], (DEPTH, HEAD_DIM), 0.02),
        'k_gain_b': 1.0 + nrm(ks[6], (DEPTH, HEAD_DIM), 0.02),
        'conv_w': nrm(ks[7], (DEPTH, CONV_WIDTH, BW), CONV_WIDTH ** -0.5),
        'conv_b': nrm(ks[8], (DEPTH, BW), 0.02),
        'conv_ln_g': 1.0 + nrm(ks[9], (DEPTH, BW), 0.02),
        'conv_ln_b': nrm(ks[10], (DEPTH, BW), 0.02),
        'conv_pw_w': nrm(ks[11], (DEPTH, BW, BW), BW ** -0.5),
        'conv_pw_b': nrm(ks[12], (DEPTH, BW), 0.02),
        'gla_gate_w': nrm(ks[13], (DEPTH, GLA_RANK, GLA_HEADS * GLA_DK), GLA_RANK ** -0.5),
        'gla_gate_b': nrm(ks[14], (DEPTH, GLA_HEADS * GLA_DK), 0.02),
        'gla_norm_g': 1.0 + nrm(ks[15], (DEPTH, GLA_DV), 0.02),
        'w_out': nrm(ks[16], (DEPTH, MIX_WIDTH, D_MODEL), MIX_WIDTH ** -0.5),
    }


def reference(x, norm_g, w_in, q_gain_a, k_gain_a, q_gain_b, k_gain_b, conv_w, conv_b, conv_ln_g, conv_ln_b, conv_pw_w, conv_pw_b, gla_gate_w, gla_gate_b, gla_norm_g, w_out):
    for l in range(DEPTH):
        x = hybrid_layer(x, norm_g[l], w_in[l], q_gain_a[l], k_gain_a[l], q_gain_b[l], k_gain_b[l], conv_w[l], conv_b[l], conv_ln_g[l], conv_ln_b[l], conv_pw_w[l], conv_pw_b[l], gla_gate_w[l], gla_gate_b[l], gla_norm_g[l], w_out[l])
    return x
```

```cpp
#include <hip/hip_runtime.h>
#include <hip/hip_cooperative_groups.h>
#include <cstdio>
#include <cstdint>
namespace cg = cooperative_groups;
namespace pg8 {
#define PG8_LAS __attribute__((address_space(3)))
typedef unsigned short bf16_t;
typedef short bf16x8 __attribute__((ext_vector_type(8)));
typedef float f32x4 __attribute__((ext_vector_type(4)));
typedef unsigned u32x4 __attribute__((ext_vector_type(4)));
constexpr int BM = 256, BK = 64, HALF = 128, HTB = HALF * BK * 2  , STAGE_BYTES = 8 * HTB, NXCD = 8, WGM = 8;

__host__ __device__ __forceinline__ int lds_byte(int r, int c) { const int st = (r >> 4) * 2 + (c >> 5), rr = r & 15, cc = c & 31, ob = rr * 64 + cc * 2; return st * 1024 + (ob ^ (((ob >> 9) & 1) << 5)); }
__host__ __device__ __forceinline__ void stage_rc(int b, int& R, int& C) { const int st = b / 1024, sb = b % 1024, swz = sb ^ (((sb >> 9) & 1) << 5); R = (st >> 1) * 16 + swz / 64; C = (st & 1) * 32 + (swz % 64) / 2; }
__host__ __device__ __forceinline__ int perm32(int rho) { const int n = rho >> 4, i = rho & 15; return 8 * (i >> 2) + 4 * n + (i & 3); }

struct Unit { int pm, pn; };
struct Gemm { const bf16_t* A; const bf16_t* Bt; int M, N, K; };

struct StaticOrder {
    int nM, nN, nwg, G, c;
    __host__ __device__ void init(int M, int N, int G_, int c_) { nM = M / BM; nN = N / BM; nwg = nM * nN; G = G_; c = c_; }
    __host__ __device__ bool next(int i, Unit& u) const {
        const long L = (long)i * G + c; if (L >= nwg) return false;
        int wgid = (int)L; { const int q = nwg / NXCD, r = nwg % NXCD, xcd = wgid % NXCD, off = wgid / NXCD; wgid = (xcd < r ? xcd * (q + 1) : r * (q + 1) + (xcd - r) * q) + off; }
        const int nig = WGM * nN, gid = wgid / nig, fm = gid * WGM, gsz = (nM - fm) < WGM ? (nM - fm) : WGM;
        u.pm = fm + ((wgid % nig) % gsz); u.pn = (wgid % nig) / gsz; return true;
    }
    __device__ __forceinline__ void a_ready(const Unit&) const {}
    __device__ __forceinline__ void done(const Unit&) const {}
};

__device__ __forceinline__ unsigned cvt_pk_bf16(float lo, float hi) { unsigned r; asm volatile("v_cvt_pk_bf16_f32 %0, %1, %2" : "=v"(r) : "v"(lo), "v"(hi)); return r; }
struct EpiZ {
    static constexpr bool PERM = true, AFTER_DRAIN = false;
    bf16_t* O; int ldc;
    __device__ __forceinline__ void operator()(const f32x4 (&acc)[2][2][4][2], const Unit& u, int wr, int wc, int fr, int fq) const {
        const int row0 = u.pm * BM + wr * 64 + fr; const int col0 = u.pn * BM + wc * 32 + 8 * fq;
#pragma unroll
        for (int ai = 0; ai < 2; ++ai)
#pragma unroll
            for (int m = 0; m < 4; ++m) { bf16_t* rowp = O + (size_t)(row0 + ai * HALF + m * 16) * ldc + col0;
#pragma unroll
                for (int bj = 0; bj < 2; ++bj) { const f32x4 v0 = acc[ai][bj][m][0], v1 = acc[ai][bj][m][1];
                    u32x4 w; w.x = cvt_pk_bf16(v0[0], v0[1]); w.y = cvt_pk_bf16(v0[2], v0[3]); w.z = cvt_pk_bf16(v1[0], v1[1]); w.w = cvt_pk_bf16(v1[2], v1[3]);
                    *(u32x4*)(rowp + bj * HALF) = w; } }
    }
};
struct EpiRes {
    static constexpr bool PERM = false, AFTER_DRAIN = false;
    const float* base; float* out; int ldc;
    __device__ __forceinline__ void operator()(const f32x4 (&acc)[2][2][4][2], const Unit& u, int wr, int wc, int fr, int fq) const {
        const int col0 = u.pn * BM + wc * 32 + 4 * fq;
#pragma unroll
        for (int ai = 0; ai < 2; ++ai)
#pragma unroll
            for (int m = 0; m < 4; ++m) { const size_t off = (size_t)(u.pm * BM + ai * HALF + wr * 64 + m * 16 + fr) * ldc + col0;
#pragma unroll
                for (int bj = 0; bj < 2; ++bj)
#pragma unroll
                    for (int n = 0; n < 2; ++n) { const f32x4 bs = *(const f32x4*)(base + off + bj * HALF + n * 16); *(f32x4*)(out + off + bj * HALF + n * 16) = bs + acc[ai][bj][m][n]; } }
    }
};
template <class Epi, class Sched, bool ALIGN_EPI = false, bool SP2 = false>
__device__ __forceinline__ void gemm_phase(PG8_LAS unsigned char* lds, const Gemm g, const Sched& S, const Epi& E) {
    int tid_l = threadIdx.x; asm volatile("" : "+v"(tid_l));
    const int tid = tid_l, wid = __builtin_amdgcn_readfirstlane(tid >> 6), lane = tid & 63, wr = wid >> 2, wc = wid & 3, fr = lane & 15, fq = lane >> 4;
    const int K = g.K, nt = K / BK;
    unsigned voffA[2], voffB[2];
#pragma unroll
    for (int i = 0; i < 2; ++i) { int R, C; stage_rc(tid * 16 + i * 8192, R, C); const int Rb = Epi::PERM ? ((R & ~31) + perm32(R & 31)) : R;
        voffA[i] = (unsigned)(R * K + C) * 2u; voffB[i] = (unsigned)(Rb * K + C) * 2u; }
    const size_t kstep = (size_t)(BK * 2);
    const size_t hstep = (size_t)HALF * K * 2;
    const size_t tstep = 2 * hstep;
    const unsigned ldsw = (unsigned)wid * 1024u;
    const int aoff = lds_byte(wr * 64 + fr, fq * 8), boff = lds_byte(wc * 32 + fr, fq * 8);
#define PG8_SA(b, h) (((b) * 2 + (h)) * HTB)
#define PG8_SB(b, h) ((4 + (b) * 2 + (h)) * HTB)
#define PG8_STAGE(bufoff, gbase, voff) do { _Pragma("unroll") for (int _i = 0; _i < 2; ++_i) \
        __builtin_amdgcn_global_load_lds((const unsigned*)((const char*)(gbase) + (voff)[_i]), (PG8_LAS unsigned*)(lds + (bufoff) + ldsw + _i * 8192), 16, 0, 0); } while (0)
#define PG8_LDA(dst, b, h) do { _Pragma("unroll") for (int m = 0; m < 4; ++m) _Pragma("unroll") for (int k = 0; k < 2; ++k) dst[m][k] = *(const PG8_LAS bf16x8*)(lds + PG8_SA(b, h) + aoff + m * 2048 + k * 1024); } while (0)
#define PG8_LDB(dst, b, h) do { _Pragma("unroll") for (int n = 0; n < 2; ++n) _Pragma("unroll") for (int k = 0; k < 2; ++k) dst[n][k] = *(const PG8_LAS bf16x8*)(lds + PG8_SB(b, h) + boff + n * 2048 + k * 1024); } while (0)
#define PG8_MMA(ai, bj, At, Bt) do { __builtin_amdgcn_s_setprio(1); _Pragma("unroll") for (int m = 0; m < 4; ++m) _Pragma("unroll") for (int n = 0; n < 2; ++n) _Pragma("unroll") for (int k = 0; k < 2; ++k) \
        acc[ai][bj][m][n] = __builtin_amdgcn_mfma_f32_16x16x32_bf16(Bt[n][k], At[m][k], acc[ai][bj][m][n], 0, 0, 0); __builtin_amdgcn_s_setprio(0); } while (0)
#define PG8_WAIT_V(n) asm volatile("s_waitcnt vmcnt(" #n ")" ::: "memory")
#define PG8_WAIT_L(n) asm volatile("s_waitcnt lgkmcnt(" #n ")" ::: "memory")
#define PG8_BAR __builtin_amdgcn_s_barrier()
#define PG8_SCHED __builtin_amdgcn_sched_barrier(0)
    Unit cur, nxt; int ui = 0;
    if (!S.next(0, cur)) return;
    f32x4 acc[2][2][4][2];
#pragma unroll
    for (int a = 0; a < 2; ++a)
#pragma unroll
        for (int b = 0; b < 2; ++b)
#pragma unroll
            for (int m = 0; m < 4; ++m)
#pragma unroll
                for (int n = 0; n < 2; ++n) acc[a][b][m][n] = (f32x4){0.f, 0.f, 0.f, 0.f};
    bf16x8 At[4][2], B0[2][2], B1[2][2];
    const char* cA = (const char*)g.A + (size_t)cur.pm * tstep; const char* cB = (const char*)g.Bt + (size_t)cur.pn * tstep;
    S.a_ready(cur);
    if constexpr (SP2) {
        PG8_STAGE(PG8_SB(0, 0), cB, voffB); PG8_STAGE(PG8_SB(0, 1), cB + hstep, voffB); PG8_STAGE(PG8_SA(0, 0), cA, voffA); PG8_STAGE(PG8_SA(0, 1), cA + hstep, voffA);
        if (wr == 1) PG8_BAR;
        PG8_WAIT_V(2); PG8_BAR;
        PG8_STAGE(PG8_SB(1, 0), cB + kstep, voffB); PG8_STAGE(PG8_SA(1, 0), cA + kstep, voffA); PG8_STAGE(PG8_SB(1, 1), cB + hstep + kstep, voffB);
        PG8_WAIT_V(6); PG8_BAR;
    } else {
        PG8_STAGE(PG8_SB(0, 0), cB, voffB); PG8_STAGE(PG8_SA(0, 0), cA, voffA); PG8_STAGE(PG8_SB(0, 1), cB + hstep, voffB); PG8_STAGE(PG8_SA(0, 1), cA + hstep, voffA);
        if (wr == 1) PG8_BAR;
        PG8_WAIT_V(4); PG8_BAR;
        PG8_STAGE(PG8_SB(1, 0), cB + kstep, voffB); PG8_STAGE(PG8_SA(1, 0), cA + kstep, voffA); PG8_STAGE(PG8_SB(1, 1), cB + hstep + kstep, voffB);
        PG8_WAIT_V(6); PG8_BAR;
    }
    for (;;) {
        const bool has_next = S.next(ui + 1, nxt);
        const char* nA = has_next ? (const char*)g.A + (size_t)nxt.pm * tstep : cA; const char* nB = has_next ? (const char*)g.Bt + (size_t)nxt.pn * tstep : cB;
        for (int t = 0; t < nt; t += 2) {
            const bool last = (t == nt - 2);
            const char* a1 = cA + (size_t)(t + 1) * kstep;
            const char* a2 = last ? nA : cA + (size_t)(t + 2) * kstep; const char* b2 = last ? nB : cB + (size_t)(t + 2) * kstep;
            const char* a3 = a2 + kstep; const char* b3 = b2 + kstep;
            if (last && has_next) S.a_ready(nxt);
            if constexpr (SP2) {
            PG8_LDB(B0, 0, 0); PG8_LDB(B1, 0, 1); PG8_SCHED; PG8_LDA(At, 0, 0); PG8_STAGE(PG8_SA(1, 1), a1 + hstep, voffA);
            PG8_WAIT_V(8); PG8_WAIT_L(0); PG8_BAR; PG8_MMA(0, 0, At, B0); PG8_MMA(0, 1, At, B1); PG8_BAR; PG8_SCHED;
            PG8_LDA(At, 0, 1); PG8_STAGE(PG8_SB(0, 0), b2, voffB); PG8_STAGE(PG8_SB(0, 1), b2 + hstep, voffB); PG8_STAGE(PG8_SA(0, 0), a2, voffA);
            PG8_WAIT_V(8); PG8_WAIT_L(0); PG8_BAR; PG8_MMA(1, 0, At, B0); PG8_MMA(1, 1, At, B1); PG8_BAR; PG8_SCHED;
            PG8_LDB(B0, 1, 0); PG8_LDB(B1, 1, 1); PG8_SCHED; PG8_LDA(At, 1, 0); PG8_STAGE(PG8_SA(0, 1), a2 + hstep, voffA);
            PG8_WAIT_V(8); PG8_WAIT_L(0); PG8_BAR; PG8_MMA(0, 0, At, B0); PG8_MMA(0, 1, At, B1); PG8_BAR; PG8_SCHED;
            PG8_LDA(At, 1, 1); PG8_STAGE(PG8_SB(1, 0), b3, voffB); PG8_STAGE(PG8_SB(1, 1), b3 + hstep, voffB); PG8_STAGE(PG8_SA(1, 0), a3, voffA);
            PG8_WAIT_V(8); PG8_WAIT_L(0); PG8_BAR; PG8_MMA(1, 0, At, B0); PG8_MMA(1, 1, At, B1); PG8_BAR; PG8_SCHED;
            } else {
            PG8_LDB(B0, 0, 0); PG8_SCHED; PG8_LDA(At, 0, 0); PG8_STAGE(PG8_SA(1, 1), a1 + hstep, voffA);
            PG8_WAIT_L(8); PG8_BAR; PG8_WAIT_L(0); PG8_MMA(0, 0, At, B0); PG8_BAR; PG8_SCHED;
            PG8_LDB(B1, 0, 1); PG8_STAGE(PG8_SB(0, 0), b2, voffB);
            PG8_BAR; PG8_WAIT_L(0); PG8_MMA(0, 1, At, B1); PG8_BAR;
            PG8_LDA(At, 0, 1); PG8_STAGE(PG8_SA(0, 0), a2, voffA);
            PG8_BAR; PG8_WAIT_L(0); PG8_MMA(1, 0, At, B0); PG8_BAR; PG8_SCHED;
            PG8_STAGE(PG8_SB(0, 1), b2 + hstep, voffB);
            PG8_WAIT_V(6); PG8_BAR; PG8_MMA(1, 1, At, B1); PG8_BAR;
            PG8_LDB(B0, 1, 0); PG8_SCHED; PG8_LDA(At, 1, 0); PG8_STAGE(PG8_SA(0, 1), a2 + hstep, voffA);
            PG8_WAIT_L(8); PG8_BAR; PG8_WAIT_L(0); PG8_MMA(0, 0, At, B0); PG8_BAR; PG8_SCHED;
            PG8_LDB(B1, 1, 1); PG8_STAGE(PG8_SB(1, 0), b3, voffB);
            PG8_BAR; PG8_WAIT_L(0); PG8_MMA(0, 1, At, B1); PG8_BAR;
            PG8_LDA(At, 1, 1); PG8_STAGE(PG8_SA(1, 0), a3, voffA);
            PG8_BAR; PG8_WAIT_L(0); PG8_MMA(1, 0, At, B0); PG8_BAR; PG8_SCHED;
            PG8_STAGE(PG8_SB(1, 1), b3 + hstep, voffB);
            PG8_WAIT_V(6); PG8_BAR; PG8_MMA(1, 1, At, B1); PG8_BAR;
            }
        }
        if constexpr (ALIGN_EPI) { if (wr == 0) PG8_BAR; }
        if constexpr (!Epi::AFTER_DRAIN) { E(acc, cur, wr, wc, fr, fq); S.done(cur); }
        if (!has_next) break;
#pragma unroll
        for (int a = 0; a < 2; ++a)
#pragma unroll
            for (int b = 0; b < 2; ++b)
#pragma unroll
                for (int m = 0; m < 4; ++m)
#pragma unroll
                    for (int n = 0; n < 2; ++n) acc[a][b][m][n] = (f32x4){0.f, 0.f, 0.f, 0.f};
        cur = nxt; cA = nA; cB = nB; ++ui;
        if constexpr (ALIGN_EPI) { if (wr == 1) PG8_BAR; }
    }
    PG8_WAIT_V(0);
    if constexpr (!ALIGN_EPI) { if (wr == 0) PG8_BAR; }
    PG8_BAR;
    if constexpr (Epi::AFTER_DRAIN) { E.fused(acc, cur, wr, wc, fr, fq, lds, wid, lane); S.done(cur); }
#undef PG8_SA
#undef PG8_SB
#undef PG8_STAGE
#undef PG8_LDA
#undef PG8_LDB
#undef PG8_MMA
#undef PG8_WAIT_V
#undef PG8_WAIT_L
#undef PG8_BAR
#undef PG8_SCHED
}
}

#define LAS __attribute__((address_space(3)))
typedef unsigned short bf16_t;
typedef short bf16x8 __attribute__((ext_vector_type(8)));
typedef float f32x4 __attribute__((ext_vector_type(4)));
typedef float f32x16 __attribute__((ext_vector_type(16)));
typedef unsigned u32x4 __attribute__((ext_vector_type(4)));
typedef unsigned u32x2 __attribute__((ext_vector_type(2)));

constexpr int NB = 2, SEQ = 8192, MTOK = NB * SEQ, DM = 1024, NZ = 3600, NZP = 3840, DEPTH = 2;
constexpr int C_QA = 0, C_KA = 256, C_VA = 512, C_GA = 768, C_QB = 1024, C_KB = 1280, C_VB = 1536, C_GB = 1792;
constexpr int C_CA = 2048, C_CG = 2304, C_GC = 2560, C_QD = 2816, C_KD = 2944, C_VD = 3072, C_LR = 3328, C_GD = 3344;
constexpr float EPS = 1e-6f, LOG2E = 1.4426950408889634f, QSCALE = 0.125f * LOG2E;
constexpr int NTHR = 512, NWAVES = 8;
constexpr int LDS_BYTES = 155648;

#ifndef EN_MOBA
#define EN_MOBA 1
#endif
#ifndef EN_DIL
#define EN_DIL 1
#endif
#ifndef EN_CONV
#define EN_CONV 1
#endif
#ifndef EN_GLA
#define EN_GLA 1
#endif
#ifndef PH_MASK
#define PH_MASK 63
#endif
#ifndef N_LAUNCH_MODE
#define N_LAUNCH_MODE 0
#endif

constexpr size_t MiB = 1u << 20;
constexpr size_t WS_CTL = 0, CTL_ZERO_BYTES = 1 * MiB;
constexpr size_t WS_WIN = 1 * MiB;
constexpr size_t WIN_L = (size_t)NZP * DM * 2;
constexpr size_t WS_WOUT = 16 * MiB;
constexpr size_t WOUT_L = (size_t)DM * DM * 2;
constexpr size_t WS_WPW = 20 * MiB;
constexpr size_t WPW_L = 256 * 256 * 2;
constexpr size_t WS_KMP = 20 * MiB + 512 * 1024;
constexpr size_t WS_BL = 20 * MiB + 768 * 1024;
constexpr size_t WS_DST = 21 * MiB;
constexpr size_t WS_KV = 23 * MiB;
constexpr size_t WS_DO = 32 * MiB;
constexpr size_t WS_H = 56 * MiB;
constexpr size_t WS_CC = 88 * MiB;
constexpr size_t WS_Z = 120 * MiB;
constexpr size_t WS_END = 240 * MiB;

__device__ __forceinline__ float bf2f(unsigned v) { return __uint_as_float(v << 16); }
__device__ __forceinline__ unsigned f2bf(float f) { unsigned u = __float_as_uint(f); return (u + 0x7fffu + ((u >> 16) & 1u)) >> 16; }
__device__ __forceinline__ unsigned pk2(float lo, float hi) { return f2bf(lo) | (f2bf(hi) << 16); }
__device__ __forceinline__ void unpack8(const u32x4 a, float (&x)[8]) {
#pragma unroll
    for (int k = 0; k < 4; ++k) { x[2 * k] = bf2f(a[k] & 0xffffu); x[2 * k + 1] = bf2f(a[k] >> 16); }
}
__device__ __forceinline__ float wave_sum(float v) {
#pragma unroll
    for (int o = 1; o < 64; o <<= 1) v += __shfl_xor(v, o);
    return v;
}
__device__ __forceinline__ float sigmoidf_(float x) { return 1.0f / (1.0f + __expf(-x)); }
__device__ __forceinline__ float siluf_(float x) { return x / (1.0f + __expf(-x)); }
__device__ __forceinline__ float logsigmoidf_(float x) { return x < 0.f ? x - log1pf(__expf(x)) : -log1pf(__expf(-x)); }
__device__ __forceinline__ int crow(int r, int hi) { return (r & 3) + 8 * (r >> 2) + 4 * hi; }
__device__ __forceinline__ float ex2(float x) { return __builtin_amdgcn_exp2f(x); }

struct LayerP {
    const float *norm_g, *qga, *kga, *qgb, *kgb, *conv_w, *conv_b, *ln_g, *ln_b, *pw_b, *gate_w, *gate_b, *gla_g;
    const bf16_t *WinT, *WoutT, *WpwT;
    const float* xin; float* xout;
};
struct Frame {
    LAS unsigned char* lds;
    int tid, lane, wave, G, bid;
    unsigned* ctl;
    bf16_t *H, *Z, *CC, *DOp; float *KMP, *BL, *DST, *KV;
};

__device__ __forceinline__ void transpose_item(const float* W, int K, int N, int NPb, bf16_t* WT, LAS float* scr, int item, int lane) {
    const int nblk = NPb, kb = item / nblk, nb = item % nblk, k0 = 64 * kb, n0 = 32 * nb;
    const int nn = n0 + (lane & 31);
#pragma unroll 8
    for (int i = 0; i < 32; ++i) { const int kk = 2 * i + (lane >> 5); scr[kk * 33 + (lane & 31)] = (nn < N) ? W[(size_t)(k0 + kk) * N + nn] : 0.f; }
    asm volatile("s_waitcnt lgkmcnt(0)" ::: "memory");
    const int c = lane & 7;
#pragma unroll
    for (int j = 0; j < 4; ++j) { const int n = (lane >> 3) + 8 * j; const LAS float* s = scr + (8 * c) * 33 + n;
        u32x4 o; o.x = pk2(s[0 * 33], s[1 * 33]); o.y = pk2(s[2 * 33], s[3 * 33]); o.z = pk2(s[4 * 33], s[5 * 33]); o.w = pk2(s[6 * 33], s[7 * 33]);
        *(u32x4*)(WT + (size_t)(n0 + n) * K + k0 + 8 * c) = o; }
    asm volatile("s_waitcnt lgkmcnt(0)" ::: "memory");
}
__device__ __forceinline__ void rms_row(const float* xrow, const float* g, bf16_t* orow, int lane) {
    const f32x4* xr = (const f32x4*)xrow + lane; const f32x4* gr = (const f32x4*)g + lane;
    f32x4 v[4]; float s = 0.f;
#pragma unroll
    for (int j = 0; j < 4; ++j) { v[j] = xr[64 * j]; s += (v[j].x * v[j].x + v[j].y * v[j].y) + (v[j].z * v[j].z + v[j].w * v[j].w); }
    const float rinv = 1.0f / sqrtf(wave_sum(s) * (1.0f / DM) + EPS);
    unsigned long long* o8 = (unsigned long long*)orow + lane;
#pragma unroll
    for (int j = 0; j < 4; ++j) { const f32x4 gg = gr[64 * j]; const f32x4 y = (v[j] * rinv) * gg;
        o8[64 * j] = (unsigned long long)pk2(y.x, y.y) | ((unsigned long long)pk2(y.z, y.w) << 32); }
}

__device__ __forceinline__ void prep_norm_item(const Frame& F, const LayerP& P, int it) {
    LAS float* red = (LAS float*)F.lds;
    const int lane = F.lane, w = F.wave;
    float g0[8], g1[8];
    {
        const float* ga0 = lane < 32 ? P.qga : P.kga; const float* ga1 = lane < 32 ? P.qgb : P.kgb; const float sc = lane < 32 ? QSCALE : 1.0f;
#pragma unroll
        for (int e = 0; e < 8; ++e) { const int d = (8 * lane + e) & 63; g0[e] = ga0[d] * sc; g1[e] = ga1[d] * sc; }
    }
    float kacc[8];
#pragma unroll
    for (int e = 0; e < 8; ++e) kacc[e] = 0.f;
    for (int i = 0; i < 8; ++i) {
        bf16_t* p = F.Z + (size_t)(it * 64 + 8 * w + i) * NZP;
        const u32x4 a = *(const u32x4*)(p + 8 * lane), b = *(const u32x4*)(p + C_QB + 8 * lane);
        float x[8], y[8];
        unpack8(a, x);
        float ss = 0.f;
#pragma unroll
        for (int e = 0; e < 8; ++e) ss += x[e] * x[e];
        ss += __shfl_xor(ss, 1); ss += __shfl_xor(ss, 2); ss += __shfl_xor(ss, 4);
        float rinv = 1.0f / sqrtf(ss * (1.0f / 64.0f) + EPS);
#pragma unroll
        for (int e = 0; e < 8; ++e) { y[e] = (x[e] * rinv) * g0[e]; kacc[e] += y[e]; }
        u32x4 o; o.x = pk2(y[0], y[1]); o.y = pk2(y[2], y[3]); o.z = pk2(y[4], y[5]); o.w = pk2(y[6], y[7]);
        *(u32x4*)(p + 8 * lane) = o;
        unpack8(b, x);
        ss = 0.f;
#pragma unroll
        for (int e = 0; e < 8; ++e) ss += x[e] * x[e];
        ss += __shfl_xor(ss, 1); ss += __shfl_xor(ss, 2); ss += __shfl_xor(ss, 4);
        rinv = 1.0f / sqrtf(ss * (1.0f / 64.0f) + EPS);
#pragma unroll
        for (int e = 0; e < 8; ++e) y[e] = (x[e] * rinv) * g1[e];
        o.x = pk2(y[0], y[1]); o.y = pk2(y[2], y[3]); o.z = pk2(y[4], y[5]); o.w = pk2(y[6], y[7]);
        *(u32x4*)(p + C_QB + 8 * lane) = o;
    }
    if (lane >= 32) {
#pragma unroll
        for (int e = 0; e < 8; ++e) red[w * 256 + 8 * (lane - 32) + e] = kacc[e];
    }
    __syncthreads();
    if (F.tid < 256) { float s = 0.f;
#pragma unroll
        for (int ww = 0; ww < 8; ++ww) s += red[ww * 256 + F.tid];
        F.KMP[(size_t)it * 256 + F.tid] = s; }
    __syncthreads();
}

constexpr int GL_BC = 0;
constexpr int GL_Q = 64 * 129;
constexpr int GL_V = 2 * 64 * 129;
constexpr int GL_LR = GL_V + 64 * 257;
constexpr int GL_TOT = GL_LR + 64 * 17;
constexpr int GL_END = GL_TOT + 512;
static_assert(GL_END * 4 <= LDS_BYTES, "GLA LDS");

__device__ __forceinline__ void gla_compute_bc(const Frame& F, const LayerP& P, int m0) {
    LAS float* S = (LAS float*)F.lds;
    LAS float* lrS = S + GL_LR; LAS float* bcS = S + GL_BC; LAS float* totS = S + GL_TOT;
    const int tid = F.tid;
    { const int idx = tid * 2, row = idx >> 4, c = idx & 15;
      const unsigned v = *(const unsigned*)(F.Z + (size_t)(m0 + row) * NZP + C_LR + c);
      lrS[row * 17 + c] = bf2f(v & 0xffffu); lrS[row * 17 + c + 1] = bf2f(v >> 16); }
    __syncthreads();
    const int c = tid & 127, jg = tid >> 7;
    float wv[16];
#pragma unroll
    for (int r = 0; r < 16; ++r) wv[r] = P.gate_w[r * 128 + c];
    const float bias = P.gate_b[c];
    float loc[16]; float run = 0.f;
#pragma unroll
    for (int i = 0; i < 16; ++i) { const int j = jg * 16 + i; float x = 0.f;
#pragma unroll
        for (int r = 0; r < 16; ++r) x += lrS[j * 17 + r] * wv[r];
        x += bias;
        run += logsigmoidf_(x) * (1.0f / 16.0f); loc[i] = run; }
    totS[jg * 128 + c] = run;
    __syncthreads();
    float off = 0.f;
    for (int g = 0; g < jg; ++g) off += totS[g * 128 + c];
#pragma unroll
    for (int i = 0; i < 16; ++i) bcS[(jg * 16 + i) * 129 + c] = off + loc[i];
    __syncthreads();
}
__device__ __forceinline__ void gla_load_v(const Frame& F, int m0) {
    LAS float* vS = (LAS float*)F.lds + GL_V;
#pragma unroll
    for (int i = 0; i < 4; ++i) { const int q = F.tid + 512 * i, j = q >> 5, c8 = q & 31;
        const u32x4 a = *(const u32x4*)(F.Z + (size_t)(m0 + j) * NZP + C_VD + 8 * c8);
        float x[8]; unpack8(a, x);
#pragma unroll
        for (int e = 0; e < 8; ++e) vS[j * 257 + 8 * c8 + e] = x[e]; }
}
__device__ __forceinline__ void gla_kv_item(const Frame& F, const LayerP& P, int it) {
    LAS float* S = (LAS float*)F.lds; LAS float* bcS = S + GL_BC; LAS float* vS = S + GL_V;
    const int m0 = it * 64, tid = F.tid, lane = F.lane;
    gla_compute_bc(F, P, m0);
    const int c = tid & 127;
    const float blast = bcS[63 * 129 + c];
    if (tid < 128) F.BL[(size_t)it * 128 + c] = blast;
    __syncthreads();
#pragma unroll 4
    for (int i = 0; i < 16; ++i) { const int j = (tid >> 7) + 4 * i;
        const float k = bf2f(F.Z[(size_t)(m0 + j) * NZP + C_KD + c]);
        bcS[j * 129 + c] = k * __expf(blast - bcS[j * 129 + c]); }
    gla_load_v(F, m0);
    __syncthreads();
    const int h = F.wave >> 1, vh = F.wave & 1;
    f32x16 acc;
#pragma unroll
    for (int r = 0; r < 16; ++r) acc[r] = 0.f;
#pragma unroll 4
    for (int s = 0; s < 32; ++s) { const int ja = 2 * s + (lane >> 5);
        const float a = bcS[ja * 129 + h * 32 + (lane & 31)];
        const float b = vS[ja * 257 + h * 64 + 32 * vh + (lane & 31)];
        acc = __builtin_amdgcn_mfma_f32_32x32x2f32(a, b, acc, 0, 0, 0); }
    float* kvp = F.KV + ((size_t)it * 4 + h) * 2048;
#pragma unroll
    for (int r = 0; r < 16; ++r) { const int d = crow(r, lane >> 5); kvp[d * 64 + 32 * vh + (lane & 31)] = acc[r]; }
    __syncthreads();
}
__device__ __forceinline__ void gla_scan_item(const Frame& F, int sc) {
    const int gid = sc * 512 + F.tid, b = gid >> 13, rem = gid & 8191, hd = rem >> 6;
    float* kv = F.KV + (size_t)b * 128 * 8192 + rem; const float* bl = F.BL + (size_t)b * 128 * 128 + hd;
    float st = 0.f;
    for (int c0 = 0; c0 < 128; c0 += 8) {
        float kvv[8], dec[8];
#pragma unroll
        for (int u = 0; u < 8; ++u) { kvv[u] = kv[(size_t)(c0 + u) * 8192]; dec[u] = bl[(c0 + u) * 128]; }
#pragma unroll
        for (int u = 0; u < 8; ++u) { kv[(size_t)(c0 + u) * 8192] = st; st = __expf(dec[u]) * st + kvv[u]; }
    }
}
__device__ __forceinline__ void gla_out_item(const Frame& F, const LayerP& P, int it) {
    LAS float* S = (LAS float*)F.lds; LAS float* bcS = S + GL_BC; LAS float* qS = S + GL_Q; LAS float* vS = S + GL_V;
    const int m0 = it * 64, tid = F.tid, lane = F.lane, hf = lane >> 5, l31 = lane & 31;
    gla_compute_bc(F, P, m0);
    { const int c = tid & 127;
#pragma unroll 4
      for (int i = 0; i < 16; ++i) { const int j = (tid >> 7) + 4 * i;
          const bf16_t* zr = F.Z + (size_t)(m0 + j) * NZP;
          const float bc = bcS[j * 129 + c];
          const float q = bf2f(zr[C_QD + c]), k = bf2f(zr[C_KD + c]);
          qS[j * 129 + c] = q * 0.17677669529663687f * __expf(bc);
          bcS[j * 129 + c] = k * __expf(-bc); } }
    gla_load_v(F, m0);
    __syncthreads();
    const int h = F.wave >> 1, ih = F.wave & 1;
    f32x16 aT[2];
#pragma unroll
    for (int jt = 0; jt < 2; ++jt) {
#pragma unroll
        for (int r = 0; r < 16; ++r) aT[jt][r] = 0.f;
        if (jt <= ih) {
#pragma unroll 4
            for (int s = 0; s < 16; ++s) { const int d = 2 * s + hf;
                const float a = bcS[(32 * jt + l31) * 129 + h * 32 + d];
                const float b = qS[(32 * ih + l31) * 129 + h * 32 + d];
                aT[jt] = __builtin_amdgcn_mfma_f32_32x32x2f32(a, b, aT[jt], 0, 0, 0); }
#pragma unroll
            for (int r = 0; r < 16; ++r) { const int j = 32 * jt + crow(r, hf), i = 32 * ih + l31; if (j > i) aT[jt][r] = 0.f; }
        }
    }
    f32x16 oT[2];
    const float* st = F.KV + ((size_t)it * 4 + h) * 2048;
#pragma unroll
    for (int vt = 0; vt < 2; ++vt) {
#pragma unroll
        for (int r = 0; r < 16; ++r) oT[vt][r] = 0.f;
#pragma unroll
        for (int jt = 0; jt < 2; ++jt) {
            if (jt <= ih) {
#pragma unroll
                for (int s = 0; s < 16; ++s) {
                    const float a = vS[(32 * jt + crow(s, hf)) * 257 + h * 64 + 32 * vt + l31];
                    oT[vt] = __builtin_amdgcn_mfma_f32_32x32x2f32(a, aT[jt][s], oT[vt], 0, 0, 0); }
            }
        }
#pragma unroll 4
        for (int s = 0; s < 16; ++s) { const int d = 2 * s + hf;
            const float a = st[d * 64 + 32 * vt + l31];
            const float b = qS[(32 * ih + l31) * 129 + h * 32 + d];
            oT[vt] = __builtin_amdgcn_mfma_f32_32x32x2f32(a, b, oT[vt], 0, 0, 0); }
    }
    float ss = 0.f;
#pragma unroll
    for (int vt = 0; vt < 2; ++vt)
#pragma unroll
        for (int r = 0; r < 16; ++r) ss += oT[vt][r] * oT[vt][r];
    ss += __shfl_xor(ss, 32);
    const float rinv = 1.0f / sqrtf(ss * (1.0f / 64.0f) + EPS);
    const size_t row = (size_t)(m0 + 32 * ih + l31);
    const bf16_t* zg = F.Z + row * NZP + C_GD + h * 64; bf16_t* cc = F.CC + row * DM + 768 + h * 64;
#pragma unroll
    for (int vt = 0; vt < 2; ++vt)
#pragma unroll
        for (int r = 0; r < 16; ++r) { const int v = 32 * vt + crow(r, hf);
            const float y = (oT[vt][r] * rinv) * P.gla_g[v];
            cc[v] = (bf16_t)f2bf(y * siluf_(bf2f(zg[v]))); }
    __syncthreads();
}

constexpr int CV_U = 0;
constexpr int CV_A = 94 * 256 * 4;
static_assert(CV_A + 64 * 264 * 2 <= LDS_BYTES, "conv LDS");
__device__ __forceinline__ void conv_item(const Frame& F, const LayerP& P, int it) {
    LAS float* uS = (LAS float*)F.lds; LAS bf16_t* aS = (LAS bf16_t*)(F.lds + CV_A);
    const int tid = F.tid, lane = F.lane, w = F.wave;
    const int b = it >> 7, t0 = (it & 127) * 64, m0 = it * 64;
    for (int q = tid; q < 94 * 32; q += 512) { const int r = q >> 5, c8 = q & 31, tt = t0 - 30 + r;
        float u[8];
        if (tt >= 0) { const bf16_t* zr = F.Z + (size_t)(b * SEQ + tt) * NZP;
            const u32x4 a = *(const u32x4*)(zr + C_CA + 8 * c8), g = *(const u32x4*)(zr + C_CG + 8 * c8);
            float xa[8], xg[8]; unpack8(a, xa); unpack8(g, xg);
#pragma unroll
            for (int e = 0; e < 8; ++e) u[e] = xa[e] * sigmoidf_(xg[e]);
        } else {
#pragma unroll
            for (int e = 0; e < 8; ++e) u[e] = 0.f; }
#pragma unroll
        for (int e = 0; e < 8; ++e) uS[r * 256 + 8 * c8 + e] = u[e]; }
    __syncthreads();
    if (tid < 256) { const int ch = tid;
      float wk[31];
#pragma unroll
      for (int k = 0; k < 31; ++k) wk[k] = P.conv_w[k * 256 + ch];
      const float bias = P.conv_b[ch];
#pragma unroll 2
      for (int t = 0; t < 64; ++t) { float acc = 0.f;
#pragma unroll
          for (int k = 0; k < 31; ++k) acc += wk[k] * uS[(t + k) * 256 + ch];
          uS[t * 256 + ch] = acc + bias; }
    }
    __syncthreads();
    for (int i = 0; i < 8; ++i) { const int row = 8 * w + i;
        float x[4]; float s = 0.f;
#pragma unroll
        for (int j = 0; j < 4; ++j) { x[j] = uS[row * 256 + lane + 64 * j]; s += x[j]; }
        const float mean = wave_sum(s) * (1.0f / 256.0f); float s2 = 0.f;
#pragma unroll
        for (int j = 0; j < 4; ++j) { x[j] -= mean; s2 += x[j] * x[j]; }
        const float rstd = 1.0f / sqrtf(wave_sum(s2) * (1.0f / 256.0f) + EPS);
#pragma unroll
        for (int j = 0; j < 4; ++j) { const int ch = lane + 64 * j; const float un = (x[j] * rstd) * P.ln_g[ch] + P.ln_b[ch];
            aS[row * 264 + ch] = (bf16_t)f2bf(siluf_(un)); } }
    __syncthreads();
    { const int n0 = 32 * w, fr = lane & 15, fq = lane >> 4;
      f32x4 acc[4][2];
#pragma unroll
      for (int m = 0; m < 4; ++m)
#pragma unroll
          for (int nt = 0; nt < 2; ++nt) acc[m][nt] = (f32x4){0.f, 0.f, 0.f, 0.f};
#pragma unroll 2
      for (int ks = 0; ks < 8; ++ks) {
          bf16x8 bfr[2];
#pragma unroll
          for (int nt = 0; nt < 2; ++nt) bfr[nt] = *(const bf16x8*)(P.WpwT + (size_t)(n0 + 16 * nt + fr) * 256 + 32 * ks + 8 * fq);
#pragma unroll
          for (int m = 0; m < 4; ++m) { const bf16x8 af = *(const LAS bf16x8*)(aS + (16 * m + fr) * 264 + 32 * ks + 8 * fq);
#pragma unroll
              for (int nt = 0; nt < 2; ++nt) acc[m][nt] = __builtin_amdgcn_mfma_f32_16x16x32_bf16(af, bfr[nt], acc[m][nt], 0, 0, 0); } }
#pragma unroll
      for (int m = 0; m < 4; ++m)
#pragma unroll
          for (int nt = 0; nt < 2; ++nt) { const int col = n0 + 16 * nt + fr; const float pb = P.pw_b[col];
#pragma unroll
              for (int r = 0; r < 4; ++r) { const size_t row = (size_t)(m0 + 16 * m + 4 * fq + r);
                  const float v = acc[m][nt][r] + pb;
                  F.CC[row * DM + 512 + col] = (bf16_t)f2bf(v * siluf_(bf2f(F.Z[row * NZP + C_GC + col]))); } }
    }
    __syncthreads();
}

typedef float f32x2_t __attribute__((ext_vector_type(2))); typedef __bf16 bf16x2_t __attribute__((ext_vector_type(2)));
__device__ __forceinline__ unsigned cvtpk(float lo, float hi) { f32x2_t v = {lo, hi}; bf16x2_t b = __builtin_convertvector(v, bf16x2_t); return __builtin_bit_cast(unsigned, b); }

struct AttnState { float m, l; f32x16 oT[2]; };
__device__ __forceinline__ void attn_update(AttnState& st, f32x16& p, const LAS bf16_t* Vt, int pitch, int kcol0, int l31, int hf) {
    float mx = p[0];
#pragma unroll
    for (int r = 1; r < 16; ++r) mx = fmaxf(mx, p[r]);
    mx = fmaxf(mx, __shfl_xor(mx, 32));
    const float mnew = fmaxf(st.m, mx);
    const float alpha = ex2(st.m - mnew);
    float ls = 0.f;
#pragma unroll
    for (int r = 0; r < 16; ++r) { p[r] = ex2(p[r] - mnew); ls += p[r]; }
    st.l = st.l * alpha + ls; st.m = mnew;
#pragma unroll
    for (int d0 = 0; d0 < 2; ++d0)
#pragma unroll
        for (int r = 0; r < 16; ++r) st.oT[d0][r] *= alpha;
#pragma unroll
    for (int s = 0; s < 2; ++s) {
        u32x4 pw; pw.x = cvtpk(p[8 * s + 0], p[8 * s + 1]); pw.y = cvtpk(p[8 * s + 2], p[8 * s + 3]); pw.z = cvtpk(p[8 * s + 4], p[8 * s + 5]); pw.w = cvtpk(p[8 * s + 6], p[8 * s + 7]);
        const bf16x8 pb = __builtin_bit_cast(bf16x8, pw);
#pragma unroll
        for (int d0 = 0; d0 < 2; ++d0) {
            const LAS bf16_t* vp = Vt + (32 * d0 + l31) * pitch + kcol0 + 16 * s + 4 * hf;
            const u32x2 v0 = *(const LAS u32x2*)vp, v1 = *(const LAS u32x2*)(vp + 8);
            u32x4 vv; vv.x = v0.x; vv.y = v0.y; vv.z = v1.x; vv.w = v1.y;
            st.oT[d0] = __builtin_amdgcn_mfma_f32_32x32x16_bf16(__builtin_bit_cast(bf16x8, vv), pb, st.oT[d0], 0, 0, 0); }
    }
}
__device__ __forceinline__ f32x16 attn_qk(const LAS bf16_t* Ks, int krow0, const bf16x8 (&qf)[4], int l31, int hf) {
    f32x16 p;
#pragma unroll
    for (int r = 0; r < 16; ++r) p[r] = 0.f;
#pragma unroll
    for (int d0 = 0; d0 < 4; ++d0) { const bf16x8 a = *(const LAS bf16x8*)(Ks + (krow0 + l31) * 72 + 16 * d0 + 8 * hf);
        p = __builtin_amdgcn_mfma_f32_32x32x16_bf16(a, qf[d0], p, 0, 0, 0); }
    return p;
}
__device__ __forceinline__ void attn_stage(const Frame& F, LAS bf16_t* Ks, LAS bf16_t* Vt, int vpitch, int nrows, const bf16_t* kbase, const bf16_t* vbase, long long row0, long long rstride, long long first_valid_k) {
    for (int q = F.tid; q < nrows * 8; q += 512) { const int r = q >> 3, c8 = q & 7;
        u32x4 kx = (u32x4){0u, 0u, 0u, 0u}, vx = (u32x4){0u, 0u, 0u, 0u};
        if (r >= first_valid_k) { const size_t off = (size_t)(row0 + (long long)r * rstride) * NZP + 8 * c8;
            kx = *(const u32x4*)(kbase + off); vx = *(const u32x4*)(vbase + off); }
        *(LAS u32x4*)(Ks + r * 72 + 8 * c8) = kx;
#pragma unroll
        for (int k = 0; k < 4; ++k) { Vt[(8 * c8 + 2 * k) * vpitch + r] = (bf16_t)(vx[k] & 0xffffu); Vt[(8 * c8 + 2 * k + 1) * vpitch + r] = (bf16_t)(vx[k] >> 16); } }
}

constexpr int MB_KS = 0;
constexpr int MB_VT = 256 * 72 * 2;
constexpr int MB_KM = MB_VT + 64 * 260 * 2;
constexpr int MB_VP = 260;
static_assert(MB_KM + 32 * 64 * 4 <= LDS_BYTES, "moba LDS");
__device__ __forceinline__ void moba_unit(const Frame& F, int b, int h, int qb) {
    LAS bf16_t* Ks = (LAS bf16_t*)(F.lds + MB_KS); LAS bf16_t* Vt = (LAS bf16_t*)(F.lds + MB_VT); LAS float* kmS = (LAS float*)(F.lds + MB_KM);
    const int tid = F.tid, lane = F.lane, w = F.wave, l31 = lane & 31, hf = lane >> 5;
    const float slope2 = exp2f(-(float)(2 * h + 1)) * LOG2E;
    for (int q = tid; q < qb * 64; q += 512) { const int n = q >> 6, d = q & 63;
        const float* kp = F.KMP + ((size_t)(b * 128 + 4 * n)) * 256 + h * 64 + d;
        kmS[q] = ((kp[0] + kp[256]) + (kp[512] + kp[768])) * (1.0f / 256.0f); }
    const int qrow = qb * 256 + 32 * w + l31;
    const size_t grow = (size_t)b * SEQ + qrow;
    bf16x8 qf[4];
#pragma unroll
    for (int d0 = 0; d0 < 4; ++d0) qf[d0] = *(const bf16x8*)(F.Z + grow * NZP + C_QA + h * 64 + 16 * d0 + 8 * hf);
    __syncthreads();
    unsigned selmask = 0u;
    {
        float qv[32];
#pragma unroll
        for (int d0 = 0; d0 < 4; ++d0)
#pragma unroll
            for (int j = 0; j < 8; ++j) qv[d0 * 8 + j] = bf2f((unsigned short)qf[d0][j]);
        float v0 = -INFINITY, v1 = -INFINITY, v2 = -INFINITY; int i0 = -1, i1 = -1, i2 = -1;
        for (int n = 0; n < qb; ++n) { float g = 0.f;
#pragma unroll
            for (int d0 = 0; d0 < 4; ++d0)
#pragma unroll
                for (int j = 0; j < 8; ++j) g += qv[d0 * 8 + j] * kmS[n * 64 + 16 * d0 + 8 * hf + j];
            g += __shfl_xor(g, 32);
            if (g > v0) { v2 = v1; i2 = i1; v1 = v0; i1 = i0; v0 = g; i0 = n; }
            else if (g > v1) { v2 = v1; i2 = i1; v1 = g; i1 = n; }
            else if (g > v2) { v2 = g; i2 = n; } }
        if (i0 >= 0) selmask |= 1u << i0;
        if (i1 >= 0) selmask |= 1u << i1;
        if (i2 >= 0) selmask |= 1u << i2;
    }
    AttnState st; st.m = -INFINITY; st.l = 0.f;
#pragma unroll
    for (int d0 = 0; d0 < 2; ++d0)
#pragma unroll
        for (int r = 0; r < 16; ++r) st.oT[d0][r] = 0.f;
    const bf16_t* kb = F.Z + C_KA + h * 64; const bf16_t* vb = F.Z + C_VA + h * 64;
    for (int step = 0; step <= qb; ++step) {
        const int n = (step == 0) ? qb : (qb - step);
        __syncthreads();
        attn_stage(F, Ks, Vt, MB_VP, 256, kb, vb, (long long)b * SEQ + n * 256, 1, 0);
        __syncthreads();
        const bool own = (step == 0);
        const bool lane_sel = own || ((selmask >> n) & 1u);
        if (!__any(lane_sel)) continue;
        const int ntile = own ? (w + 1) : 8;
        for (int t = 0; t < ntile; ++t) {
            f32x16 p = attn_qk(Ks, 32 * t, qf, l31, hf);
            const int kpos0 = n * 256 + 32 * t;
#pragma unroll
            for (int r = 0; r < 16; ++r) { const int kp = kpos0 + crow(r, hf);
                const float s = p[r] + slope2 * (float)(kp - qrow);
                const bool valid = own ? (kp <= qrow) : lane_sel;
                p[r] = valid ? s : -INFINITY; }
            attn_update(st, p, Vt, MB_VP, 32 * t, l31, hf);
        }
    }
    const float ltot = st.l + __shfl_xor(st.l, 32);
    const float rl = 1.0f / ltot;
    const bf16_t* zg = F.Z + grow * NZP + C_GA + h * 64; bf16_t* cc = F.CC + grow * DM + h * 64;
#pragma unroll
    for (int d0 = 0; d0 < 2; ++d0)
#pragma unroll
        for (int r = 0; r < 16; ++r) { const int d = 32 * d0 + crow(r, hf);
            cc[d] = (bf16_t)f2bf(st.oT[d0][r] * rl * siluf_(bf2f(zg[d]))); }
    __syncthreads();
}

constexpr int DL_KS = 0;
constexpr int DL_VT = 384 * 72 * 2;
constexpr int DL_VP = 388;
static_assert(DL_VT + 64 * 388 * 2 <= LDS_BYTES, "dil LDS");
__device__ __forceinline__ void dil_unit(const Frame& F, int b, int h, int pat, int uidx) {
    LAS bf16_t* Ks = (LAS bf16_t*)(F.lds + DL_KS); LAS bf16_t* Vt = (LAS bf16_t*)(F.lds + DL_VT);
    const int lane = F.lane, w = F.wave, l31 = lane & 31, hf = lane >> 5;
    const int dil = (pat == 0) ? 1 : (pat == 1 ? 4 : 16);
    const int upg = 32 / dil;
    const int g = uidx / upg, u = uidx % upg;
    const float slope2 = exp2f(-(float)(2 * h + 2)) * LOG2E * (float)dil;
    const int i0 = 256 * u - 128;
    __syncthreads();
    attn_stage(F, Ks, Vt, DL_VP, 384, F.Z + C_KB + h * 64, F.Z + C_VB + h * 64, (long long)b * SEQ + (long long)i0 * dil + g, dil, (i0 < 0) ? 128 : 0);
    const int iq = 256 * u + 32 * w + l31;
    const size_t grow = (size_t)b * SEQ + (size_t)iq * dil + g;
    bf16x8 qf[4];
#pragma unroll
    for (int d0 = 0; d0 < 4; ++d0) qf[d0] = *(const bf16x8*)(F.Z + grow * NZP + C_QB + h * 64 + 16 * d0 + 8 * hf);
    __syncthreads();
    AttnState st; st.m = -INFINITY; st.l = 0.f;
#pragma unroll
    for (int d0 = 0; d0 < 2; ++d0)
#pragma unroll
        for (int r = 0; r < 16; ++r) st.oT[d0][r] = 0.f;
    for (int j = 4; j >= 0; --j) {
        const int kk0 = 32 * w + 32 * j;
        if (i0 + kk0 + 31 < 0) continue;
        f32x16 p = attn_qk(Ks, kk0, qf, l31, hf);
#pragma unroll
        for (int r = 0; r < 16; ++r) { const int kk = kk0 + crow(r, hf); const int dist = (32 * w + l31 + 128) - kk;
            const bool valid = (dist >= 0) && (dist <= 128) && (i0 + kk >= 0);
            p[r] = valid ? (p[r] - slope2 * (float)dist) : -INFINITY; }
        attn_update(st, p, Vt, DL_VP, kk0, l31, hf);
    }
    const float ltot = st.l + __shfl_xor(st.l, 32);
    const float rl = 1.0f / ltot;
    bf16_t* op = F.DOp + ((size_t)pat * MTOK + grow) * 256 + h * 64;
#pragma unroll
    for (int d0 = 0; d0 < 2; ++d0)
#pragma unroll
        for (int r = 0; r < 16; ++r) { const int d = 32 * d0 + crow(r, hf); op[d] = (bf16_t)f2bf(st.oT[d0][r] * rl); }
    if (hf == 0) { float* sp = F.DST + (((size_t)pat * MTOK + grow) * 4 + h) * 2; sp[0] = st.m; sp[1] = ltot; }
    __syncthreads();
}
__device__ __forceinline__ void dil_combine_item(const Frame& F, int item) {
    const int idx = item * 512 + F.tid; const size_t row = (size_t)(idx >> 5); const int h = (idx >> 3) & 3, c8 = idx & 7;
    float m[3], l[3];
#pragma unroll
    for (int p = 0; p < 3; ++p) { const float* sp = F.DST + (((size_t)p * MTOK + row) * 4 + h) * 2; m[p] = sp[0]; l[p] = sp[1]; }
    const float mm = fmaxf(fmaxf(m[0], m[1]), m[2]);
    float wsum = 0.f; float o[8];
#pragma unroll
    for (int e = 0; e < 8; ++e) o[e] = 0.f;
#pragma unroll
    for (int p = 0; p < 3; ++p) { const float wgt = l[p] * ex2(m[p] - mm); wsum += wgt;
        const u32x4 a = *(const u32x4*)(F.DOp + ((size_t)p * MTOK + row) * 256 + h * 64 + 8 * c8);
        float x[8]; unpack8(a, x);
#pragma unroll
        for (int e = 0; e < 8; ++e) o[e] += wgt * x[e]; }
    const float rw = 1.0f / wsum;
    const u32x4 gz = *(const u32x4*)(F.Z + row * NZP + C_GB + h * 64 + 8 * c8);
    float gx[8]; unpack8(gz, gx);
    float y[8];
#pragma unroll
    for (int e = 0; e < 8; ++e) y[e] = o[e] * rw * siluf_(gx[e]);
    u32x4 ov; ov.x = pk2(y[0], y[1]); ov.y = pk2(y[2], y[3]); ov.z = pk2(y[4], y[5]); ov.w = pk2(y[6], y[7]);
    *(u32x4*)(F.CC + row * DM + 256 + h * 64 + 8 * c8) = ov;
}
__device__ __forceinline__ void cc_zero_cols(const Frame& F, int col0) {
    for (size_t q = (size_t)F.bid * 512 + F.tid; q < (size_t)MTOK * 32; q += (size_t)F.G * 512) { const size_t row = q >> 5; const int c8 = (int)(q & 31);
        *(u32x4*)(F.CC + row * DM + col0 + 8 * c8) = (u32x4){0u, 0u, 0u, 0u}; }
}

struct Args { const float* in[17]; float* out; unsigned char* ws; int ph_lo, ph_hi, coop, pad; };

template <int K> __device__ __forceinline__ void run_phase(const int l, LAS unsigned char* lds_base, LAS int* s_item) {
        typedef const __attribute__((address_space(4))) Args* ArgP;
        ArgP ap = (ArgP)__builtin_amdgcn_kernarg_segment_ptr(); asm volatile("" : "+s"(ap));
        Frame F;
        F.lds = lds_base;
        { int t_ = threadIdx.x; asm volatile("" : "+v"(t_)); F.tid = t_; F.lane = t_ & 63; F.wave = __builtin_amdgcn_readfirstlane(t_ >> 6); }
        { int g_ = gridDim.x, b_ = blockIdx.x; asm volatile("" : "+s"(g_), "+s"(b_)); F.G = g_; F.bid = b_; }
        unsigned char* ws = ap->ws;
        F.ctl = (unsigned*)(ws + WS_CTL);
        F.H = (bf16_t*)(ws + WS_H); F.Z = (bf16_t*)(ws + WS_Z); F.CC = (bf16_t*)(ws + WS_CC); F.DOp = (bf16_t*)(ws + WS_DO);
        F.KMP = (float*)(ws + WS_KMP); F.BL = (float*)(ws + WS_BL); F.DST = (float*)(ws + WS_DST); F.KV = (float*)(ws + WS_KV);
        LayerP P;
        P.norm_g = ap->in[1] + l * DM;
        P.qga = ap->in[3] + l * 64; P.kga = ap->in[4] + l * 64; P.qgb = ap->in[5] + l * 64; P.kgb = ap->in[6] + l * 64;
        P.conv_w = ap->in[7] + l * 31 * 256; P.conv_b = ap->in[8] + l * 256; P.ln_g = ap->in[9] + l * 256; P.ln_b = ap->in[10] + l * 256;
        P.pw_b = ap->in[12] + l * 256; P.gate_w = ap->in[13] + l * 16 * 128; P.gate_b = ap->in[14] + l * 128; P.gla_g = ap->in[15] + l * 64;
        P.WinT = (const bf16_t*)(ws + WS_WIN + l * WIN_L); P.WoutT = (const bf16_t*)(ws + WS_WOUT + l * WOUT_L); P.WpwT = (const bf16_t*)(ws + WS_WPW + l * WPW_L);
        P.xin = (l == 0) ? ap->in[0] : ap->out; P.xout = ap->out;

        if constexpr (K == 0) {
            const int gw = F.bid * NWAVES + F.wave, NGW = F.G * NWAVES;
            if (l == 0) {
                LAS float* scr = (LAS float*)(F.lds + F.wave * 16384);
                constexpr int I_IN = 16 * (NZP / 32), I_OUT = 16 * 32, I_PW = 4 * 8, I_L = I_IN + I_OUT + I_PW;
                for (int it = gw; it < 2 * I_L; it += NGW) { const int ll = it / I_L; int r = it - ll * I_L;
                    if (r < I_IN) { transpose_item(ap->in[2] + (size_t)ll * DM * NZ, DM, NZ, NZP / 32, (bf16_t*)(ws + WS_WIN + ll * WIN_L), scr, r, F.lane); continue; } r -= I_IN;
                    if (r < I_OUT) { transpose_item(ap->in[16] + (size_t)ll * DM * DM, DM, DM, 32, (bf16_t*)(ws + WS_WOUT + ll * WOUT_L), scr, r, F.lane); continue; } r -= I_OUT;
                    transpose_item(ap->in[11] + (size_t)ll * 65536, 256, 256, 8, (bf16_t*)(ws + WS_WPW + ll * WPW_L), scr, r, F.lane); }
            }
            for (int m = gw; m < MTOK; m += NGW) rms_row(P.xin + (size_t)m * DM, P.norm_g, F.H + (size_t)m * DM, F.lane);
        } else if constexpr (K == 1) {
            pg8::Gemm g{F.H, P.WinT, MTOK, NZP, DM}; pg8::StaticOrder S; S.init(MTOK, NZP, F.G, F.bid);
            pg8::EpiZ E{F.Z, NZP};
            pg8::gemm_phase<pg8::EpiZ, pg8::StaticOrder, true, true>(F.lds, g, S, E);
        } else if constexpr (K == 2) {
            for (int it = F.bid; it < 256; it += F.G) prep_norm_item(F, P, it);
#if EN_GLA
            for (int it = F.bid; it < 256; it += F.G) gla_kv_item(F, P, it);
#endif
#if EN_CONV
            for (int it = F.bid; it < 256; it += F.G) conv_item(F, P, it);
#else
            cc_zero_cols(F, 512);
#endif
        } else if constexpr (K == 3) {
            unsigned* ctr = F.ctl + 64 * (1 + l);
            for (;;) {
                __syncthreads();
                if (F.tid == 0) *s_item = (int)atomicAdd(ctr, 1u);
                __syncthreads();
                const int item = *s_item;
                if (item >= 32 + 256 + 768) break;
                if (item < 32) {
#if EN_GLA
                    gla_scan_item(F, item);
#endif
                } else if (item < 288) {
#if EN_MOBA
                    const int q = item - 32; moba_unit(F, (q >> 2) & 1, q & 3, 31 - (q >> 3));
#endif
                } else {
#if EN_DIL
                    const int q = item - 288; const int pat = q / 256, r = q % 256; dil_unit(F, (r >> 2) & 1, r & 3, pat, r >> 3);
#endif
                }
            }
#if !EN_MOBA
            cc_zero_cols(F, 0);
#endif
        } else if constexpr (K == 4) {
#if EN_GLA
            for (int it = F.bid; it < 256; it += F.G) gla_out_item(F, P, it);
#else
            cc_zero_cols(F, 768);
#endif
#if EN_DIL
            for (int it = F.bid; it < 1024; it += F.G) dil_combine_item(F, it);
#else
            cc_zero_cols(F, 256);
#endif
        } else {
            pg8::Gemm g{F.CC, P.WoutT, MTOK, DM, DM}; pg8::StaticOrder S; S.init(MTOK, DM, F.G, F.bid);
            pg8::EpiRes E{P.xin, P.xout, DM};
            pg8::gemm_phase<pg8::EpiRes, pg8::StaticOrder, true, true>(F.lds, g, S, E);
        }
}

__global__ void __launch_bounds__(NTHR, 2) hybrid_fwd(Args args) {
    extern __shared__ __attribute__((aligned(16))) unsigned char lds_raw[];
    cg::grid_group grid = cg::this_grid();
    LAS unsigned char* lds_base = (LAS unsigned char*)lds_raw;
    LAS int* s_item = (LAS int*)(lds_base + LDS_BYTES - 64);
    const int ph_lo = args.ph_lo, ph_hi = args.ph_hi, coop = args.coop;
#define RUN(PH) if (ph_lo <= (PH) && (PH) < ph_hi) { run_phase<(PH) % 6>((PH) / 6, lds_base, s_item); if ((PH) + 1 < ph_hi && coop) grid.sync(); }
    RUN(0) RUN(1) RUN(2) RUN(3) RUN(4) RUN(5) RUN(6) RUN(7) RUN(8) RUN(9) RUN(10) RUN(11)
#undef RUN
}

extern "C" void kernel_launch(void* const* d_in, const int* in_sizes, int n_in, void* d_out, int out_size, void* d_ws, size_t ws_size, hipStream_t stream) {
    static int grid = 0;
    if (grid == 0) {
        if (n_in != 17 || out_size != MTOK * DM || ws_size < WS_END) { fprintf(stderr, "kernel_launch: unexpected shapes (n_in %d out %d ws %zu)\n", n_in, out_size, ws_size); grid = -1; return; }
        int dev = 0, cus = 0, per_cu = 0;
        hipGetDevice(&dev); hipDeviceGetAttribute(&cus, hipDeviceAttributeMultiprocessorCount, dev);
        if (hipFuncSetAttribute((const void*)hybrid_fwd, hipFuncAttributeMaxDynamicSharedMemorySize, LDS_BYTES) != hipSuccess) { fprintf(stderr, "kernel_launch: hipFuncSetAttribute failed\n"); grid = -1; return; }
        if (hipOccupancyMaxActiveBlocksPerMultiprocessor(&per_cu, (const void*)hybrid_fwd, NTHR, LDS_BYTES) != hipSuccess || per_cu < 1) { fprintf(stderr, "kernel_launch: occupancy query gives %d\n", per_cu); per_cu = 1; }
        (void)hipGetLastError();
        if (per_cu > 1) per_cu = 1;
        grid = cus * per_cu;
    }
    if (grid < 0) return;
    hipMemsetAsync((char*)d_ws + WS_CTL, 0, CTL_ZERO_BYTES, stream);
    Args a{};
    for (int i = 0; i < 17; ++i) a.in[i] = (const float*)d_in[i];
    a.out = (float*)d_out; a.ws = (unsigned char*)d_ws;
#if N_LAUNCH_MODE == 1
    a.ph_lo = 0; a.ph_hi = 12; a.coop = 1;
    void* kargs[] = {&a};
    hipError_t e = hipLaunchCooperativeKernel((const void*)hybrid_fwd, dim3(grid), dim3(NTHR), kargs, LDS_BYTES, stream);
    if (e != hipSuccess) fprintf(stderr, "cooperative launch failed: %s (grid %d)\n", hipGetErrorString(e), grid);
#else
    for (int ph = 0; ph < 12; ++ph) { a.ph_lo = ph; a.ph_hi = ph + 1; a.coop = 0;
        hipLaunchKernelGGL(hybrid_fwd, dim3(grid), dim3(NTHR), LDS_BYTES, stream, a); }
#endif
}
```

```cpp
#include <hip/hip_runtime.h>
#include <hip/hip_cooperative_groups.h>
#include <cstdio>
#include <cstdint>
namespace cg = cooperative_groups;
template <int CTRL> __device__ __forceinline__ float xl_dpp(float v) { return __int_as_float(__builtin_amdgcn_update_dpp(0, __float_as_int(v), CTRL, 0xF, 0xF, true)); }
__device__ __forceinline__ float row16_sum(float v) { v += xl_dpp<0xB1>(v); v += xl_dpp<0x4E>(v); v += xl_dpp<0x141>(v); v += xl_dpp<0x140>(v); return v; }
__device__ __forceinline__ float row16_max(float v) { v = fmaxf(v, xl_dpp<0xB1>(v)); v = fmaxf(v, xl_dpp<0x4E>(v)); v = fmaxf(v, xl_dpp<0x141>(v)); v = fmaxf(v, xl_dpp<0x140>(v)); return v; }
__device__ __forceinline__ float xor16_sum(float v) { const auto r = __builtin_amdgcn_permlane16_swap(__float_as_uint(v), __float_as_uint(v), false, false); return __uint_as_float(r[0]) + __uint_as_float(r[1]); }
__device__ __forceinline__ float xor32_sum(float v) { const auto r = __builtin_amdgcn_permlane32_swap(__float_as_uint(v), __float_as_uint(v), false, false); return __uint_as_float(r[0]) + __uint_as_float(r[1]); }
__device__ __forceinline__ float wave64_sum(float v) { v = row16_sum(v);
    return (__int_as_float(__builtin_amdgcn_readlane(__float_as_int(v), 0)) + __int_as_float(__builtin_amdgcn_readlane(__float_as_int(v), 16))) + (__int_as_float(__builtin_amdgcn_readlane(__float_as_int(v), 32)) + __int_as_float(__builtin_amdgcn_readlane(__float_as_int(v), 48))); }
__device__ __forceinline__ float wave64_max(float v) { v = row16_max(v);
    return fmaxf(fmaxf(__int_as_float(__builtin_amdgcn_readlane(__float_as_int(v), 0)), __int_as_float(__builtin_amdgcn_readlane(__float_as_int(v), 16))), fmaxf(__int_as_float(__builtin_amdgcn_readlane(__float_as_int(v), 32)), __int_as_float(__builtin_amdgcn_readlane(__float_as_int(v), 48)))); }
namespace pg8 {
#define PG8_LAS __attribute__((address_space(3)))
typedef unsigned short bf16_t;
typedef short bf16x8 __attribute__((ext_vector_type(8)));
typedef float f32x4 __attribute__((ext_vector_type(4)));
typedef unsigned u32x4 __attribute__((ext_vector_type(4)));
constexpr int BM = 256, BK = 64, HALF = 128, HTB = HALF * BK * 2  , STAGE_BYTES = 8 * HTB, NXCD = 8, WGM = 8;

__host__ __device__ __forceinline__ int lds_byte(int r, int c) { const int st = (r >> 4) * 2 + (c >> 5), rr = r & 15, cc = c & 31, ob = rr * 64 + cc * 2; return st * 1024 + (ob ^ (((ob >> 9) & 1) << 5)); }
__host__ __device__ __forceinline__ void stage_rc(int b, int& R, int& C) { const int st = b / 1024, sb = b % 1024, swz = sb ^ (((sb >> 9) & 1) << 5); R = (st >> 1) * 16 + swz / 64; C = (st & 1) * 32 + (swz % 64) / 2; }
__host__ __device__ __forceinline__ int perm32(int rho) { const int n = rho >> 4, i = rho & 15; return 8 * (i >> 2) + 4 * n + (i & 3); }

struct Unit { int pm, pn; };
struct Gemm { const bf16_t* A; const bf16_t* Bt; int M, N, K; };

struct StaticOrder {
    int nM, nN, nwg, G, c;
    __host__ __device__ void init(int M, int N, int G_, int c_) { nM = M / BM; nN = N / BM; nwg = nM * nN; G = G_; c = c_; }
    __host__ __device__ bool next(int i, Unit& u) const {
        const long L = (long)i * G + c; if (L >= nwg) return false;
        int wgid = (int)L; { const int q = nwg / NXCD, r = nwg % NXCD, xcd = wgid % NXCD, off = wgid / NXCD; wgid = (xcd < r ? xcd * (q + 1) : r * (q + 1) + (xcd - r) * q) + off; }
        const int nig = WGM * nN, gid = wgid / nig, fm = gid * WGM, gsz = (nM - fm) < WGM ? (nM - fm) : WGM;
        u.pm = fm + ((wgid % nig) % gsz); u.pn = (wgid % nig) / gsz; return true;
    }
    __device__ __forceinline__ void a_ready(const Unit&) const {}
    __device__ __forceinline__ void done(const Unit&) const {}
};

__device__ __forceinline__ unsigned cvt_pk_bf16(float lo, float hi) { unsigned r; asm volatile("v_cvt_pk_bf16_f32 %0, %1, %2" : "=v"(r) : "v"(lo), "v"(hi)); return r; }
struct EpiZ {
    static constexpr bool PERM = true, AFTER_DRAIN = false;
    bf16_t* O; int ldc; const float* ssq; float inv_k, eps;
    PG8_LAS float* xch; const float *qga, *kga, *qgb, *kgb; float* km; float qscale; int ncols;
    __device__ __forceinline__ void operator()(const f32x4 (&acc)[2][2][4][2], const Unit& u, int wr, int wc, int fr, int fq) const {
        const int row0 = u.pm * BM + wr * 64 + fr; const int col0 = u.pn * BM + wc * 32 + 8 * fq;
        const int kind = (u.pn == 0) ? 1 : (u.pn == 1) ? 2 : (u.pn == 4) ? 3 : (u.pn == 5) ? 4 : 0;
        float sc[2][4];
#pragma unroll
        for (int ai = 0; ai < 2; ++ai)
#pragma unroll
            for (int m = 0; m < 4; ++m) sc[ai][m] = __builtin_amdgcn_rsqf(__hip_atomic_load(ssq + row0 + ai * HALF + m * 16, __ATOMIC_RELAXED, __HIP_MEMORY_SCOPE_AGENT) * inv_k + eps);
        const int wave = wr * 4 + wc;
        const float* gp = (kind == 1) ? qga : (kind == 2) ? kga : (kind == 3) ? qgb : kgb;
        const float gs = (kind & 1) ? qscale : 1.0f;
        float g[8];
#pragma unroll
        for (int e2 = 0; e2 < 8; ++e2) g[e2] = gp[32 * (wc & 1) + 8 * fq + e2] * gs;
        if (kind != 0) {
#pragma unroll
            for (int ai = 0; ai < 2; ++ai)
#pragma unroll
                for (int m = 0; m < 4; ++m)
#pragma unroll
                    for (int bj = 0; bj < 2; ++bj) { const f32x4 v0 = acc[ai][bj][m][0] * sc[ai][m], v1 = acc[ai][bj][m][1] * sc[ai][m];
                        float s = (v0[0] * v0[0] + v0[1] * v0[1]) + (v0[2] * v0[2] + v0[3] * v0[3]) + (v1[0] * v1[0] + v1[1] * v1[1]) + (v1[2] * v1[2] + v1[3] * v1[3]);
                        s = xor16_sum(s); s = xor32_sum(s);
                        if (fq == 0) xch[((wave * 2 + ai) * 4 + m) * 32 + bj * 16 + fr] = s; }
        }
        asm volatile("s_waitcnt lgkmcnt(0)" ::: "memory"); __builtin_amdgcn_s_barrier(); asm volatile("" ::: "memory");
        if (kind == 0) {
#pragma unroll
            for (int ai = 0; ai < 2; ++ai)
#pragma unroll
                for (int m = 0; m < 4; ++m) { bf16_t* rowp = O + (size_t)(row0 + ai * HALF + m * 16) * ldc + col0;
#pragma unroll
                    for (int bj = 0; bj < 2; ++bj) { const f32x4 v0 = acc[ai][bj][m][0] * sc[ai][m], v1 = acc[ai][bj][m][1] * sc[ai][m];
                        u32x4 w; w.x = cvt_pk_bf16(v0[0], v0[1]); w.y = cvt_pk_bf16(v0[2], v0[3]); w.z = cvt_pk_bf16(v1[0], v1[1]); w.w = cvt_pk_bf16(v1[2], v1[3]);
                        if (col0 + bj * HALF < ncols) *(u32x4*)(rowp + bj * HALF) = w; } }
            return;
        }
        float kacc[2][8];
#pragma unroll
        for (int bj = 0; bj < 2; ++bj)
#pragma unroll
            for (int e2 = 0; e2 < 8; ++e2) kacc[bj][e2] = 0.f;
        const int we = wave & ~1;
#pragma unroll
        for (int ai = 0; ai < 2; ++ai)
#pragma unroll
            for (int m = 0; m < 4; ++m) { bf16_t* rowp = O + (size_t)(row0 + ai * HALF + m * 16) * ldc + col0;
#pragma unroll
                for (int bj = 0; bj < 2; ++bj) {
                    const float tot = xch[((we * 2 + ai) * 4 + m) * 32 + bj * 16 + fr] + xch[(((we + 1) * 2 + ai) * 4 + m) * 32 + bj * 16 + fr];
                    const float rh = sc[ai][m] * __builtin_amdgcn_rsqf(tot * (1.0f / 64.0f) + eps);
                    f32x4 v0 = acc[ai][bj][m][0] * rh, v1 = acc[ai][bj][m][1] * rh;
                    v0[0] *= g[0]; v0[1] *= g[1]; v0[2] *= g[2]; v0[3] *= g[3]; v1[0] *= g[4]; v1[1] *= g[5]; v1[2] *= g[6]; v1[3] *= g[7];
                    if (kind == 2) { kacc[bj][0] += v0[0]; kacc[bj][1] += v0[1]; kacc[bj][2] += v0[2]; kacc[bj][3] += v0[3]; kacc[bj][4] += v1[0]; kacc[bj][5] += v1[1]; kacc[bj][6] += v1[2]; kacc[bj][7] += v1[3]; }
                    u32x4 w; w.x = cvt_pk_bf16(v0[0], v0[1]); w.y = cvt_pk_bf16(v0[2], v0[3]); w.z = cvt_pk_bf16(v1[0], v1[1]); w.w = cvt_pk_bf16(v1[2], v1[3]);
                    *(u32x4*)(rowp + bj * HALF) = w; } }
        if (kind == 2) {
#pragma unroll
            for (int bj = 0; bj < 2; ++bj)
#pragma unroll
                for (int e2 = 0; e2 < 8; ++e2) { float s = kacc[bj][e2];
                    s = row16_sum(s);
                    if (fr == 0) atomicAdd(km + (size_t)u.pm * 256 + bj * HALF + wc * 32 + 8 * fq + e2, s); }
        }
    }
};
struct EpiResX {
    static constexpr bool PERM = false, AFTER_DRAIN = false;
    bf16_t* xb; float* ssq; int ldc;
    __device__ __forceinline__ void operator()(const f32x4 (&acc)[2][2][4][2], const Unit& u, int wr, int wc, int fr, int fq) const {
        const int col0 = u.pn * BM + wc * 32 + 4 * fq;
#pragma unroll
        for (int ai = 0; ai < 2; ++ai) {
            unsigned long long bs[4][2][2];
#pragma unroll
            for (int m = 0; m < 4; ++m) { const size_t off = (size_t)(u.pm * BM + ai * HALF + wr * 64 + m * 16 + fr) * ldc + col0;
#pragma unroll
                for (int bj = 0; bj < 2; ++bj)
#pragma unroll
                    for (int n = 0; n < 2; ++n) bs[m][bj][n] = *(const unsigned long long*)(xb + off + bj * HALF + n * 16); }
            asm volatile("" ::: "memory");
#pragma unroll
            for (int m = 0; m < 4; ++m) { const int row = u.pm * BM + ai * HALF + wr * 64 + m * 16 + fr; const size_t off = (size_t)row * ldc + col0;
                float s = 0.f;
#pragma unroll
                for (int bj = 0; bj < 2; ++bj)
#pragma unroll
                    for (int n = 0; n < 2; ++n) { const unsigned long long wv = bs[m][bj][n]; const unsigned lo = (unsigned)wv, hi = (unsigned)(wv >> 32);
                        f32x4 r; r[0] = __uint_as_float(lo << 16); r[1] = __uint_as_float(lo & 0xffff0000u); r[2] = __uint_as_float(hi << 16); r[3] = __uint_as_float(hi & 0xffff0000u);
                        const f32x4 x1 = r + acc[ai][bj][m][n];
                        unsigned long long w = (unsigned long long)cvt_pk_bf16(x1[0], x1[1]) | ((unsigned long long)cvt_pk_bf16(x1[2], x1[3]) << 32);
                        *(unsigned long long*)(xb + off + bj * HALF + n * 16) = w;
                        s += (x1[0] * x1[0] + x1[1] * x1[1]) + (x1[2] * x1[2] + x1[3] * x1[3]); }
                s = xor16_sum(s); s = xor32_sum(s);
                if (fq == 0) atomicAdd(ssq + row, s); }
            asm volatile("" ::: "memory");
        }
    }
};
struct EpiRes {
    static constexpr bool PERM = false, AFTER_DRAIN = false;
    const bf16_t* xb; float* out; int ldc;
    __device__ __forceinline__ void operator()(const f32x4 (&acc)[2][2][4][2], const Unit& u, int wr, int wc, int fr, int fq) const {
        const int col0 = u.pn * BM + wc * 32 + 4 * fq;
        unsigned long long bs[2][4][2][2];
#pragma unroll
        for (int ai = 0; ai < 2; ++ai)
#pragma unroll
            for (int m = 0; m < 4; ++m) { const size_t off = (size_t)(u.pm * BM + ai * HALF + wr * 64 + m * 16 + fr) * ldc + col0;
#pragma unroll
                for (int bj = 0; bj < 2; ++bj)
#pragma unroll
                    for (int n = 0; n < 2; ++n) bs[ai][m][bj][n] = *(const unsigned long long*)(xb + off + bj * HALF + n * 16); }
        asm volatile("" ::: "memory");
#pragma unroll
        for (int ai = 0; ai < 2; ++ai)
#pragma unroll
            for (int m = 0; m < 4; ++m) { const size_t off = (size_t)(u.pm * BM + ai * HALF + wr * 64 + m * 16 + fr) * ldc + col0;
#pragma unroll
                for (int bj = 0; bj < 2; ++bj)
#pragma unroll
                    for (int n = 0; n < 2; ++n) { const unsigned long long w = bs[ai][m][bj][n]; const unsigned lo = (unsigned)w, hi = (unsigned)(w >> 32);
                        f32x4 r; r[0] = __uint_as_float(lo << 16); r[1] = __uint_as_float(lo & 0xffff0000u); r[2] = __uint_as_float(hi << 16); r[3] = __uint_as_float(hi & 0xffff0000u);
                        *(f32x4*)(out + off + bj * HALF + n * 16) = r + acc[ai][bj][m][n]; } }
    }
};
template <class Epi, class Sched, bool ALIGN_EPI = false, bool SP2 = false>
__device__ __forceinline__ void gemm_phase(PG8_LAS unsigned char* lds, const Gemm g, const Sched& S, const Epi& E) {
    int tid_l = threadIdx.x; asm volatile("" : "+v"(tid_l));
    const int tid = tid_l, wid = __builtin_amdgcn_readfirstlane(tid >> 6), lane = tid & 63, wr = wid >> 2, wc = wid & 3, fr = lane & 15, fq = lane >> 4;
    const int K = g.K, nt = K / BK;
    unsigned voffA[2], voffB[2];
#pragma unroll
    for (int i = 0; i < 2; ++i) { int R, C; stage_rc(tid * 16 + i * 8192, R, C); const int Rb = Epi::PERM ? ((R & ~31) + perm32(R & 31)) : R;
        voffA[i] = (unsigned)(R * K + C) * 2u; voffB[i] = (unsigned)(Rb * K + C) * 2u; }
    const size_t kstep = (size_t)(BK * 2);
    const size_t hstep = (size_t)HALF * K * 2;
    const size_t tstep = 2 * hstep;
    const unsigned ldsw = (unsigned)wid * 1024u;
    const int aoff = lds_byte(wr * 64 + fr, fq * 8), boff = lds_byte(wc * 32 + fr, fq * 8);
#define PG8_SA(b, h) (((b) * 2 + (h)) * HTB)
#define PG8_SB(b, h) ((4 + (b) * 2 + (h)) * HTB)
#define PG8_STAGE(bufoff, gbase, voff) do { _Pragma("unroll") for (int _i = 0; _i < 2; ++_i) \
        __builtin_amdgcn_global_load_lds((const unsigned*)((const char*)(gbase) + (voff)[_i]), (PG8_LAS unsigned*)(lds + (bufoff) + ldsw + _i * 8192), 16, 0, 0); } while (0)
#define PG8_LDA(dst, b, h) do { _Pragma("unroll") for (int m = 0; m < 4; ++m) _Pragma("unroll") for (int k = 0; k < 2; ++k) dst[m][k] = *(const PG8_LAS bf16x8*)(lds + PG8_SA(b, h) + aoff + m * 2048 + k * 1024); } while (0)
#define PG8_LDB(dst, b, h) do { _Pragma("unroll") for (int n = 0; n < 2; ++n) _Pragma("unroll") for (int k = 0; k < 2; ++k) dst[n][k] = *(const PG8_LAS bf16x8*)(lds + PG8_SB(b, h) + boff + n * 2048 + k * 1024); } while (0)
#define PG8_MMA(ai, bj, At, Bt) do { __builtin_amdgcn_s_setprio(1); _Pragma("unroll") for (int m = 0; m < 4; ++m) _Pragma("unroll") for (int n = 0; n < 2; ++n) _Pragma("unroll") for (int k = 0; k < 2; ++k) \
        acc[ai][bj][m][n] = __builtin_amdgcn_mfma_f32_16x16x32_bf16(Bt[n][k], At[m][k], acc[ai][bj][m][n], 0, 0, 0); __builtin_amdgcn_s_setprio(0); } while (0)
#define PG8_WAIT_V(n) asm volatile("s_waitcnt vmcnt(" #n ")" ::: "memory")
#define PG8_WAIT_L(n) asm volatile("s_waitcnt lgkmcnt(" #n ")" ::: "memory")
#define PG8_BAR __builtin_amdgcn_s_barrier()
#define PG8_SCHED __builtin_amdgcn_sched_barrier(0)
    Unit cur, nxt; int ui = 0;
    if (!S.next(0, cur)) return;
    f32x4 acc[2][2][4][2];
#pragma unroll
    for (int a = 0; a < 2; ++a)
#pragma unroll
        for (int b = 0; b < 2; ++b)
#pragma unroll
            for (int m = 0; m < 4; ++m)
#pragma unroll
                for (int n = 0; n < 2; ++n) acc[a][b][m][n] = (f32x4){0.f, 0.f, 0.f, 0.f};
    bf16x8 At[4][2], B0[2][2], B1[2][2];
    const char* cA = (const char*)g.A + (size_t)cur.pm * tstep; const char* cB = (const char*)g.Bt + (size_t)cur.pn * tstep;
    S.a_ready(cur);
    if constexpr (SP2) {
        PG8_STAGE(PG8_SB(0, 0), cB, voffB); PG8_STAGE(PG8_SB(0, 1), cB + hstep, voffB); PG8_STAGE(PG8_SA(0, 0), cA, voffA); PG8_STAGE(PG8_SA(0, 1), cA + hstep, voffA);
        if (wr == 1) PG8_BAR;
        PG8_WAIT_V(2); PG8_BAR;
        PG8_STAGE(PG8_SB(1, 0), cB + kstep, voffB); PG8_STAGE(PG8_SA(1, 0), cA + kstep, voffA); PG8_STAGE(PG8_SB(1, 1), cB + hstep + kstep, voffB);
        PG8_WAIT_V(6); PG8_BAR;
    } else {
        PG8_STAGE(PG8_SB(0, 0), cB, voffB); PG8_STAGE(PG8_SA(0, 0), cA, voffA); PG8_STAGE(PG8_SB(0, 1), cB + hstep, voffB); PG8_STAGE(PG8_SA(0, 1), cA + hstep, voffA);
        if (wr == 1) PG8_BAR;
        PG8_WAIT_V(4); PG8_BAR;
        PG8_STAGE(PG8_SB(1, 0), cB + kstep, voffB); PG8_STAGE(PG8_SA(1, 0), cA + kstep, voffA); PG8_STAGE(PG8_SB(1, 1), cB + hstep + kstep, voffB);
        PG8_WAIT_V(6); PG8_BAR;
    }
    for (;;) {
        const bool has_next = S.next(ui + 1, nxt);
        const char* nA = has_next ? (const char*)g.A + (size_t)nxt.pm * tstep : cA; const char* nB = has_next ? (const char*)g.Bt + (size_t)nxt.pn * tstep : cB;
        for (int t = 0; t < nt; t += 2) {
            const bool last = (t == nt - 2);
            const char* a1 = cA + (size_t)(t + 1) * kstep;
            const char* a2 = last ? nA : cA + (size_t)(t + 2) * kstep; const char* b2 = last ? nB : cB + (size_t)(t + 2) * kstep;
            const char* a3 = a2 + kstep; const char* b3 = b2 + kstep;
            if (last && has_next) S.a_ready(nxt);
            if constexpr (SP2) {
            PG8_LDB(B0, 0, 0); PG8_LDB(B1, 0, 1); PG8_SCHED; PG8_LDA(At, 0, 0); PG8_STAGE(PG8_SA(1, 1), a1 + hstep, voffA);
            PG8_WAIT_V(8); PG8_WAIT_L(0); PG8_BAR; PG8_MMA(0, 0, At, B0); PG8_MMA(0, 1, At, B1); PG8_BAR; PG8_SCHED;
            PG8_LDA(At, 0, 1); PG8_STAGE(PG8_SB(0, 0), b2, voffB); PG8_STAGE(PG8_SB(0, 1), b2 + hstep, voffB); PG8_STAGE(PG8_SA(0, 0), a2, voffA);
            PG8_WAIT_V(8); PG8_WAIT_L(0); PG8_BAR; PG8_MMA(1, 0, At, B0); PG8_MMA(1, 1, At, B1); PG8_BAR; PG8_SCHED;
            PG8_LDB(B0, 1, 0); PG8_LDB(B1, 1, 1); PG8_SCHED; PG8_LDA(At, 1, 0); PG8_STAGE(PG8_SA(0, 1), a2 + hstep, voffA);
            PG8_WAIT_V(8); PG8_WAIT_L(0); PG8_BAR; PG8_MMA(0, 0, At, B0); PG8_MMA(0, 1, At, B1); PG8_BAR; PG8_SCHED;
            PG8_LDA(At, 1, 1); PG8_STAGE(PG8_SB(1, 0), b3, voffB); PG8_STAGE(PG8_SB(1, 1), b3 + hstep, voffB); PG8_STAGE(PG8_SA(1, 0), a3, voffA);
            PG8_WAIT_V(8); PG8_WAIT_L(0); PG8_BAR; PG8_MMA(1, 0, At, B0); PG8_MMA(1, 1, At, B1); PG8_BAR; PG8_SCHED;
            } else {
            PG8_LDB(B0, 0, 0); PG8_SCHED; PG8_LDA(At, 0, 0); PG8_STAGE(PG8_SA(1, 1), a1 + hstep, voffA);
            PG8_WAIT_L(8); PG8_BAR; PG8_WAIT_L(0); PG8_MMA(0, 0, At, B0); PG8_BAR; PG8_SCHED;
            PG8_LDB(B1, 0, 1); PG8_STAGE(PG8_SB(0, 0), b2, voffB);
            PG8_BAR; PG8_WAIT_L(0); PG8_MMA(0, 1, At, B1); PG8_BAR;
            PG8_LDA(At, 0, 1); PG8_STAGE(PG8_SA(0, 0), a2, voffA);
            PG8_BAR; PG8_WAIT_L(0); PG8_MMA(1, 0, At, B0); PG8_BAR; PG8_SCHED;
            PG8_STAGE(PG8_SB(0, 1), b2 + hstep, voffB);
            PG8_WAIT_V(6); PG8_BAR; PG8_MMA(1, 1, At, B1); PG8_BAR;
            PG8_LDB(B0, 1, 0); PG8_SCHED; PG8_LDA(At, 1, 0); PG8_STAGE(PG8_SA(0, 1), a2 + hstep, voffA);
            PG8_WAIT_L(8); PG8_BAR; PG8_WAIT_L(0); PG8_MMA(0, 0, At, B0); PG8_BAR; PG8_SCHED;
            PG8_LDB(B1, 1, 1); PG8_STAGE(PG8_SB(1, 0), b3, voffB);
            PG8_BAR; PG8_WAIT_L(0); PG8_MMA(0, 1, At, B1); PG8_BAR;
            PG8_LDA(At, 1, 1); PG8_STAGE(PG8_SA(1, 0), a3, voffA);
            PG8_BAR; PG8_WAIT_L(0); PG8_MMA(1, 0, At, B0); PG8_BAR; PG8_SCHED;
            PG8_STAGE(PG8_SB(1, 1), b3 + hstep, voffB);
            PG8_WAIT_V(6); PG8_BAR; PG8_MMA(1, 1, At, B1); PG8_BAR;
            }
        }
        if constexpr (ALIGN_EPI) { if (wr == 0) PG8_BAR; }
        if constexpr (!Epi::AFTER_DRAIN) { E(acc, cur, wr, wc, fr, fq); S.done(cur); }
        if (!has_next) break;
#pragma unroll
        for (int a = 0; a < 2; ++a)
#pragma unroll
            for (int b = 0; b < 2; ++b)
#pragma unroll
                for (int m = 0; m < 4; ++m)
#pragma unroll
                    for (int n = 0; n < 2; ++n) acc[a][b][m][n] = (f32x4){0.f, 0.f, 0.f, 0.f};
        cur = nxt; cA = nA; cB = nB; ++ui;
        if constexpr (ALIGN_EPI) { if (wr == 1) PG8_BAR; }
    }
    PG8_WAIT_V(0);
    if constexpr (!ALIGN_EPI) { if (wr == 0) PG8_BAR; }
    PG8_BAR;
    if constexpr (Epi::AFTER_DRAIN) { E.fused(acc, cur, wr, wc, fr, fq, lds, wid, lane); S.done(cur); }
#undef PG8_SA
#undef PG8_SB
#undef PG8_STAGE
#undef PG8_LDA
#undef PG8_LDB
#undef PG8_MMA
#undef PG8_WAIT_V
#undef PG8_WAIT_L
#undef PG8_BAR
#undef PG8_SCHED
}
}

#define LAS __attribute__((address_space(3)))
typedef unsigned short bf16_t;
typedef short bf16x8 __attribute__((ext_vector_type(8)));
typedef float f32x4 __attribute__((ext_vector_type(4)));
typedef float f32x16 __attribute__((ext_vector_type(16)));
typedef unsigned u32x4 __attribute__((ext_vector_type(4)));
typedef unsigned u32x2 __attribute__((ext_vector_type(2)));

constexpr int NB = 2, SEQ = 8192, MTOK = NB * SEQ, DM = 1024, NZ = 3600, NZP = 3840, DEPTH = 2;
constexpr int C_QA = 0, C_KA = 256, C_VA = 512, C_GA = 768, C_QB = 1024, C_KB = 1280, C_VB = 1536, C_GB = 1792;
constexpr int C_CA = 2048, C_CG = 2304, C_GC = 2560, C_QD = 2816, C_KD = 2944, C_VD = 3072, C_LR = 3328, C_GD = 3344;
constexpr float EPS = 1e-6f, LOG2E = 1.4426950408889634f, QSCALE = 0.125f * LOG2E;
constexpr int NTHR = 512, NWAVES = 8;
constexpr int LDS_BYTES = 155648;

#ifndef REP_PHASE
#define REP_PHASE -1
#endif
#ifndef N_LAUNCH_MODE
#define N_LAUNCH_MODE 1
#endif

constexpr size_t MiB = 1u << 20;
constexpr size_t WS_CTL = 0, CTL_ZERO_BYTES = 1 * MiB;
constexpr size_t WS_SSQ0 = 256 * 1024, WS_SSQ1 = 384 * 1024;
constexpr size_t WS_KM = 512 * 1024;
constexpr size_t WS_WIN = 1 * MiB;
constexpr size_t WIN_L = (size_t)NZP * DM * 2;
constexpr size_t WS_WOUT = 16 * MiB;
constexpr size_t WOUT_L = (size_t)DM * DM * 2;
constexpr size_t WS_WPW = 20 * MiB;
constexpr size_t WPW_L = 256 * 256 * 2;
constexpr size_t WS_BL = 20 * MiB + 768 * 1024;
constexpr size_t WS_DST = 21 * MiB;
constexpr size_t WS_KV = 23 * MiB;
constexpr size_t WS_PO = 32 * MiB;
constexpr size_t WS_H = 64 * MiB;
constexpr size_t WS_CC = 96 * MiB;
constexpr size_t WS_Z = 128 * MiB;
constexpr size_t WS_LIST = 248 * MiB;
constexpr size_t WS_END = 256 * MiB;
constexpr int C_DO = C_CA;
constexpr int C_PS = NZ;

__device__ __forceinline__ float bf2f(unsigned v) { return __uint_as_float(v << 16); }
typedef float f32x2c_t __attribute__((ext_vector_type(2))); typedef __bf16 bf16x2c_t __attribute__((ext_vector_type(2)));
__device__ __forceinline__ unsigned cvtpk_(float lo, float hi) { f32x2c_t v = {lo, hi}; bf16x2c_t b = __builtin_convertvector(v, bf16x2c_t); return __builtin_bit_cast(unsigned, b); }
__device__ __forceinline__ unsigned pk2(float lo, float hi) { return cvtpk_(lo, hi); }
__device__ __forceinline__ unsigned f2bf(float f) { return cvtpk_(f, 0.f) & 0xffffu; }
__device__ __forceinline__ void unpack8(const u32x4 a, float (&x)[8]) {
#pragma unroll
    for (int k = 0; k < 4; ++k) { x[2 * k] = bf2f(a[k] & 0xffffu); x[2 * k + 1] = bf2f(a[k] >> 16); }
}
__device__ __forceinline__ float wave_sum(float v) {
    return wave64_sum(v);
}
__device__ __forceinline__ float sigmoidf_(float x) { return __builtin_amdgcn_rcpf(1.0f + __expf(-x)); }
__device__ __forceinline__ float siluf_(float x) { return x * __builtin_amdgcn_rcpf(1.0f + __expf(-x)); }
__device__ __forceinline__ float logsigmoidf_(float x) { return x < 0.f ? x - log1pf(__expf(x)) : -log1pf(__expf(-x)); }
__device__ __forceinline__ int crow(int r, int hi) { return (r & 3) + 8 * (r >> 2) + 4 * hi; }
__device__ __forceinline__ float ex2(float x) { return __builtin_amdgcn_exp2f(x); }


struct LayerP {
    const float *norm_g, *qga, *kga, *qgb, *kgb, *conv_w, *conv_b, *ln_g, *ln_b, *pw_b, *gate_w, *gate_b, *gla_g;
    const bf16_t *WinT, *WoutT, *WpwT;
    const float* xin; float* xout;
};
struct Frame {
    LAS unsigned char* lds;
    int tid, lane, wave, G, bid;
    unsigned* ctl;
    bf16_t *H, *Z, *CC, *DOp, *PO; float *KMP, *BL, *DST, *KV, *PS; unsigned* LIST;
};

__device__ __forceinline__ void transpose_item(const float* W, int K, int N, int NPb, bf16_t* WT, LAS float* scr, int item, int lane, const float* kscale = nullptr) {
    const int nblk = NPb, kb = item / nblk, nb = item % nblk, k0 = 64 * kb, n0 = 32 * nb;
    const int nn = n0 + (lane & 31);
    float wv[32];
#pragma unroll
    for (int i = 0; i < 32; ++i) { const int kk = 2 * i + (lane >> 5); wv[i] = (nn < N) ? __builtin_nontemporal_load(W + (size_t)(k0 + kk) * N + nn) : 0.f; }
    if (kscale) {
#pragma unroll
        for (int i = 0; i < 32; ++i) wv[i] *= kscale[k0 + 2 * i + (lane >> 5)]; }
#pragma unroll
    for (int i = 0; i < 32; ++i) scr[(2 * i + (lane >> 5)) * 33 + (lane & 31)] = wv[i];
    asm volatile("s_waitcnt lgkmcnt(0)" ::: "memory");
    const int c = lane & 7;
#pragma unroll
    for (int j = 0; j < 4; ++j) { const int n = (lane >> 3) + 8 * j; const LAS float* s = scr + (8 * c) * 33 + n;
        u32x4 o; o.x = pk2(s[0 * 33], s[1 * 33]); o.y = pk2(s[2 * 33], s[3 * 33]); o.z = pk2(s[4 * 33], s[5 * 33]); o.w = pk2(s[6 * 33], s[7 * 33]);
        *(u32x4*)(WT + (size_t)(n0 + n) * K + k0 + 8 * c) = o; }
    asm volatile("s_waitcnt lgkmcnt(0)" ::: "memory");
}
__device__ __forceinline__ void cvt_row(const float* xrow, bf16_t* orow, float* ssq_out, int lane) {
    const f32x4* xr = (const f32x4*)xrow + lane;
    f32x4 v[4]; float s = 0.f;
#pragma unroll
    for (int j = 0; j < 4; ++j) { v[j] = xr[64 * j]; s += (v[j].x * v[j].x + v[j].y * v[j].y) + (v[j].z * v[j].z + v[j].w * v[j].w); }
    unsigned long long* o8 = (unsigned long long*)orow + lane;
#pragma unroll
    for (int j = 0; j < 4; ++j) o8[64 * j] = (unsigned long long)pk2(v[j].x, v[j].y) | ((unsigned long long)pk2(v[j].z, v[j].w) << 32);
    s = wave_sum(s);
    if (lane == 0) *ssq_out = s;
}

__device__ __forceinline__ void cvt_row2(const float* xrow, bf16_t* orow, float* ssq_out, size_t rstride, int lane) {
    f32x4 v[2][4];
#pragma unroll
    for (int t = 0; t < 2; ++t)
#pragma unroll
        for (int j = 0; j < 4; ++j) v[t][j] = __builtin_nontemporal_load((const f32x4*)(xrow + t * rstride * DM) + lane + 64 * j);
#pragma unroll
    for (int t = 0; t < 2; ++t) { float s = 0.f;
        unsigned long long* o8 = (unsigned long long*)(orow + t * rstride * DM) + lane;
#pragma unroll
        for (int j = 0; j < 4; ++j) { s += (v[t][j].x * v[t][j].x + v[t][j].y * v[t][j].y) + (v[t][j].z * v[t][j].z + v[t][j].w * v[t][j].w);
            o8[64 * j] = (unsigned long long)pk2(v[t][j].x, v[t][j].y) | ((unsigned long long)pk2(v[t][j].z, v[t][j].w) << 32); }
        s = wave_sum(s);
        if (lane == 0) ssq_out[t * rstride] = s; }
}

__device__ __forceinline__ float logsigmoid_fast(float x) { return fminf(x, 0.f) - __logf(1.0f + __expf(-fabsf(x))); }
constexpr int GL_BC = 0;
constexpr int GL_V = 64 * 132;
constexpr int GL_LR = GL_V + 64 * 260;
constexpr int GL_TOT = GL_LR + 64 * 20;
constexpr int GL_END = GL_TOT + 512;
static_assert(GL_END * 4 <= 140 * 1024, "GLA LDS");

__device__ __forceinline__ void gla_kv_item(const Frame& F, const LayerP& P, int it) {
    LAS float* S = (LAS float*)F.lds; LAS float* bcS = S + GL_BC; LAS float* vS = S + GL_V; LAS float* lrS = S + GL_LR; LAS float* totS = S + GL_TOT;
    const int m0 = it * 64, tid = F.tid, lane = F.lane;
    unsigned lrv; { const int idx = tid * 2, row = idx >> 4, c = idx & 15; lrv = *(const unsigned*)(F.Z + (size_t)(m0 + row) * NZP + C_LR + c); }
    const int cc = tid & 127, jg = tid >> 7;
    float wv[16];
#pragma unroll
    for (int r = 0; r < 16; ++r) wv[r] = P.gate_w[r * 128 + cc];
    const float bias = P.gate_b[cc];
    u32x4 qx[2], kx[2], vx[4];
#pragma unroll
    for (int i = 0; i < 2; ++i) { const int q = tid + 512 * i, j = q >> 4, c8 = q & 15; const bf16_t* zr = F.Z + (size_t)(m0 + j) * NZP + 8 * c8;
        qx[i] = *(const u32x4*)(zr + C_QD); kx[i] = *(const u32x4*)(zr + C_KD); }
#pragma unroll
    for (int i = 0; i < 4; ++i) { const int q = tid + 512 * i, j = q >> 5, c8 = q & 31; vx[i] = *(const u32x4*)(F.Z + (size_t)(m0 + j) * NZP + C_VD + 8 * c8); }
    __syncthreads();
    { const int idx = tid * 2, row = idx >> 4, c = idx & 15; lrS[row * 20 + c] = bf2f(lrv & 0xffffu); lrS[row * 20 + c + 1] = bf2f(lrv >> 16); }
#pragma unroll
    for (int i = 0; i < 4; ++i) { const int q = tid + 512 * i, j = q >> 5, c8 = q & 31; float x[8]; unpack8(vx[i], x);
        *(LAS f32x4*)(vS + j * 260 + 8 * c8) = (f32x4){x[0], x[1], x[2], x[3]}; *(LAS f32x4*)(vS + j * 260 + 8 * c8 + 4) = (f32x4){x[4], x[5], x[6], x[7]}; }
    __syncthreads();
    float loc[16]; float run = 0.f;
#pragma unroll
    for (int i = 0; i < 16; ++i) { const int j = jg * 16 + i; float x = bias;
#pragma unroll
        for (int r4 = 0; r4 < 4; ++r4) { const f32x4 lv = *(const LAS f32x4*)(lrS + j * 20 + 4 * r4);
            x += lv.x * wv[4 * r4] + lv.y * wv[4 * r4 + 1] + lv.z * wv[4 * r4 + 2] + lv.w * wv[4 * r4 + 3]; }
        run += logsigmoid_fast(x) * (1.0f / 16.0f); loc[i] = run; }
    totS[jg * 128 + cc] = run;
    __syncthreads();
    float off = 0.f;
    for (int gg = 0; gg < jg; ++gg) off += totS[gg * 128 + cc];
#pragma unroll
    for (int i = 0; i < 16; ++i) bcS[(jg * 16 + i) * 132 + cc] = off + loc[i];
    __syncthreads();
    float eb[2][8];
#pragma unroll
    for (int i = 0; i < 2; ++i) { const int c8 = (tid + 512 * i) & 15;
#pragma unroll
        for (int e = 0; e < 8; ++e) eb[i][e] = __expf(bcS[63 * 132 + 8 * c8 + e]); }
    if (tid < 128) F.BL[(size_t)it * 128 + tid] = bcS[63 * 132 + tid];
    __syncthreads();
#pragma unroll
    for (int i = 0; i < 2; ++i) { const int q = tid + 512 * i, j = q >> 4, c8 = q & 15; float xq[8], xk[8], yq[8], yk[8]; unpack8(qx[i], xq); unpack8(kx[i], xk);
        const f32x4 b0 = *(const LAS f32x4*)(bcS + j * 132 + 8 * c8), b1 = *(const LAS f32x4*)(bcS + j * 132 + 8 * c8 + 4);
        const float bcv[8] = {b0.x, b0.y, b0.z, b0.w, b1.x, b1.y, b1.z, b1.w}; float kh[8];
#pragma unroll
        for (int e = 0; e < 8; ++e) { const float e1 = __expf(bcv[e]), e2 = __builtin_amdgcn_rcpf(e1);
            yq[e] = xq[e] * 0.17677669529663687f * e1; yk[e] = xk[e] * e2;
            kh[e] = xk[e] * (eb[i][e] * e2); }
        *(LAS f32x4*)(bcS + j * 132 + 8 * c8) = (f32x4){kh[0], kh[1], kh[2], kh[3]}; *(LAS f32x4*)(bcS + j * 132 + 8 * c8 + 4) = (f32x4){kh[4], kh[5], kh[6], kh[7]};
        bf16_t* zr = F.Z + (size_t)(m0 + j) * NZP + 8 * c8;
        u32x4 o; o.x = pk2(yq[0], yq[1]); o.y = pk2(yq[2], yq[3]); o.z = pk2(yq[4], yq[5]); o.w = pk2(yq[6], yq[7]); *(u32x4*)(zr + C_QD) = o;
        o.x = pk2(yk[0], yk[1]); o.y = pk2(yk[2], yk[3]); o.z = pk2(yk[4], yk[5]); o.w = pk2(yk[6], yk[7]); *(u32x4*)(zr + C_KD) = o; }
    __syncthreads();
    const int h = F.wave >> 1, vh = F.wave & 1;
    f32x16 acc;
#pragma unroll
    for (int r = 0; r < 16; ++r) acc[r] = 0.f;
#pragma unroll 8
    for (int s = 0; s < 32; ++s) { const int ja = 2 * s + (lane >> 5);
        const float a = bcS[ja * 132 + h * 32 + (lane & 31)];
        const float b = vS[ja * 260 + h * 64 + 32 * vh + (lane & 31)];
        acc = __builtin_amdgcn_mfma_f32_32x32x2f32(a, b, acc, 0, 0, 0); }
    float* kvp = F.KV + ((size_t)it * 4 + h) * 2048;
#pragma unroll
    for (int r = 0; r < 16; ++r) { const int d = crow(r, lane >> 5); kvp[d * 64 + 32 * vh + (lane & 31)] = acc[r]; }
}

constexpr int GO_Q = 0;
constexpr int GO_K = 64 * 136 * 2;
constexpr int GO_VT = 2 * 64 * 136 * 2;
constexpr int GO_OUT = GO_VT + 256 * 72 * 2;
static_assert(GO_OUT + 64 * 260 * 4 <= 140 * 1024, "GLA out LDS");
__device__ __forceinline__ void gla_out_item(const Frame& F, const LayerP& P, int it) {
    LAS bf16_t* QtS = (LAS bf16_t*)(F.lds + GO_Q); LAS bf16_t* KtS = (LAS bf16_t*)(F.lds + GO_K); LAS bf16_t* VT = (LAS bf16_t*)(F.lds + GO_VT); LAS float* oS = (LAS float*)(F.lds + GO_OUT);
    const int m0 = it * 64, tid = F.tid, lane = F.lane, hf = lane >> 5, l31 = lane & 31;
    const int h = F.wave >> 1, ih = F.wave & 1;
    u32x4 qx[2], kx[2], vx[2][2], gx[4];
#pragma unroll
    for (int i = 0; i < 2; ++i) { const int q = tid + 512 * i, j = q >> 4, c8 = q & 15; const bf16_t* zr = F.Z + (size_t)(m0 + j) * NZP + 8 * c8;
        qx[i] = *(const u32x4*)(zr + C_QD); kx[i] = *(const u32x4*)(zr + C_KD); }
#pragma unroll
    for (int i = 0; i < 2; ++i) { const int q = tid + 512 * i, rp = q & 31, c8 = q >> 5; const bf16_t* zr = F.Z + (size_t)(m0 + 2 * rp) * NZP + C_VD + 8 * c8;
        vx[i][0] = *(const u32x4*)zr; vx[i][1] = *(const u32x4*)(zr + NZP); }
#pragma unroll
    for (int i = 0; i < 4; ++i) { const int q = tid + 512 * i, j = q >> 5, c8 = q & 31; gx[i] = *(const u32x4*)(F.Z + (size_t)(m0 + j) * NZP + C_GD + 8 * c8); }
    float sta[2][2][8];
    { const float* st = F.KV + ((size_t)it * 4 + h) * 2048;
#pragma unroll
      for (int vt = 0; vt < 2; ++vt)
#pragma unroll
          for (int s = 0; s < 2; ++s)
#pragma unroll
              for (int jj = 0; jj < 8; ++jj) sta[vt][s][jj] = st[(16 * s + 8 * hf + jj) * 64 + 32 * vt + l31]; }
    float gn[2][16];
#pragma unroll
    for (int vt = 0; vt < 2; ++vt)
#pragma unroll
        for (int r = 0; r < 16; ++r) gn[vt][r] = P.gla_g[32 * vt + crow(r, hf)];
    __syncthreads();
#pragma unroll
    for (int i = 0; i < 2; ++i) { const int q = tid + 512 * i, j = q >> 4, c8 = q & 15;
        *(LAS u32x4*)(QtS + j * 136 + 8 * c8) = qx[i]; *(LAS u32x4*)(KtS + j * 136 + 8 * c8) = kx[i]; }
#pragma unroll
    for (int i = 0; i < 2; ++i) { const int q = tid + 512 * i, rp = q & 31, c8 = q >> 5;
#pragma unroll
        for (int k = 0; k < 4; ++k) { const unsigned a = vx[i][0][k], b = vx[i][1][k];
            *(LAS unsigned*)(VT + (8 * c8 + 2 * k) * 72 + 2 * rp) = (a & 0xffffu) | (b << 16);
            *(LAS unsigned*)(VT + (8 * c8 + 2 * k + 1) * 72 + 2 * rp) = (a >> 16) | (b & 0xffff0000u); } }
    __syncthreads();
    bf16x8 qB[2];
#pragma unroll
    for (int s = 0; s < 2; ++s) qB[s] = *(const LAS bf16x8*)(QtS + (32 * ih + l31) * 136 + h * 32 + 16 * s + 8 * hf);
    f32x16 aT[2];
#pragma unroll
    for (int jt = 0; jt < 2; ++jt) {
#pragma unroll
        for (int r = 0; r < 16; ++r) aT[jt][r] = 0.f;
        if (jt <= ih) {
#pragma unroll
            for (int s = 0; s < 2; ++s) { const bf16x8 a = *(const LAS bf16x8*)(KtS + (32 * jt + l31) * 136 + h * 32 + 16 * s + 8 * hf);
                aT[jt] = __builtin_amdgcn_mfma_f32_32x32x16_bf16(a, qB[s], aT[jt], 0, 0, 0); }
#pragma unroll
            for (int r = 0; r < 16; ++r) { const int j = 32 * jt + crow(r, hf), i = 32 * ih + l31; if (j > i) aT[jt][r] = 0.f; }
        }
    }
    f32x16 oT[2];
#pragma unroll
    for (int vt = 0; vt < 2; ++vt) {
#pragma unroll
        for (int r = 0; r < 16; ++r) oT[vt][r] = 0.f;
#pragma unroll
        for (int s = 0; s < 2; ++s) { u32x4 sw; sw.x = cvtpk_(sta[vt][s][0], sta[vt][s][1]); sw.y = cvtpk_(sta[vt][s][2], sta[vt][s][3]); sw.z = cvtpk_(sta[vt][s][4], sta[vt][s][5]); sw.w = cvtpk_(sta[vt][s][6], sta[vt][s][7]);
            oT[vt] = __builtin_amdgcn_mfma_f32_32x32x16_bf16(__builtin_bit_cast(bf16x8, sw), qB[s], oT[vt], 0, 0, 0); }
#pragma unroll
        for (int jt = 0; jt < 2; ++jt) {
            if (jt <= ih) {
#pragma unroll
                for (int s = 0; s < 2; ++s) {
                    u32x4 pw; pw.x = cvtpk_(aT[jt][8 * s + 0], aT[jt][8 * s + 1]); pw.y = cvtpk_(aT[jt][8 * s + 2], aT[jt][8 * s + 3]); pw.z = cvtpk_(aT[jt][8 * s + 4], aT[jt][8 * s + 5]); pw.w = cvtpk_(aT[jt][8 * s + 6], aT[jt][8 * s + 7]);
                    const LAS bf16_t* vp = VT + (h * 64 + 32 * vt + l31) * 72 + 32 * jt + 16 * s + 4 * hf;
                    const u32x2 v0 = *(const LAS u32x2*)vp, v1 = *(const LAS u32x2*)(vp + 8);
                    u32x4 vv; vv.x = v0.x; vv.y = v0.y; vv.z = v1.x; vv.w = v1.y;
                    oT[vt] = __builtin_amdgcn_mfma_f32_32x32x16_bf16(__builtin_bit_cast(bf16x8, vv), __builtin_bit_cast(bf16x8, pw), oT[vt], 0, 0, 0); }
            }
        }
    }
    float ss = 0.f;
#pragma unroll
    for (int vt = 0; vt < 2; ++vt)
#pragma unroll
        for (int r = 0; r < 16; ++r) ss += oT[vt][r] * oT[vt][r];
    ss = xor32_sum(ss);
    const float rinv = __builtin_amdgcn_rsqf(ss * (1.0f / 64.0f) + EPS);
#pragma unroll
    for (int vt = 0; vt < 2; ++vt)
#pragma unroll
        for (int r = 0; r < 16; ++r) oS[(32 * ih + l31) * 260 + h * 64 + 32 * vt + crow(r, hf)] = (oT[vt][r] * rinv) * gn[vt][r];
    __syncthreads();
#pragma unroll
    for (int i = 0; i < 4; ++i) { const int q = tid + 512 * i, j = q >> 5, c8 = q & 31; float gg[8]; unpack8(gx[i], gg); float y[8];
        const f32x4 t0 = *(const LAS f32x4*)(oS + j * 260 + 8 * c8), t1 = *(const LAS f32x4*)(oS + j * 260 + 8 * c8 + 4); const float tv[8] = {t0.x, t0.y, t0.z, t0.w, t1.x, t1.y, t1.z, t1.w};
#pragma unroll
        for (int e = 0; e < 8; ++e) y[e] = tv[e] * siluf_(gg[e]);
        u32x4 o; o.x = pk2(y[0], y[1]); o.y = pk2(y[2], y[3]); o.z = pk2(y[4], y[5]); o.w = pk2(y[6], y[7]);
        *(u32x4*)(F.CC + (size_t)(m0 + j) * DM + 768 + 8 * c8) = o; }
}

constexpr int CV_U = 0;
constexpr int CV_A = 94 * 256 * 4;
static_assert(CV_A + 64 * 264 * 2 <= 140 * 1024, "conv LDS");
__device__ __forceinline__ void conv_item(const Frame& F, const LayerP& P, int it) {
    LAS float* uS = (LAS float*)F.lds; LAS bf16_t* aS = (LAS bf16_t*)(F.lds + CV_A);
    const int tid = F.tid, lane = F.lane, w = F.wave;
    const int b = it >> 7, t0 = (it & 127) * 64, m0 = it * 64;
    u32x4 ua[6], ug[6];
#pragma unroll
    for (int i = 0; i < 6; ++i) { const int q = tid + 512 * i, r = q >> 5, c8 = q & 31, tt = t0 - 30 + r;
        ua[i] = (u32x4){0u, 0u, 0u, 0u}; ug[i] = (u32x4){0u, 0u, 0u, 0u};
        if (q < 94 * 32 && tt >= 0) { const bf16_t* zr = F.Z + (size_t)(b * SEQ + tt) * NZP + 8 * c8; ua[i] = *(const u32x4*)(zr + C_CA); ug[i] = *(const u32x4*)(zr + C_CG); } }
    typedef float f32x2v __attribute__((ext_vector_type(2)));
    const int cp = tid & 127, tq = tid >> 7;

    __syncthreads();
#pragma unroll
    for (int i = 0; i < 6; ++i) { const int q = tid + 512 * i, r = q >> 5, c8 = q & 31;
        if (q < 94 * 32) { float xa[8], xg[8]; unpack8(ua[i], xa); unpack8(ug[i], xg);
#pragma unroll
            for (int e = 0; e < 8; ++e) xa[e] = xa[e] * sigmoidf_(xg[e]);
            *(LAS f32x4*)(uS + r * 256 + 8 * c8) = (f32x4){xa[0], xa[1], xa[2], xa[3]}; *(LAS f32x4*)(uS + r * 256 + 8 * c8 + 4) = (f32x4){xa[4], xa[5], xa[6], xa[7]}; } }
    __syncthreads();
    {
        f32x2v wk[31];
#pragma unroll
        for (int k = 0; k < 31; ++k) wk[k] = *(const f32x2v*)(P.conv_w + k * 256 + 2 * cp);
        const f32x2v cbias = *(const f32x2v*)(P.conv_b + 2 * cp);
#pragma nounroll
        for (int hh = 0; hh < 2; ++hh) { const int t0r = 16 * tq + 8 * hh;
            f32x2v u[38];
#pragma unroll
            for (int r = 0; r < 38; ++r) u[r] = *(const LAS f32x2v*)(uS + (t0r + r) * 256 + 2 * cp);
#pragma unroll
            for (int i = 0; i < 8; ++i) { f32x2v acc = wk[0] * u[i];
#pragma unroll
                for (int k = 1; k < 31; ++k) acc = __builtin_elementwise_fma(wk[k], u[i + k], acc);
                acc = acc + cbias;
                *(LAS unsigned*)(aS + (t0r + i) * 264 + 2 * cp) = pk2(acc.x, acc.y); } }
    }
    asm volatile("" ::: "memory"); __builtin_amdgcn_sched_barrier(0);
    const int n0 = 32 * w, fr = lane & 15, fq = lane >> 4;
    bf16x8 bfr[8][2];
#pragma unroll
    for (int ks = 0; ks < 8; ++ks)
#pragma unroll
        for (int nt = 0; nt < 2; ++nt) bfr[ks][nt] = *(const bf16x8*)(P.WpwT + (size_t)(n0 + 16 * nt + fr) * 256 + 32 * ks + 8 * fq);
    u32x4 gx[4];
#pragma unroll
    for (int i = 0; i < 4; ++i) { const int q = tid + 512 * i, j = q >> 5, c8 = q & 31; gx[i] = *(const u32x4*)(F.Z + (size_t)(m0 + j) * NZP + C_GC + 8 * c8); }
    float lg[4], lb[4];
#pragma unroll
    for (int j = 0; j < 4; ++j) { lg[j] = P.ln_g[lane + 64 * j]; lb[j] = P.ln_b[lane + 64 * j]; }
    __syncthreads();
#pragma unroll 2
    for (int i = 0; i < 8; ++i) { const int row = 8 * w + i;
        float x[4]; float s = 0.f;
#pragma unroll
        for (int j = 0; j < 4; ++j) { x[j] = bf2f(aS[row * 264 + lane + 64 * j]); s += x[j]; }
        const float mean = wave_sum(s) * (1.0f / 256.0f); float s2 = 0.f;
#pragma unroll
        for (int j = 0; j < 4; ++j) { x[j] -= mean; s2 += x[j] * x[j]; }
        const float rstd = __builtin_amdgcn_rsqf(wave_sum(s2) * (1.0f / 256.0f) + EPS);
#pragma unroll
        for (int j = 0; j < 4; ++j) { const float un = (x[j] * rstd) * lg[j] + lb[j];
            aS[row * 264 + lane + 64 * j] = (bf16_t)f2bf(siluf_(un)); } }
    __syncthreads();
    f32x4 acc[4][2];
#pragma unroll
    for (int m = 0; m < 4; ++m)
#pragma unroll
        for (int nt = 0; nt < 2; ++nt) acc[m][nt] = (f32x4){0.f, 0.f, 0.f, 0.f};
#pragma unroll
    for (int ks = 0; ks < 8; ++ks) {
#pragma unroll
        for (int m = 0; m < 4; ++m) { const bf16x8 af = *(const LAS bf16x8*)(aS + (16 * m + fr) * 264 + 32 * ks + 8 * fq);
#pragma unroll
            for (int nt = 0; nt < 2; ++nt) acc[m][nt] = __builtin_amdgcn_mfma_f32_16x16x32_bf16(af, bfr[ks][nt], acc[m][nt], 0, 0, 0); } }
#pragma unroll
    for (int m = 0; m < 4; ++m)
#pragma unroll
        for (int nt = 0; nt < 2; ++nt) { const int col = n0 + 16 * nt + fr; const float pb = P.pw_b[col];
#pragma unroll
            for (int r = 0; r < 4; ++r) uS[(16 * m + 4 * fq + r) * 260 + col] = acc[m][nt][r] + pb; }
    __syncthreads();
#pragma unroll
    for (int i = 0; i < 4; ++i) { const int q = tid + 512 * i, j = q >> 5, c8 = q & 31; float gg[8]; unpack8(gx[i], gg); float y[8];
        const f32x4 t0 = *(const LAS f32x4*)(uS + j * 260 + 8 * c8), t1 = *(const LAS f32x4*)(uS + j * 260 + 8 * c8 + 4); const float tv[8] = {t0.x, t0.y, t0.z, t0.w, t1.x, t1.y, t1.z, t1.w};
#pragma unroll
        for (int e = 0; e < 8; ++e) y[e] = tv[e] * siluf_(gg[e]);
        u32x4 o; o.x = pk2(y[0], y[1]); o.y = pk2(y[2], y[3]); o.z = pk2(y[4], y[5]); o.w = pk2(y[6], y[7]);
        *(u32x4*)(F.CC + (size_t)(m0 + j) * DM + 512 + 8 * c8) = o; }
}

typedef float f32x2_t __attribute__((ext_vector_type(2))); typedef __bf16 bf16x2_t __attribute__((ext_vector_type(2)));
__device__ __forceinline__ unsigned cvtpk(float lo, float hi) { f32x2_t v = {lo, hi}; bf16x2_t b = __builtin_convertvector(v, bf16x2_t); return __builtin_bit_cast(unsigned, b); }

struct AttnState { float m, l; f32x16 oT[2]; };
__device__ __forceinline__ void attn_init(AttnState& st) {
    st.m = -INFINITY; st.l = 0.f;
#pragma unroll
    for (int d0 = 0; d0 < 2; ++d0)
#pragma unroll
        for (int r = 0; r < 16; ++r) st.oT[d0][r] = 0.f;
}
__device__ __forceinline__ f32x16 attn_qk(const LAS bf16_t* Ks, int krow0, const bf16x8 (&qf)[4], const f32x16& cb, int l31, int hf) {
    f32x16 p = cb;
    bf16x8 a[4];
#pragma unroll
    for (int d0 = 0; d0 < 4; ++d0) a[d0] = *(const LAS bf16x8*)(Ks + (krow0 + l31) * 72 + 16 * d0 + 8 * hf);
    __builtin_amdgcn_s_setprio(1);
#pragma unroll
    for (int d0 = 0; d0 < 4; ++d0) p = __builtin_amdgcn_mfma_f32_32x32x16_bf16(a[d0], qf[d0], p, 0, 0, 0);
    __builtin_amdgcn_s_setprio(0);
    return p;
}
__device__ __forceinline__ float xhalf_max(float v) { const auto rr = __builtin_amdgcn_permlane32_swap(__float_as_uint(v), __float_as_uint(v), false, false); return fmaxf(__uint_as_float(rr[0]), __uint_as_float(rr[1])); }
__device__ __forceinline__ float xhalf_sum(float v) { const auto rr = __builtin_amdgcn_permlane32_swap(__float_as_uint(v), __float_as_uint(v), false, false); return __uint_as_float(rr[0]) + __uint_as_float(rr[1]); }
__device__ __forceinline__ void attn_softmax_pv(AttnState& st, f32x16 p, const LAS bf16_t* Vt, int vpitch, int kcol0, float coff, bool MASKED, int lo, int hi, int l31, int hf) {
    if (MASKED) {
#pragma unroll
        for (int r = 0; r < 16; ++r) { const int c = crow(r, hf); if (c < lo || c > hi) p[r] = -INFINITY; }
    }
    float mx = fmaxf(fmaxf(p[0], p[1]), p[2]);
#pragma unroll
    for (int r = 3; r < 15; r += 2) mx = fmaxf(fmaxf(mx, p[r]), p[r + 1]);
    mx = fmaxf(mx, p[15]);
    mx += coff;
    mx = xhalf_max(mx);
    if (__any(mx > st.m)) {
        const float mnew = fmaxf(st.m, mx);
        const float alpha = ex2(st.m - mnew);
        st.l *= alpha; st.m = mnew;
#pragma unroll
        for (int d0 = 0; d0 < 2; ++d0)
#pragma unroll
            for (int r = 0; r < 16; ++r) st.oT[d0][r] *= alpha;
    }
    const float c = coff - st.m;
    float ls = 0.f;
#pragma unroll
    for (int r = 0; r < 16; ++r) { p[r] = ex2(p[r] + c); ls += p[r]; }
    st.l += ls;
#pragma unroll
    for (int s = 0; s < 2; ++s) {
        u32x4 pw; pw.x = cvtpk(p[8 * s + 0], p[8 * s + 1]); pw.y = cvtpk(p[8 * s + 2], p[8 * s + 3]); pw.z = cvtpk(p[8 * s + 4], p[8 * s + 5]); pw.w = cvtpk(p[8 * s + 6], p[8 * s + 7]);
        const bf16x8 pb = __builtin_bit_cast(bf16x8, pw);
#pragma unroll
        for (int d0 = 0; d0 < 2; ++d0) {
            const LAS bf16_t* vp = Vt + (32 * d0 + l31) * vpitch + kcol0 + 16 * s + 4 * hf;
            const u32x2 v0 = *(const LAS u32x2*)vp, v1 = *(const LAS u32x2*)(vp + 8);
            u32x4 vv; vv.x = v0.x; vv.y = v0.y; vv.z = v1.x; vv.w = v1.y;
            st.oT[d0] = __builtin_amdgcn_mfma_f32_32x32x16_bf16(__builtin_bit_cast(bf16x8, vv), pb, st.oT[d0], 0, 0, 0); }
    }
}
struct TileP { int kk0; float coff; bool masked; int lo, hi; };
__device__ __forceinline__ void attn_pair(AttnState& st, const LAS bf16_t* Ks, const LAS bf16_t* Vt, int vpitch, const bf16x8 (&qf)[4], const f32x16& cb, const TileP A, const TileP B, int l31, int hf) {
    f32x16 pA = attn_qk(Ks, A.kk0, qf, cb, l31, hf);
    f32x16 pB = attn_qk(Ks, B.kk0, qf, cb, l31, hf);
    if (A.masked) {
#pragma unroll
        for (int r = 0; r < 16; ++r) { const int c = crow(r, hf); if (c < A.lo || c > A.hi) pA[r] = -INFINITY; }
    }
    if (B.masked) {
#pragma unroll
        for (int r = 0; r < 16; ++r) { const int c = crow(r, hf); if (c < B.lo || c > B.hi) pB[r] = -INFINITY; }
    }
    float ma = fmaxf(fmaxf(pA[0], pA[1]), pA[2]), mb = fmaxf(fmaxf(pB[0], pB[1]), pB[2]);
#pragma unroll
    for (int r = 3; r < 15; r += 2) { ma = fmaxf(fmaxf(ma, pA[r]), pA[r + 1]); mb = fmaxf(fmaxf(mb, pB[r]), pB[r + 1]); }
    ma = fmaxf(ma, pA[15]) + A.coff; mb = fmaxf(mb, pB[15]) + B.coff;
    const float mx = xhalf_max(fmaxf(ma, mb));
    if (__any(mx > st.m)) {
        const float mnew = fmaxf(st.m, mx);
        const float alpha = ex2(st.m - mnew);
        st.l *= alpha; st.m = mnew;
#pragma unroll
        for (int d0 = 0; d0 < 2; ++d0)
#pragma unroll
            for (int r = 0; r < 16; ++r) st.oT[d0][r] *= alpha;
    }
    const float ca = A.coff - st.m, cbb = B.coff - st.m;
    float ls = 0.f;
#pragma unroll
    for (int r = 0; r < 16; ++r) { pA[r] = ex2(pA[r] + ca); ls += pA[r]; }
#pragma unroll
    for (int s = 0; s < 2; ++s) {
        u32x4 pw; pw.x = cvtpk(pA[8 * s + 0], pA[8 * s + 1]); pw.y = cvtpk(pA[8 * s + 2], pA[8 * s + 3]); pw.z = cvtpk(pA[8 * s + 4], pA[8 * s + 5]); pw.w = cvtpk(pA[8 * s + 6], pA[8 * s + 7]);
        const bf16x8 pb = __builtin_bit_cast(bf16x8, pw);
#pragma unroll
        for (int d0 = 0; d0 < 2; ++d0) {
            const LAS bf16_t* vp = Vt + (32 * d0 + l31) * vpitch + A.kk0 + 16 * s + 4 * hf;
            const u32x2 v0 = *(const LAS u32x2*)vp, v1 = *(const LAS u32x2*)(vp + 8);
            u32x4 vv; vv.x = v0.x; vv.y = v0.y; vv.z = v1.x; vv.w = v1.y;
            st.oT[d0] = __builtin_amdgcn_mfma_f32_32x32x16_bf16(__builtin_bit_cast(bf16x8, vv), pb, st.oT[d0], 0, 0, 0); }
    }
#pragma unroll
    for (int r = 0; r < 16; ++r) { pB[r] = ex2(pB[r] + cbb); ls += pB[r]; }
    st.l += ls;
#pragma unroll
    for (int s = 0; s < 2; ++s) {
        u32x4 pw; pw.x = cvtpk(pB[8 * s + 0], pB[8 * s + 1]); pw.y = cvtpk(pB[8 * s + 2], pB[8 * s + 3]); pw.z = cvtpk(pB[8 * s + 4], pB[8 * s + 5]); pw.w = cvtpk(pB[8 * s + 6], pB[8 * s + 7]);
        const bf16x8 pb = __builtin_bit_cast(bf16x8, pw);
#pragma unroll
        for (int d0 = 0; d0 < 2; ++d0) {
            const LAS bf16_t* vp = Vt + (32 * d0 + l31) * vpitch + B.kk0 + 16 * s + 4 * hf;
            const u32x2 v0 = *(const LAS u32x2*)vp, v1 = *(const LAS u32x2*)(vp + 8);
            u32x4 vv; vv.x = v0.x; vv.y = v0.y; vv.z = v1.x; vv.w = v1.y;
            st.oT[d0] = __builtin_amdgcn_mfma_f32_32x32x16_bf16(__builtin_bit_cast(bf16x8, vv), pb, st.oT[d0], 0, 0, 0); }
    }
}
__device__ __forceinline__ void attn_store_row(const AttnState& st, float scale, bf16_t* dst, int hf) {
#pragma unroll
    for (int d0 = 0; d0 < 2; ++d0)
#pragma unroll
        for (int g = 0; g < 4; ++g) { u32x2 w; w.x = pk2(st.oT[d0][4 * g] * scale, st.oT[d0][4 * g + 1] * scale); w.y = pk2(st.oT[d0][4 * g + 2] * scale, st.oT[d0][4 * g + 3] * scale);
            *(u32x2*)(dst + 32 * d0 + 8 * g + 4 * hf) = w; }
}

constexpr int MB_KS = 0;
constexpr int MB_VT = 256 * 72 * 2;
constexpr int MB_KM = MB_VT + 64 * 260 * 2;
constexpr int MB_VP = 260;
constexpr int DL_KS = 0;
constexpr int DL_VT = 384 * 72 * 2;
constexpr int DL_VP = 388;
constexpr int AT_PREF = 120 * 1024;
static_assert(DL_VT + 64 * 388 * 2 <= AT_PREF && MB_KM + 32 * 64 * 4 <= AT_PREF, "attention LDS");
constexpr int LIST_CAP = 8192;

__device__ __forceinline__ void moba_topk_unit(const Frame& F, const LayerP& P, int b, int h, int qb, unsigned* cnt  , unsigned* list  ) {
    LAS float* kmS = (LAS float*)(F.lds + MB_KM);
    const int tid = F.tid, lane = F.lane, w = F.wave, l31 = lane & 31, hf = lane >> 5, bh = b * 4 + h;
    __syncthreads();
    for (int q = tid; q < qb * 64; q += 512) { const int n = q >> 6, d = q & 63;
        kmS[q] = __hip_atomic_load(F.KMP + ((size_t)(b * 32 + n)) * 256 + h * 64 + d, __ATOMIC_RELAXED, __HIP_MEMORY_SCOPE_AGENT) * (1.0f / 256.0f); }
    const int qpos = qb * 256 + 32 * w + l31;
    const size_t grow = (size_t)b * SEQ + qpos;
    float qv[32];
#pragma unroll
    for (int d0 = 0; d0 < 4; ++d0) { const u32x4 a = *(const u32x4*)(F.Z + grow * NZP + C_QA + h * 64 + 16 * d0 + 8 * hf);
#pragma unroll
        for (int k = 0; k < 4; ++k) { qv[d0 * 8 + 2 * k] = bf2f(a[k] & 0xffffu); qv[d0 * 8 + 2 * k + 1] = bf2f(a[k] >> 16); } }
    __syncthreads();
    float v0 = -INFINITY, v1 = -INFINITY, v2 = -INFINITY; int i0 = -1, i1 = -1, i2 = -1;
    for (int n = 0; n < qb; ++n) { float g = 0.f;
#pragma unroll
        for (int d0 = 0; d0 < 4; ++d0) { const f32x4 k0 = *(const LAS f32x4*)(kmS + n * 64 + 16 * d0 + 8 * hf), k1 = *(const LAS f32x4*)(kmS + n * 64 + 16 * d0 + 8 * hf + 4);
            g += qv[d0 * 8 + 0] * k0.x + qv[d0 * 8 + 1] * k0.y + qv[d0 * 8 + 2] * k0.z + qv[d0 * 8 + 3] * k0.w + qv[d0 * 8 + 4] * k1.x + qv[d0 * 8 + 5] * k1.y + qv[d0 * 8 + 6] * k1.z + qv[d0 * 8 + 7] * k1.w; }
        g = xor32_sum(g);
        if (g > v0) { v2 = v1; i2 = i1; v1 = v0; i1 = i0; v0 = g; i0 = n; }
        else if (g > v1) { v2 = v1; i2 = i1; v1 = g; i1 = n; }
        else if (g > v2) { v2 = g; i2 = n; } }
    float gq = fabsf(P.qga[lane]), gk = fabsf(P.kga[lane]);
    gq = wave64_max(gq); gk = wave64_max(gk);
    const float B2 = 2.04f * 64.0f * gq * gk * QSCALE, slope2 = exp2f(-(float)(2 * h + 1)) * LOG2E;
    const bool z0 = i0 >= 0 && (B2 - slope2 * (float)(qpos - 256 * i0 - 255)) < -152.0f;
    const bool z1 = i1 >= 0 && (B2 - slope2 * (float)(qpos - 256 * i1 - 255)) < -152.0f;
    const bool z2 = i2 >= 0 && (B2 - slope2 * (float)(qpos - 256 * i2 - 255)) < -152.0f;
    if (z0) i0 = -1;
    if (z1) i1 = -1;
    if (z2) i2 = -1;
    unsigned mymask = 0u;
    for (int n = 0; n < qb; ++n) {
        const unsigned long long mask = __ballot(hf == 0 && (n == i0 || n == i1 || n == i2));
        if (lane == n) mymask = (unsigned)mask;
    }
    unsigned mybase = 0u;
    if (mymask != 0u) mybase = atomicAdd(cnt + bh * 32 + lane, (unsigned)__popc(mymask));
    {
        const unsigned below = (1u << l31) - 1u;
        const int sel[3] = {i0, i1, i2};
#pragma unroll
        for (int k = 0; k < 3; ++k) {
            const int n = sel[k] < 0 ? 0 : sel[k];
            const unsigned mk = (unsigned)__shfl((int)mymask, n), bs = (unsigned)__shfl((int)mybase, n);
            if (hf == 0 && sel[k] >= 0) { const int pos = (int)bs + __popc(mk & below);
                if (pos < LIST_CAP) list[((size_t)bh * 32 + n) * LIST_CAP + pos] = ((unsigned)qpos << 2) | (unsigned)k; }
        }
    }
    if (hf == 0) { float* ps = F.PS + grow * (NZP / 2) + h * 8;
        float ninf = -1e30f, zer = 0.f; asm volatile("" : "+v"(ninf), "+v"(zer));
        if (i0 < 0) { ps[0] = ninf; ps[1] = zer; }
        if (i1 < 0) { ps[2] = ninf; ps[3] = zer; }
        if (i2 < 0) { ps[4] = ninf; ps[5] = zer; } }
}

constexpr int AT_KS = 0, AT_VT = 384 * 72 * 2, AT_VP = 388;
struct AttDesc {
    int kind;
    int b, h, n, tile, cnt, pr;
    int pat, dil, g, u;
    int nrows, first_valid; long long row0, rstride;
    int kcol, vcol;
};
__device__ __forceinline__ AttDesc att_decode(int j, int total, const LAS int* pref, const unsigned* cnt) {
    AttDesc D; D.kind = 0; D.b = 0; D.h = 0; D.n = 0; D.tile = 0; D.cnt = 0; D.pr = 0; D.pat = 0; D.dil = 1; D.g = 0; D.u = 0;
    if (j < total + 256) {
        int pr, tile;
        if (j < total) { int lo = 0, hi = 255;
            while (lo < hi) { const int mid = (lo + hi + 1) >> 1; if (pref[mid] <= j) lo = mid; else hi = mid - 1; }
            pr = lo; tile = j - pref[pr] + 1; D.kind = 0;
        } else { const int u = j - total; pr = (u & 7) * 32 + (u >> 3); tile = 0; D.kind = 1; }
        D.cnt = pref[272 + pr];
        D.pr = pr; D.tile = tile; D.b = pr >> 7; D.h = (pr >> 5) & 3; D.n = pr & 31;
        D.nrows = 256; D.first_valid = 0; D.row0 = (long long)D.b * SEQ + D.n * 256; D.rstride = 1; D.kcol = C_KA + D.h * 64; D.vcol = C_VA + D.h * 64;
    } else {
        const int q = j - total - 256; D.kind = 2; D.pat = q >> 8; const int r = q & 255; D.b = (r >> 2) & 1; D.h = r & 3; const int uidx = r >> 3;
        D.dil = (D.pat == 0) ? 1 : (D.pat == 1 ? 4 : 16);
        const int upg = 32 / D.dil; D.g = uidx / upg; D.u = uidx % upg;
        const int i0 = 256 * D.u - 128;
        D.nrows = 384; D.first_valid = (i0 < 0) ? 128 : 0; D.row0 = (long long)D.b * SEQ + (long long)i0 * D.dil + D.g; D.rstride = D.dil; D.kcol = C_KB + D.h * 64; D.vcol = C_VB + D.h * 64;
    }
    return D;
}
struct StageRegs { u32x4 kx[2][2], vx[2][2]; };
__device__ __forceinline__ void att_stage_issue(StageRegs& R, int tid, const bf16_t* Z, const AttDesc& D) {
#pragma unroll
    for (int i = 0; i < 2; ++i) { const int q = tid + 512 * i, r = (q >> 3) * 2, c8 = q & 7;
#pragma unroll
        for (int e = 0; e < 2; ++e) { R.kx[i][e] = (u32x4){0u, 0u, 0u, 0u}; R.vx[i][e] = (u32x4){0u, 0u, 0u, 0u};
            if (r + e >= D.first_valid) { const bf16_t* zr = Z + (size_t)(D.row0 + (long long)(r + e) * D.rstride) * NZP + 8 * c8;
                R.kx[i][e] = *(const u32x4*)(zr + D.kcol); R.vx[i][e] = *(const u32x4*)(zr + D.vcol); } } }
}
__device__ __forceinline__ void att_stage_put(const u32x4 (&kx)[2], const u32x4 (&vx)[2], int r, int c8, LAS bf16_t* Ks, LAS bf16_t* Vt) {
    *(LAS u32x4*)(Ks + r * 72 + 8 * c8) = kx[0]; *(LAS u32x4*)(Ks + (r + 1) * 72 + 8 * c8) = kx[1];
#pragma unroll
    for (int k = 0; k < 4; ++k) { const unsigned a = vx[0][k], b = vx[1][k];
        *(LAS unsigned*)(Vt + (8 * c8 + 2 * k) * AT_VP + r) = (a & 0xffffu) | (b << 16);
        *(LAS unsigned*)(Vt + (8 * c8 + 2 * k + 1) * AT_VP + r) = (a >> 16) | (b & 0xffff0000u); }
}
struct StageTail { u32x4 k3[2], v3[2]; };
__device__ __forceinline__ void att_stage_tail_issue(StageTail& T3, int tid, const bf16_t* Z, const AttDesc& D) {
    const int q3 = tid + 1024, r3 = (q3 >> 3) * 2, c83 = q3 & 7;
#pragma unroll
    for (int e = 0; e < 2; ++e) { T3.k3[e] = (u32x4){0u, 0u, 0u, 0u}; T3.v3[e] = (u32x4){0u, 0u, 0u, 0u};
        if (D.nrows > 256) { const bf16_t* zr = Z + (size_t)(D.row0 + (long long)(r3 + e) * D.rstride) * NZP + 8 * c83; T3.k3[e] = *(const u32x4*)(zr + D.kcol); T3.v3[e] = *(const u32x4*)(zr + D.vcol); } }
}
__device__ __forceinline__ void att_stage_write(const StageRegs& R, const StageTail& T3, int tid, const AttDesc& D, LAS bf16_t* Ks, LAS bf16_t* Vt) {
#pragma unroll
    for (int i = 0; i < 2; ++i) { const int q = tid + 512 * i, r = (q >> 3) * 2, c8 = q & 7; att_stage_put(R.kx[i], R.vx[i], r, c8, Ks, Vt); }
    if (D.nrows > 256) { const int q3 = tid + 1024, r3 = (q3 >> 3) * 2, c83 = q3 & 7; att_stage_put(T3.k3, T3.v3, r3, c83, Ks, Vt); }
}
__device__ __forceinline__ unsigned att_entry_issue(const AttDesc& D, const unsigned* LIST, int w, int l31) {
    if (D.kind == 2) return 0u;
    const int idx0 = D.tile * 256 + 32 * w;
    if (idx0 >= D.cnt) return 0u;
    const int idx = idx0 + l31;
    return LIST[(size_t)D.pr * LIST_CAP + (idx < D.cnt ? idx : idx0)];
}
__device__ __forceinline__ void att_compute(const Frame& F, const AttDesc& D, const int mode  , unsigned entry, const bf16x8 (&qf)[4], size_t grow, int qpos) {
    const LAS bf16_t* Ks = (const LAS bf16_t*)(F.lds + AT_KS); const LAS bf16_t* Vt = (const LAS bf16_t*)(F.lds + AT_VT);
    const int lane = F.lane, w = F.wave, l31 = lane & 31, hf = lane >> 5;
    const bool dilk = mode == 2, own = mode == 1;
    const int idx0 = D.tile * 256 + 32 * w;
    if (mode == 0 && idx0 >= D.cnt) return;
    const float slope2 = dilk ? exp2f(-(float)(2 * D.h + 2)) * LOG2E * (float)D.dil : exp2f(-(float)(2 * D.h + 1)) * LOG2E;
    f32x16 cb;
#pragma unroll
    for (int r = 0; r < 16; ++r) cb[r] = slope2 * (float)crow(r, hf);
    const int i0 = 256 * D.u - 128;
    AttnState st; attn_init(st);
    int jmin = 0; if (dilk) { jmin = (-i0 - 32 * w + 31) >> 5; jmin = jmin < 0 ? 0 : jmin; }
    const int ntile = dilk ? (5 - jmin) : (own ? (w + 1) : 8);
    auto tile_params = [&](int s) -> TileP { TileP T;
        if (dilk) { const int j = 4 - s; T.kk0 = 32 * w + 32 * j; T.coff = -slope2 * (float)(l31 + 128 - 32 * j); T.masked = (j == 4 || j == 0); T.lo = l31 - 32 * j; T.hi = l31 + 128 - 32 * j; }
        else { T.kk0 = 32 * s; T.coff = slope2 * (float)(D.n * 256 + 32 * s - qpos); T.masked = own && (s == w); T.lo = -1; T.hi = l31; }
        return T; };
    int s = 0;
#pragma nounroll
    for (; s + 1 < ntile; s += 2) attn_pair(st, Ks, Vt, AT_VP, qf, cb, tile_params(s), tile_params(s + 1), l31, hf);
    if (s < ntile) { const TileP T = tile_params(s);
        const f32x16 pc = attn_qk(Ks, T.kk0, qf, cb, l31, hf);
        attn_softmax_pv(st, pc, Vt, AT_VP, T.kk0, T.coff, T.masked, T.lo, T.hi, l31, hf); }
    const float ltot = xhalf_sum(st.l);
    if (dilk) {
        attn_store_row(st, __builtin_amdgcn_rcpf(ltot), F.DOp + grow * NZP + D.pat * 256 + D.h * 64, hf);
        if (hf == 0) { float* sp = F.DST + (((size_t)D.pat * MTOK + grow) * 4 + D.h) * 2; sp[0] = st.m; sp[1] = ltot; }
    } else {
        const bool valid = own || (idx0 + l31 < D.cnt);
        const int slot = own ? 3 : (int)(entry & 3u);
        if (valid) {
            attn_store_row(st, __builtin_amdgcn_rcpf(ltot), F.PO + (((size_t)slot * MTOK + grow) * 4 + D.h) * 64, hf);
            if (hf == 0) { float* ps = F.PS + grow * (NZP / 2) + D.h * 8 + slot * 2; ps[0] = st.m; ps[1] = ltot; } }
    }
}
__device__ __forceinline__ void att_phase(const Frame& F, const unsigned* cnt, unsigned* dctr  ) {
    LAS int* pref = (LAS int*)(F.lds + AT_PREF);
    LAS bf16_t* Ks = (LAS bf16_t*)(F.lds + AT_KS); LAS bf16_t* Vt = (LAS bf16_t*)(F.lds + AT_VT);
    const int lane = F.lane, w = F.wave, l31 = lane & 31, hf = lane >> 5;
    LAS int* dq = pref + 530;
    __syncthreads();
    if (F.tid == 0) dq[0] = (int)atomicAdd(dctr, 1u);
    {
        int T = 0;
        if (F.tid < 256) { int c = (int)__hip_atomic_load(cnt + F.tid, __ATOMIC_RELAXED, __HIP_MEMORY_SCOPE_AGENT); c = c > LIST_CAP ? LIST_CAP : c; pref[272 + F.tid] = c; T = ((c + 255) >> 8) - 1; T = T < 0 ? 0 : T; }
        int x = T;
#pragma unroll
        for (int o = 1; o < 64; o <<= 1) { const int y = __shfl_up(x, o); if (lane >= o) x += y; }
        if (lane == 63) pref[264 + w] = x;
        __syncthreads();
        int off = 0;
        for (int ww = 0; ww < w; ++ww) off += pref[264 + ww];
        if (F.tid < 256) pref[F.tid] = x + off - T;
        if (F.tid == 255) pref[256] = x + off;
        __syncthreads();
    }
    const int total = pref[256], NS = total + 256;
    const int vcu = (F.G % 8 == 0) ? (F.bid % 8) * (F.G / 8) + F.bid / 8 : F.bid;
    int j = vcu, nd = 0; bool isdyn = false;
    if (j >= NS) { const int d = dq[0]; nd = 1; isdyn = true; if (d >= 768) return; j = NS + d; if (F.tid == 0) dq[1] = (int)atomicAdd(dctr, 1u); }
    AttDesc D = att_decode(j, total, pref, cnt);
    StageRegs R; att_stage_issue(R, F.tid, F.Z, D);
    unsigned entry = att_entry_issue(D, F.LIST, w, l31);
    for (;;) {
        int qpos; size_t grow; int qcol;
        if (D.kind == 2) { const int iq = 256 * D.u + 32 * w + l31; qpos = iq; grow = (size_t)D.b * SEQ + (size_t)iq * D.dil + D.g; qcol = C_QB + D.h * 64; }
        else { qpos = (D.kind == 1) ? (D.n * 256 + 32 * w + l31) : (int)(entry >> 2); grow = (size_t)D.b * SEQ + qpos; qcol = C_QA + D.h * 64; }
        bf16x8 qf[4];
#pragma unroll
        for (int d0 = 0; d0 < 4; ++d0) qf[d0] = *(const bf16x8*)(F.Z + grow * NZP + qcol + 16 * d0 + 8 * hf);
        const bool two = (D.kind == 1) && (D.cnt > 0);
        const int qpos2 = (int)(entry >> 2); const size_t grow2 = (size_t)D.b * SEQ + qpos2;
        StageTail T3; att_stage_tail_issue(T3, F.tid, F.Z, D);
        __syncthreads();
        att_stage_write(R, T3, F.tid, D, Ks, Vt);
        __syncthreads();
        int jn; bool have_n; int fd = 0; bool fetched = false;
        if (!isdyn && j + F.G < NS) { jn = j + F.G; have_n = true; }
        else { const int d = dq[nd & 1]; ++nd; isdyn = true; have_n = d < 768; jn = NS + d;
            if (have_n) { fetched = true; if (F.tid == 0) fd = (int)atomicAdd(dctr, 1u); } }
        AttDesc Dn = D; unsigned entry_n = 0u;
        if (have_n) { Dn = att_decode(jn, total, pref, cnt); att_stage_issue(R, F.tid, F.Z, Dn); entry_n = att_entry_issue(Dn, F.LIST, w, l31); }
        const int npass = two ? 2 : 1;
#pragma nounroll
        for (int pass = 0; pass < npass; ++pass) {
            const int mode = (pass == 1) ? 0 : D.kind;
            att_compute(F, D, mode, entry, qf, pass ? grow2 : grow, pass ? qpos2 : qpos);
            if (pass + 1 < npass) {
#pragma unroll
                for (int d0 = 0; d0 < 4; ++d0) qf[d0] = *(const bf16x8*)(F.Z + grow2 * NZP + qcol + 16 * d0 + 8 * hf); }
        }
        if (fetched && F.tid == 0) dq[nd & 1] = fd;
        if (!have_n) break;
        D = Dn; entry = entry_n; j = jn;
    }
    __syncthreads();
}

template <int NP, int NB>
__device__ __forceinline__ void combine_items(const Frame& F, int item0, int istride, int nitems, const bf16_t* PO, size_t o_row, size_t o_head, size_t o_part, const float* PS, size_t s_row, size_t s_head, size_t s_part, int zgate_col, int cc_col) {
    float m[NB][NP], l[NB][NP]; u32x4 ox[NB][NP], gz[NB];
#pragma unroll
    for (int k = 0; k < NB; ++k) { const int item = item0 + k * istride; const int idx = (item < nitems ? item : item0) * 512 + F.tid; const size_t row = (size_t)(idx >> 5); const int h = (idx >> 3) & 3, c8 = idx & 7;
#pragma unroll
        for (int pp = 0; pp < NP; ++pp) { const float* sp = PS + row * s_row + h * s_head + pp * s_part; m[k][pp] = sp[0]; l[k][pp] = sp[1];
            ox[k][pp] = __builtin_nontemporal_load((const u32x4*)(PO + row * o_row + h * o_head + pp * o_part + 8 * c8)); }
        gz[k] = *(const u32x4*)(F.Z + row * NZP + zgate_col + h * 64 + 8 * c8); }
#pragma unroll
    for (int k = 0; k < NB; ++k) { const int item = item0 + k * istride; if (item >= nitems) continue;
        const int idx = item * 512 + F.tid; const size_t row = (size_t)(idx >> 5); const int h = (idx >> 3) & 3, c8 = idx & 7;
        float mm = m[k][0];
#pragma unroll
        for (int pp = 1; pp < NP; ++pp) mm = fmaxf(mm, m[k][pp]);
        float wsum = 0.f; float o[8];
#pragma unroll
        for (int e = 0; e < 8; ++e) o[e] = 0.f;
#pragma unroll
        for (int pp = 0; pp < NP; ++pp) { const float wgt = (l[k][pp] > 0.f) ? l[k][pp] * ex2(m[k][pp] - mm) : 0.f; wsum += wgt;
            float x[8]; unpack8(ox[k][pp], x);
#pragma unroll
            for (int e = 0; e < 8; ++e) o[e] += wgt * x[e]; }
        const float rw = __builtin_amdgcn_rcpf(wsum);
        float gx[8]; unpack8(gz[k], gx);
        float y[8];
#pragma unroll
        for (int e = 0; e < 8; ++e) y[e] = o[e] * rw * siluf_(gx[e]);
        u32x4 ov; ov.x = pk2(y[0], y[1]); ov.y = pk2(y[2], y[3]); ov.z = pk2(y[4], y[5]); ov.w = pk2(y[6], y[7]);
        *(u32x4*)(F.CC + row * DM + cc_col + h * 64 + 8 * c8) = ov; }
}

__device__ __forceinline__ void gla_scan_item2(const Frame& F, int sc, const int rep = 0) {
    LAS float* S = (LAS float*)F.lds;
    const int lane = F.lane, w = F.wave;
    const int gidx = sc * 64 + lane, b = gidx >> 13, rem = gidx & 8191, hd = rem >> 6;
    float* kv = F.KV + ((size_t)b * 128 + 16 * w) * 8192 + rem; const float* bl = F.BL + ((size_t)b * 128 + 16 * w) * 128 + hd;
    float kvv[16], dec[16];
#pragma unroll
    for (int u = 0; u < 16; ++u) { kvv[u] = kv[(size_t)u * 8192]; dec[u] = bl[u * 128]; }
    float A = 1.f, Sx = 0.f;
#pragma unroll
    for (int u = 0; u < 16; ++u) { dec[u] = __expf(dec[u]); Sx = dec[u] * Sx + kvv[u]; A *= dec[u]; }
    __syncthreads();
    S[(w * 2 + 0) * 64 + lane] = A; S[(w * 2 + 1) * 64 + lane] = Sx;
    __syncthreads();
    float X = 0.f;
    for (int ww = 0; ww < w; ++ww) X = S[(ww * 2) * 64 + lane] * X + S[(ww * 2 + 1) * 64 + lane];
#pragma unroll
    for (int u = 0; u < 16; ++u) { if (!rep) kv[(size_t)u * 8192] = X; X = dec[u] * X + kvv[u]; }
    if (rep) asm volatile("" :: "v"(X));
    __syncthreads();
}

#define XB_TMO      128
#define XB_XCNT(j)  (256  + 64 * (j))
#define XB_XSUB(j)  (1280 + 64 * (j))
#define XB_XGEN(j)  (2304 + 64 * (j))
#define XB_TOP      3328
#define XB_TOPGEN   3392
#define XCD_BAR_WORDS 3456
#define XB_SPIN_CAP (1u << 18)

__device__ __forceinline__ unsigned xb_ld(unsigned* p)              { return __hip_atomic_load(p, __ATOMIC_RELAXED, __HIP_MEMORY_SCOPE_AGENT); }
__device__ __forceinline__ unsigned xb_add(unsigned* p, unsigned v) { return __hip_atomic_fetch_add(p, v, __ATOMIC_RELAXED, __HIP_MEMORY_SCOPE_AGENT); }
__device__ __forceinline__ unsigned xb_xcc_id() { return (unsigned)__builtin_amdgcn_s_getreg((3 << 11) | 20) & 0xFu; }
#define XB_SPIN(cond, bar) do { unsigned _sp = 0; while (cond) { __builtin_amdgcn_s_sleep(1); \
    if ((++_sp & 255u) == 0u) { if (xb_ld(&(bar)[XB_TMO])) break; if (_sp > XB_SPIN_CAP) { atomicAdd(&(bar)[XB_TMO], 1u); break; } } } } while (0)

struct XcdBarrier {
    unsigned* bar; unsigned x;
    volatile LAS unsigned* st;
};

__device__ __forceinline__ XcdBarrier xcd_barrier_post(unsigned* bar, volatile LAS unsigned* st) {
    XcdBarrier b; b.bar = bar; b.x = xb_xcc_id(); b.st = st;
    if (threadIdx.x == 0) (void)xb_add(&bar[XB_XCNT(b.x)], 1u);
    return b;
}
__device__ __forceinline__ void xcd_barrier_complete(unsigned* bar, unsigned x, unsigned& nloc, unsigned& nx) {
    const unsigned G = gridDim.x * gridDim.y * gridDim.z;
    unsigned sum, cnt, mine, sp = 0u;
    for (;;) {
        sum = 0u; cnt = 0u; mine = 0u;
#pragma unroll
        for (unsigned j = 0; j < 16; ++j) { const unsigned c = xb_ld(&bar[XB_XCNT(j)]); sum += c; cnt += (c > 0u) ? 1u : 0u; mine = (j == x) ? c : mine; }
        if (sum == G) break;
        __builtin_amdgcn_s_sleep(1);
        if ((++sp & 255u) == 0u) { if (xb_ld(&bar[XB_TMO])) break; if (sp > XB_SPIN_CAP) { atomicAdd(&bar[XB_TMO], 1u); break; } }
    }
    nloc = mine > 0u ? mine : 1u; nx = cnt > 0u ? cnt : 1u;
}

__device__ __forceinline__ void xcd_barrier(const XcdBarrier& b) {
    asm volatile("s_waitcnt vmcnt(0)" ::: "memory");
    __syncthreads();
    if (threadIdx.x == 0) {
        unsigned* bar = b.bar;
        __builtin_amdgcn_s_waitcnt(0);
        unsigned nloc = b.st[0], nx = b.st[1];
        if (nloc == 0u) { xcd_barrier_complete(bar, b.x, nloc, nx); b.st[0] = nloc; b.st[1] = nx; }
        const unsigned old = xb_add(&bar[XB_XSUB(b.x)], 1u);
        const unsigned gen = old / nloc;
        if (old + 1u == (gen + 1u) * nloc) {
            __builtin_amdgcn_fence(__ATOMIC_RELEASE, "agent");
            asm volatile("s_waitcnt vmcnt(0)" ::: "memory");
            const unsigned og = xb_add(&bar[XB_TOP], 1u);
            const unsigned tg = og / nx;
            if (og + 1u == (tg + 1u) * nx) xb_add(&bar[XB_TOPGEN], 1u);
            else XB_SPIN(xb_ld(&bar[XB_TOPGEN]) == tg, bar);
            __builtin_amdgcn_fence(__ATOMIC_ACQUIRE, "agent");
            xb_add(&bar[XB_XGEN(b.x)], 1u);
            asm volatile("s_waitcnt vmcnt(0)" ::: "memory");
        } else {
            XB_SPIN(xb_ld(&bar[XB_XGEN(b.x)]) == gen, bar);
            __builtin_amdgcn_fence(__ATOMIC_ACQUIRE, "agent");
            asm volatile("s_waitcnt vmcnt(0)" ::: "memory");
        }
    }
    __syncthreads();
}

struct Args { const float* in[17]; float* out; unsigned char* ws; int ph_lo, ph_hi, coop, pad; };

constexpr int W_I_IN = 16 * (NZP / 32), W_I_OUT = 16 * 32, W_I_PW = 4 * 8, W_ITEMS_L = W_I_IN + W_I_OUT + W_I_PW;
__device__ __forceinline__ void weight_copy_item(const float* w_in, const float* w_out, const float* w_pw, const float* norm_g, unsigned char* ws, int ll, int r, LAS float* scr, int lane) {
    if (r < W_I_IN) { transpose_item(w_in + (size_t)ll * DM * NZ, DM, NZ, NZP / 32, (bf16_t*)(ws + WS_WIN + ll * WIN_L), scr, r, lane, norm_g + ll * DM); return; } r -= W_I_IN;
    if (r < W_I_OUT) { transpose_item(w_out + (size_t)ll * DM * DM, DM, DM, 32, (bf16_t*)(ws + WS_WOUT + ll * WOUT_L), scr, r, lane); return; } r -= W_I_OUT;
    transpose_item(w_pw + (size_t)ll * 65536, 256, 256, 8, (bf16_t*)(ws + WS_WPW + ll * WPW_L), scr, r, lane);
}
template <int K> __device__ __forceinline__ void run_phase(const int l, LAS unsigned char* lds_base, LAS int* s_item, const int rep = 0) {
        typedef const __attribute__((address_space(4))) Args* ArgP;
        ArgP ap = (ArgP)__builtin_amdgcn_kernarg_segment_ptr(); asm volatile("" : "+s"(ap));
        Frame F;
        F.lds = lds_base;
        { int t_ = threadIdx.x; asm volatile("" : "+v"(t_)); F.tid = t_; F.lane = t_ & 63; F.wave = __builtin_amdgcn_readfirstlane(t_ >> 6); }
        { int g_ = gridDim.x, b_ = blockIdx.x; asm volatile("" : "+s"(g_), "+s"(b_)); F.G = g_; F.bid = b_; }
        unsigned char* ws = ap->ws;
        F.ctl = (unsigned*)(ws + WS_CTL);
        F.H = (bf16_t*)(ws + WS_H); F.Z = (bf16_t*)(ws + WS_Z); F.CC = (bf16_t*)(ws + WS_CC); F.DOp = F.Z + C_DO;
        F.KMP = (float*)(ws + WS_KM + (size_t)l * 65536); F.BL = (float*)(ws + WS_BL); F.DST = (float*)(ws + WS_DST); F.KV = (float*)(ws + WS_KV);
        F.PO = (bf16_t*)(ws + WS_PO); F.PS = (float*)(F.Z + C_PS); F.LIST = (unsigned*)(ws + WS_LIST);
        LayerP P;
        P.norm_g = ap->in[1] + l * DM;
        P.qga = ap->in[3] + l * 64; P.kga = ap->in[4] + l * 64; P.qgb = ap->in[5] + l * 64; P.kgb = ap->in[6] + l * 64;
        P.conv_w = ap->in[7] + l * 31 * 256; P.conv_b = ap->in[8] + l * 256; P.ln_g = ap->in[9] + l * 256; P.ln_b = ap->in[10] + l * 256;
        P.pw_b = ap->in[12] + l * 256; P.gate_w = ap->in[13] + l * 16 * 128; P.gate_b = ap->in[14] + l * 128; P.gla_g = ap->in[15] + l * 64;
        P.WinT = (const bf16_t*)(ws + WS_WIN + l * WIN_L); P.WoutT = (const bf16_t*)(ws + WS_WOUT + l * WOUT_L); P.WpwT = (const bf16_t*)(ws + WS_WPW + l * WPW_L);
        P.xin = (l == 0) ? ap->in[0] : ap->out; P.xout = ap->out;

        if constexpr (K == 0) {
            const int gw = F.bid * NWAVES + F.wave, NGW = F.G * NWAVES;
            if (l == 0) {
                LAS float* scr = (LAS float*)(F.lds + F.wave * 16384);
                for (int it = gw; it < W_I_IN; it += NGW) weight_copy_item(ap->in[2], ap->in[16], ap->in[11], ap->in[1], ws, 0, it, scr, F.lane);
            }
            if (l == 0) for (int m = gw; m < MTOK; m += 2 * NGW) cvt_row2(P.xin + (size_t)m * DM, F.H + (size_t)m * DM, (float*)(ws + WS_SSQ0) + m, (size_t)NGW, F.lane);
        } else if constexpr (K == 1) {
            pg8::Gemm g{F.H, P.WinT, MTOK, NZP, DM}; pg8::StaticOrder S; S.init(MTOK, NZP, F.G, F.bid);
            pg8::EpiZ E{F.Z, NZP, (const float*)(ws + (l == 0 ? WS_SSQ0 : WS_SSQ1)), 1.0f / DM, EPS, (LAS float*)(F.lds + 135168), P.qga, P.kga, P.qgb, P.kgb, (float*)(ws + WS_KM + (size_t)l * 65536), QSCALE, NZ};
            pg8::gemm_phase<pg8::EpiZ, pg8::StaticOrder, true, true>(F.lds, g, S, E);
            if (l == 0) {
                const int nu = (MTOK / 256) * (NZP / 256), base_u = nu / F.G, rem_u = nu % F.G;
                const int nfree = (rem_u == 0) ? F.G : (F.G - rem_u), fidx = (rem_u == 0) ? F.bid : (F.bid - rem_u);
                if (fidx >= 0) { LAS float* scr = (LAS float*)(F.lds + F.wave * 16384);
                    const int nw_ = nfree * NWAVES, w0_ = fidx * NWAVES + F.wave;
                    for (int it = W_I_IN + w0_; it < W_ITEMS_L; it += nw_) weight_copy_item(ap->in[2], ap->in[16], ap->in[11], ap->in[1], ws, 0, it, scr, F.lane);
                    for (int it = w0_; it < W_ITEMS_L; it += nw_) weight_copy_item(ap->in[2], ap->in[16], ap->in[11], ap->in[1], ws, 1, it, scr, F.lane); }
                (void)base_u;
            }
        } else if constexpr (K == 2) {
            if (!rep) for (int it = F.bid; it < 256; it += F.G) gla_kv_item(F, P, it);
            if (!rep) { unsigned* cnt = F.ctl + 1024 + l * 256;
                for (int it = F.bid; it < 256; it += F.G) moba_topk_unit(F, P, (it >> 2) & 1, it & 3, 31 - (it >> 3), cnt, F.LIST); }
            { const int nr_ = (REP_PHASE == -8) ? 5 : 1; for (int it = F.bid; it < 256 * nr_; it += F.G) conv_item(F, P, it & 255); }
        } else if constexpr (K == 4) {
            if (!rep) for (int it = F.bid; it < 256; it += F.G) gla_scan_item2(F, it);
            att_phase(F, F.ctl + 1024 + l * 256, F.ctl + 2048 + l * 64);
        } else if constexpr (K == 5) {
            { const int nrep_ = (REP_PHASE == -2) ? 4 : 1; for (int it = F.bid; it < 256 * nrep_; it += F.G) gla_out_item(F, P, it & 255); }
            for (int it = F.bid; it < 1024; it += 4 * F.G) combine_items<4, 4>(F, it, F.G, 1024, F.PO, 256, 64, (size_t)MTOK * 256, F.PS, NZP / 2, 8, 2, C_GA, 0);
            for (int it = F.bid; it < 1024; it += 4 * F.G) combine_items<3, 4>(F, it, F.G, 1024, F.DOp, NZP, 64, 256, F.DST, 8, 2, (size_t)MTOK * 8, C_GB, 256);
        } else {
            pg8::Gemm g{F.CC, P.WoutT, MTOK, DM, DM}; pg8::StaticOrder S; S.init(MTOK, DM, F.G, F.bid);
            if (l == 0) { pg8::EpiResX E{F.H, (float*)(ws + WS_SSQ1), DM};
                pg8::gemm_phase<pg8::EpiResX, pg8::StaticOrder, true, true>(F.lds, g, S, E); }
            else { pg8::EpiRes E{F.H, P.xout, DM};
                pg8::gemm_phase<pg8::EpiRes, pg8::StaticOrder, true, true>(F.lds, g, S, E); }
        }
}

__global__ void __launch_bounds__(NTHR, 2) hybrid_fwd(Args args) {
    extern __shared__ __attribute__((aligned(16))) unsigned char lds_raw[];
    cg::grid_group grid = cg::this_grid();
    LAS unsigned char* lds_base = (LAS unsigned char*)lds_raw;
    LAS int* s_item = (LAS int*)(lds_base + LDS_BYTES - 64);
    const int ph_lo = args.ph_lo, ph_hi = args.ph_hi, coop = args.coop;
    volatile LAS unsigned* bst = (volatile LAS unsigned*)(lds_base + LDS_BYTES - 32);
    if (threadIdx.x == 0) { bst[0] = 0u; bst[1] = 0u; }
    __syncthreads();
    XcdBarrier bar; bar.bar = (unsigned*)(args.ws + WS_CTL) + 4096; bar.x = 0; bar.st = bst;
    if (coop) bar = xcd_barrier_post((unsigned*)(args.ws + WS_CTL) + 4096, bst);
#define GRID_BAR() do { if (coop == 2) grid.sync(); else if (coop == 1) xcd_barrier(bar); } while (0)
    if (REP_PHASE == -3 && coop) { for (int zz = 0; zz < 20; ++zz) GRID_BAR(); }
#ifndef ONLY_K
#define ONLY_K -1
#endif
#define RUN(PH) if ((ONLY_K < 0 || ((PH) % 7) == ONLY_K) && ph_lo <= (PH) && (PH) < ph_hi) { run_phase<(PH) % 7>((PH) / 7, lds_base, s_item); \
        if ((PH) == REP_PHASE) { GRID_BAR(); run_phase<(PH) % 7>((PH) / 7, lds_base, s_item, 1); } \
        if ((PH) + 1 < ph_hi) GRID_BAR(); }
#ifdef LAYER_LOOP
    RUN(0)
#define RUNL(KK) { const int ph_ = 7 * lyr + (KK); if ((ONLY_K < 0 || (KK) == ONLY_K) && ph_lo <= ph_ && ph_ < ph_hi) { run_phase<(KK)>(lyr, lds_base, s_item); \
        if (ph_ == REP_PHASE) { GRID_BAR(); run_phase<(KK)>(lyr, lds_base, s_item, 1); } \
        if (ph_ + 1 < ph_hi) GRID_BAR(); } }
#pragma nounroll
    for (int lyr_ = 0; lyr_ < 2; ++lyr_) { int lyr = lyr_; asm volatile("" : "+s"(lyr)); RUNL(1) RUNL(2) RUNL(4) RUNL(5) RUNL(6) }
#undef RUNL
#else
    RUN(0) RUN(1) RUN(2) RUN(4) RUN(5) RUN(6) RUN(8) RUN(9) RUN(11) RUN(12) RUN(13)
#endif
#undef RUN
#undef GRID_BAR
}

extern "C" void kernel_launch(void* const* d_in, const int* in_sizes, int n_in, void* d_out, int out_size, void* d_ws, size_t ws_size, hipStream_t stream) {
    static int grid = 0;
    if (grid == 0) {
        if (n_in != 17 || out_size != MTOK * DM || ws_size < WS_END) { fprintf(stderr, "kernel_launch: unexpected shapes (n_in %d out %d ws %zu)\n", n_in, out_size, ws_size); grid = -1; return; }
        int dev = 0, cus = 0, per_cu = 0;
        hipGetDevice(&dev); hipDeviceGetAttribute(&cus, hipDeviceAttributeMultiprocessorCount, dev);
        if (hipFuncSetAttribute((const void*)hybrid_fwd, hipFuncAttributeMaxDynamicSharedMemorySize, LDS_BYTES) != hipSuccess) { fprintf(stderr, "kernel_launch: hipFuncSetAttribute failed\n"); grid = -1; return; }
        if (hipOccupancyMaxActiveBlocksPerMultiprocessor(&per_cu, (const void*)hybrid_fwd, NTHR, LDS_BYTES) != hipSuccess || per_cu < 1) { fprintf(stderr, "kernel_launch: occupancy query gives %d\n", per_cu); per_cu = 1; }
        (void)hipGetLastError();
        if (per_cu > 1) per_cu = 1;
        grid = cus * per_cu;
    }
    if (grid < 0) return;
    hipMemsetAsync((char*)d_ws + WS_CTL, 0, CTL_ZERO_BYTES, stream);
    Args a{};
    for (int i = 0; i < 17; ++i) a.in[i] = (const float*)d_in[i];
    a.out = (float*)d_out; a.ws = (unsigned char*)d_ws;
#if N_LAUNCH_MODE == 1
    a.ph_lo = 0; a.ph_hi = 14; a.coop = 1;
    void* kargs[] = {&a};
    hipError_t e = hipLaunchCooperativeKernel((const void*)hybrid_fwd, dim3(grid), dim3(NTHR), kargs, LDS_BYTES, stream);
    if (e != hipSuccess) fprintf(stderr, "cooperative launch failed: %s (grid %d)\n", hipGetErrorString(e), grid);
#else
    for (int ph = 0; ph < 14; ++ph) { a.ph_lo = ph; a.ph_hi = ph + 1; a.coop = 0;
        hipLaunchKernelGGL(hybrid_fwd, dim3(grid), dim3(NTHR), LDS_BYTES, stream, a); }
#endif
}
```

```cpp
#include <hip/hip_runtime.h>
#include <hip/hip_cooperative_groups.h>
#include <cstdio>
#include <cstdint>
namespace cg = cooperative_groups;
template <int CTRL> __device__ __forceinline__ float xl_dpp(float v) { return __int_as_float(__builtin_amdgcn_update_dpp(0, __float_as_int(v), CTRL, 0xF, 0xF, true)); }
__device__ __forceinline__ float row16_sum(float v) { v += xl_dpp<0xB1>(v); v += xl_dpp<0x4E>(v); v += xl_dpp<0x141>(v); v += xl_dpp<0x140>(v); return v; }
__device__ __forceinline__ float row16_max(float v) { v = fmaxf(v, xl_dpp<0xB1>(v)); v = fmaxf(v, xl_dpp<0x4E>(v)); v = fmaxf(v, xl_dpp<0x141>(v)); v = fmaxf(v, xl_dpp<0x140>(v)); return v; }
__device__ __forceinline__ float xor16_sum(float v) { const auto r = __builtin_amdgcn_permlane16_swap(__float_as_uint(v), __float_as_uint(v), false, false); return __uint_as_float(r[0]) + __uint_as_float(r[1]); }
__device__ __forceinline__ float xor32_sum(float v) { const auto r = __builtin_amdgcn_permlane32_swap(__float_as_uint(v), __float_as_uint(v), false, false); return __uint_as_float(r[0]) + __uint_as_float(r[1]); }
__device__ __forceinline__ float wave64_sum(float v) { v = row16_sum(v);
    return (__int_as_float(__builtin_amdgcn_readlane(__float_as_int(v), 0)) + __int_as_float(__builtin_amdgcn_readlane(__float_as_int(v), 16))) + (__int_as_float(__builtin_amdgcn_readlane(__float_as_int(v), 32)) + __int_as_float(__builtin_amdgcn_readlane(__float_as_int(v), 48))); }
__device__ __forceinline__ float wave64_max(float v) { v = row16_max(v);
    return fmaxf(fmaxf(__int_as_float(__builtin_amdgcn_readlane(__float_as_int(v), 0)), __int_as_float(__builtin_amdgcn_readlane(__float_as_int(v), 16))), fmaxf(__int_as_float(__builtin_amdgcn_readlane(__float_as_int(v), 32)), __int_as_float(__builtin_amdgcn_readlane(__float_as_int(v), 48)))); }
namespace pg8 {
#define PG8_LAS __attribute__((address_space(3)))
typedef unsigned short bf16_t;
typedef short bf16x8 __attribute__((ext_vector_type(8)));
typedef float f32x4 __attribute__((ext_vector_type(4)));
typedef unsigned u32x4 __attribute__((ext_vector_type(4)));
constexpr int BM = 256, BK = 64, HALF = 128, HTB = HALF * BK * 2  , STAGE_BYTES = 8 * HTB, NXCD = 8, WGM = 8;

__host__ __device__ __forceinline__ int lds_byte(int r, int c) { const int st = (r >> 4) * 2 + (c >> 5), rr = r & 15, cc = c & 31, ob = rr * 64 + cc * 2; return st * 1024 + (ob ^ (((ob >> 9) & 1) << 5)); }
__host__ __device__ __forceinline__ void stage_rc(int b, int& R, int& C) { const int st = b / 1024, sb = b % 1024, swz = sb ^ (((sb >> 9) & 1) << 5); R = (st >> 1) * 16 + swz / 64; C = (st & 1) * 32 + (swz % 64) / 2; }
__host__ __device__ __forceinline__ int perm32(int rho) { const int n = rho >> 4, i = rho & 15; return 8 * (i >> 2) + 4 * n + (i & 3); }

struct Unit { int pm, pn; };
struct Gemm { const bf16_t* A; const bf16_t* Bt; int M, N, K; };

struct StaticOrder {
    int nM, nN, nwg, G, c;
    __host__ __device__ void init(int M, int N, int G_, int c_) { nM = M / BM; nN = N / BM; nwg = nM * nN; G = G_; c = c_; }
    __host__ __device__ bool next(int i, Unit& u) const {
        const long L = (long)i * G + c; if (L >= nwg) return false;
        int wgid = (int)L; { const int q = nwg / NXCD, r = nwg % NXCD, xcd = wgid % NXCD, off = wgid / NXCD; wgid = (xcd < r ? xcd * (q + 1) : r * (q + 1) + (xcd - r) * q) + off; }
        const int nig = WGM * nN, gid = wgid / nig, fm = gid * WGM, gsz = (nM - fm) < WGM ? (nM - fm) : WGM;
        u.pm = fm + ((wgid % nig) % gsz); u.pn = (wgid % nig) / gsz; return true;
    }
    __device__ __forceinline__ void a_ready(const Unit&) const {}
    __device__ __forceinline__ void done(const Unit&) const {}
};

__device__ __forceinline__ unsigned cvt_pk_bf16(float lo, float hi) { unsigned r; asm volatile("v_cvt_pk_bf16_f32 %0, %1, %2" : "=v"(r) : "v"(lo), "v"(hi)); return r; }
struct EpiZ {
    static constexpr bool PERM = true, AFTER_DRAIN = false;
    bf16_t* O; int ldc; const float* ssq; float inv_k, eps;
    PG8_LAS float* xch; const float *qga, *kga, *qgb, *kgb; float* km; float qscale; int ncols;
    __device__ __forceinline__ void operator()(const f32x4 (&acc)[2][2][4][2], const Unit& u, int wr, int wc, int fr, int fq) const {
        const int row0 = u.pm * BM + wr * 64 + fr; const int col0 = u.pn * BM + wc * 32 + 8 * fq;
        const int kind = (u.pn == 0) ? 1 : (u.pn == 1) ? 2 : (u.pn == 4) ? 3 : (u.pn == 5) ? 4 : 0;
        float sc[2][4];
#pragma unroll
        for (int ai = 0; ai < 2; ++ai)
#pragma unroll
            for (int m = 0; m < 4; ++m) sc[ai][m] = __builtin_amdgcn_rsqf(__hip_atomic_load(ssq + row0 + ai * HALF + m * 16, __ATOMIC_RELAXED, __HIP_MEMORY_SCOPE_AGENT) * inv_k + eps);
        const int wave = wr * 4 + wc;
        const float* gp = (kind == 1) ? qga : (kind == 2) ? kga : (kind == 3) ? qgb : kgb;
        const float gs = (kind & 1) ? qscale : 1.0f;
        float g[8];
#pragma unroll
        for (int e2 = 0; e2 < 8; ++e2) g[e2] = gp[32 * (wc & 1) + 8 * fq + e2] * gs;
        if (kind != 0) {
#pragma unroll
            for (int ai = 0; ai < 2; ++ai)
#pragma unroll
                for (int m = 0; m < 4; ++m)
#pragma unroll
                    for (int bj = 0; bj < 2; ++bj) { const f32x4 v0 = acc[ai][bj][m][0] * sc[ai][m], v1 = acc[ai][bj][m][1] * sc[ai][m];
                        float s = (v0[0] * v0[0] + v0[1] * v0[1]) + (v0[2] * v0[2] + v0[3] * v0[3]) + (v1[0] * v1[0] + v1[1] * v1[1]) + (v1[2] * v1[2] + v1[3] * v1[3]);
                        s = xor16_sum(s); s = xor32_sum(s);
                        if (fq == 0) xch[((wave * 2 + ai) * 4 + m) * 32 + bj * 16 + fr] = s; }
        }
        asm volatile("s_waitcnt lgkmcnt(0)" ::: "memory"); __builtin_amdgcn_s_barrier(); asm volatile("" ::: "memory");
        if (kind == 0) {
#pragma unroll
            for (int ai = 0; ai < 2; ++ai)
#pragma unroll
                for (int m = 0; m < 4; ++m) { bf16_t* rowp = O + (size_t)(row0 + ai * HALF + m * 16) * ldc + col0;
#pragma unroll
                    for (int bj = 0; bj < 2; ++bj) { const f32x4 v0 = acc[ai][bj][m][0] * sc[ai][m], v1 = acc[ai][bj][m][1] * sc[ai][m];
                        u32x4 w; w.x = cvt_pk_bf16(v0[0], v0[1]); w.y = cvt_pk_bf16(v0[2], v0[3]); w.z = cvt_pk_bf16(v1[0], v1[1]); w.w = cvt_pk_bf16(v1[2], v1[3]);
                        if (col0 + bj * HALF < ncols) *(u32x4*)(rowp + bj * HALF) = w; } }
            return;
        }
        float kacc[2][8];
#pragma unroll
        for (int bj = 0; bj < 2; ++bj)
#pragma unroll
            for (int e2 = 0; e2 < 8; ++e2) kacc[bj][e2] = 0.f;
        const int we = wave & ~1;
#pragma unroll
        for (int ai = 0; ai < 2; ++ai)
#pragma unroll
            for (int m = 0; m < 4; ++m) { bf16_t* rowp = O + (size_t)(row0 + ai * HALF + m * 16) * ldc + col0;
#pragma unroll
                for (int bj = 0; bj < 2; ++bj) {
                    const float tot = xch[((we * 2 + ai) * 4 + m) * 32 + bj * 16 + fr] + xch[(((we + 1) * 2 + ai) * 4 + m) * 32 + bj * 16 + fr];
                    const float rh = sc[ai][m] * __builtin_amdgcn_rsqf(tot * (1.0f / 64.0f) + eps);
                    f32x4 v0 = acc[ai][bj][m][0] * rh, v1 = acc[ai][bj][m][1] * rh;
                    v0[0] *= g[0]; v0[1] *= g[1]; v0[2] *= g[2]; v0[3] *= g[3]; v1[0] *= g[4]; v1[1] *= g[5]; v1[2] *= g[6]; v1[3] *= g[7];
                    if (kind == 2) { kacc[bj][0] += v0[0]; kacc[bj][1] += v0[1]; kacc[bj][2] += v0[2]; kacc[bj][3] += v0[3]; kacc[bj][4] += v1[0]; kacc[bj][5] += v1[1]; kacc[bj][6] += v1[2]; kacc[bj][7] += v1[3]; }
                    u32x4 w; w.x = cvt_pk_bf16(v0[0], v0[1]); w.y = cvt_pk_bf16(v0[2], v0[3]); w.z = cvt_pk_bf16(v1[0], v1[1]); w.w = cvt_pk_bf16(v1[2], v1[3]);
                    *(u32x4*)(rowp + bj * HALF) = w; } }
        if (kind == 2) {
#pragma unroll
            for (int bj = 0; bj < 2; ++bj)
#pragma unroll
                for (int e2 = 0; e2 < 8; ++e2) { float s = kacc[bj][e2];
                    s = row16_sum(s);
                    if (fr == 0) atomicAdd(km + (size_t)u.pm * 256 + bj * HALF + wc * 32 + 8 * fq + e2, s); }
        }
    }
};
struct EpiResX {
    static constexpr bool PERM = false, AFTER_DRAIN = false;
    bf16_t* xb; float* ssq; int ldc;
    __device__ __forceinline__ void operator()(const f32x4 (&acc)[2][2][4][2], const Unit& u, int wr, int wc, int fr, int fq) const {
        const int col0 = u.pn * BM + wc * 32 + 4 * fq;
#pragma unroll
        for (int ai = 0; ai < 2; ++ai) {
            unsigned long long bs[4][2][2];
#pragma unroll
            for (int m = 0; m < 4; ++m) { const size_t off = (size_t)(u.pm * BM + ai * HALF + wr * 64 + m * 16 + fr) * ldc + col0;
#pragma unroll
                for (int bj = 0; bj < 2; ++bj)
#pragma unroll
                    for (int n = 0; n < 2; ++n) bs[m][bj][n] = *(const unsigned long long*)(xb + off + bj * HALF + n * 16); }
            asm volatile("" ::: "memory");
#pragma unroll
            for (int m = 0; m < 4; ++m) { const int row = u.pm * BM + ai * HALF + wr * 64 + m * 16 + fr; const size_t off = (size_t)row * ldc + col0;
                float s = 0.f;
#pragma unroll
                for (int bj = 0; bj < 2; ++bj)
#pragma unroll
                    for (int n = 0; n < 2; ++n) { const unsigned long long wv = bs[m][bj][n]; const unsigned lo = (unsigned)wv, hi = (unsigned)(wv >> 32);
                        f32x4 r; r[0] = __uint_as_float(lo << 16); r[1] = __uint_as_float(lo & 0xffff0000u); r[2] = __uint_as_float(hi << 16); r[3] = __uint_as_float(hi & 0xffff0000u);
                        const f32x4 x1 = r + acc[ai][bj][m][n];
                        unsigned long long w = (unsigned long long)cvt_pk_bf16(x1[0], x1[1]) | ((unsigned long long)cvt_pk_bf16(x1[2], x1[3]) << 32);
                        *(unsigned long long*)(xb + off + bj * HALF + n * 16) = w;
                        s += (x1[0] * x1[0] + x1[1] * x1[1]) + (x1[2] * x1[2] + x1[3] * x1[3]); }
                s = xor16_sum(s); s = xor32_sum(s);
                if (fq == 0) atomicAdd(ssq + row, s); }
            asm volatile("" ::: "memory");
        }
    }
};
struct EpiRes {
    static constexpr bool PERM = false, AFTER_DRAIN = false;
    const bf16_t* xb; float* out; int ldc;
    __device__ __forceinline__ void operator()(const f32x4 (&acc)[2][2][4][2], const Unit& u, int wr, int wc, int fr, int fq) const {
        const int col0 = u.pn * BM + wc * 32 + 4 * fq;
        unsigned long long bs[2][4][2][2];
#pragma unroll
        for (int ai = 0; ai < 2; ++ai)
#pragma unroll
            for (int m = 0; m < 4; ++m) { const size_t off = (size_t)(u.pm * BM + ai * HALF + wr * 64 + m * 16 + fr) * ldc + col0;
#pragma unroll
                for (int bj = 0; bj < 2; ++bj)
#pragma unroll
                    for (int n = 0; n < 2; ++n) bs[ai][m][bj][n] = *(const unsigned long long*)(xb + off + bj * HALF + n * 16); }
        asm volatile("" ::: "memory");
#pragma unroll
        for (int ai = 0; ai < 2; ++ai)
#pragma unroll
            for (int m = 0; m < 4; ++m) { const size_t off = (size_t)(u.pm * BM + ai * HALF + wr * 64 + m * 16 + fr) * ldc + col0;
#pragma unroll
                for (int bj = 0; bj < 2; ++bj)
#pragma unroll
                    for (int n = 0; n < 2; ++n) { const unsigned long long w = bs[ai][m][bj][n]; const unsigned lo = (unsigned)w, hi = (unsigned)(w >> 32);
                        f32x4 r; r[0] = __uint_as_float(lo << 16); r[1] = __uint_as_float(lo & 0xffff0000u); r[2] = __uint_as_float(hi << 16); r[3] = __uint_as_float(hi & 0xffff0000u);
                        *(f32x4*)(out + off + bj * HALF + n * 16) = r + acc[ai][bj][m][n]; } }
    }
};
template <class Epi, class Sched, bool ALIGN_EPI = false, bool SP2 = false>
__device__ __forceinline__ void gemm_phase(PG8_LAS unsigned char* lds, const Gemm g, const Sched& S, const Epi& E) {
    int tid_l = threadIdx.x; asm volatile("" : "+v"(tid_l));
    const int tid = tid_l, wid = __builtin_amdgcn_readfirstlane(tid >> 6), lane = tid & 63, wr = wid >> 2, wc = wid & 3, fr = lane & 15, fq = lane >> 4;
    const int K = g.K, nt = K / BK;
    unsigned voffA[2], voffB[2];
#pragma unroll
    for (int i = 0; i < 2; ++i) { int R, C; stage_rc(tid * 16 + i * 8192, R, C); const int Rb = Epi::PERM ? ((R & ~31) + perm32(R & 31)) : R;
        voffA[i] = (unsigned)(R * K + C) * 2u; voffB[i] = (unsigned)(Rb * K + C) * 2u; }
    const size_t kstep = (size_t)(BK * 2);
    const size_t hstep = (size_t)HALF * K * 2;
    const size_t tstep = 2 * hstep;
    const unsigned ldsw = (unsigned)wid * 1024u;
    const int aoff = lds_byte(wr * 64 + fr, fq * 8), boff = lds_byte(wc * 32 + fr, fq * 8);
#define PG8_SA(b, h) (((b) * 2 + (h)) * HTB)
#define PG8_SB(b, h) ((4 + (b) * 2 + (h)) * HTB)
#define PG8_STAGE(bufoff, gbase, voff) do { _Pragma("unroll") for (int _i = 0; _i < 2; ++_i) \
        __builtin_amdgcn_global_load_lds((const unsigned*)((const char*)(gbase) + (voff)[_i]), (PG8_LAS unsigned*)(lds + (bufoff) + ldsw + _i * 8192), 16, 0, 0); } while (0)
#define PG8_LDA(dst, b, h) do { _Pragma("unroll") for (int m = 0; m < 4; ++m) _Pragma("unroll") for (int k = 0; k < 2; ++k) dst[m][k] = *(const PG8_LAS bf16x8*)(lds + PG8_SA(b, h) + aoff + m * 2048 + k * 1024); } while (0)
#define PG8_LDB(dst, b, h) do { _Pragma("unroll") for (int n = 0; n < 2; ++n) _Pragma("unroll") for (int k = 0; k < 2; ++k) dst[n][k] = *(const PG8_LAS bf16x8*)(lds + PG8_SB(b, h) + boff + n * 2048 + k * 1024); } while (0)
#define PG8_MMA(ai, bj, At, Bt) do { __builtin_amdgcn_s_setprio(1); _Pragma("unroll") for (int m = 0; m < 4; ++m) _Pragma("unroll") for (int n = 0; n < 2; ++n) _Pragma("unroll") for (int k = 0; k < 2; ++k) \
        acc[ai][bj][m][n] = __builtin_amdgcn_mfma_f32_16x16x32_bf16(Bt[n][k], At[m][k], acc[ai][bj][m][n], 0, 0, 0); __builtin_amdgcn_s_setprio(0); } while (0)
#define PG8_WAIT_V(n) asm volatile("s_waitcnt vmcnt(" #n ")" ::: "memory")
#define PG8_WAIT_L(n) asm volatile("s_waitcnt lgkmcnt(" #n ")" ::: "memory")
#define PG8_BAR __builtin_amdgcn_s_barrier()
#define PG8_SCHED __builtin_amdgcn_sched_barrier(0)
    Unit cur, nxt; int ui = 0;
    if (!S.next(0, cur)) return;
    f32x4 acc[2][2][4][2];
#pragma unroll
    for (int a = 0; a < 2; ++a)
#pragma unroll
        for (int b = 0; b < 2; ++b)
#pragma unroll
            for (int m = 0; m < 4; ++m)
#pragma unroll
                for (int n = 0; n < 2; ++n) acc[a][b][m][n] = (f32x4){0.f, 0.f, 0.f, 0.f};
    bf16x8 At[4][2], B0[2][2], B1[2][2];
    const char* cA = (const char*)g.A + (size_t)cur.pm * tstep; const char* cB = (const char*)g.Bt + (size_t)cur.pn * tstep;
    S.a_ready(cur);
    if constexpr (SP2) {
        PG8_STAGE(PG8_SB(0, 0), cB, voffB); PG8_STAGE(PG8_SB(0, 1), cB + hstep, voffB); PG8_STAGE(PG8_SA(0, 0), cA, voffA); PG8_STAGE(PG8_SA(0, 1), cA + hstep, voffA);
        if (wr == 1) PG8_BAR;
        PG8_WAIT_V(2); PG8_BAR;
        PG8_STAGE(PG8_SB(1, 0), cB + kstep, voffB); PG8_STAGE(PG8_SA(1, 0), cA + kstep, voffA); PG8_STAGE(PG8_SB(1, 1), cB + hstep + kstep, voffB);
        PG8_WAIT_V(6); PG8_BAR;
    } else {
        PG8_STAGE(PG8_SB(0, 0), cB, voffB); PG8_STAGE(PG8_SA(0, 0), cA, voffA); PG8_STAGE(PG8_SB(0, 1), cB + hstep, voffB); PG8_STAGE(PG8_SA(0, 1), cA + hstep, voffA);
        if (wr == 1) PG8_BAR;
        PG8_WAIT_V(4); PG8_BAR;
        PG8_STAGE(PG8_SB(1, 0), cB + kstep, voffB); PG8_STAGE(PG8_SA(1, 0), cA + kstep, voffA); PG8_STAGE(PG8_SB(1, 1), cB + hstep + kstep, voffB);
        PG8_WAIT_V(6); PG8_BAR;
    }
    for (;;) {
        const bool has_next = S.next(ui + 1, nxt);
        const char* nA = has_next ? (const char*)g.A + (size_t)nxt.pm * tstep : cA; const char* nB = has_next ? (const char*)g.Bt + (size_t)nxt.pn * tstep : cB;
        for (int t = 0; t < nt; t += 2) {
            const bool last = (t == nt - 2);
            const char* a1 = cA + (size_t)(t + 1) * kstep;
            const char* a2 = last ? nA : cA + (size_t)(t + 2) * kstep; const char* b2 = last ? nB : cB + (size_t)(t + 2) * kstep;
            const char* a3 = a2 + kstep; const char* b3 = b2 + kstep;
            if (last && has_next) S.a_ready(nxt);
            if constexpr (SP2) {
            PG8_LDB(B0, 0, 0); PG8_LDB(B1, 0, 1); PG8_SCHED; PG8_LDA(At, 0, 0); PG8_STAGE(PG8_SA(1, 1), a1 + hstep, voffA);
            PG8_WAIT_V(8); PG8_WAIT_L(0); PG8_BAR; PG8_MMA(0, 0, At, B0); PG8_MMA(0, 1, At, B1); PG8_BAR; PG8_SCHED;
            PG8_LDA(At, 0, 1); PG8_STAGE(PG8_SB(0, 0), b2, voffB); PG8_STAGE(PG8_SB(0, 1), b2 + hstep, voffB); PG8_STAGE(PG8_SA(0, 0), a2, voffA);
            PG8_WAIT_V(8); PG8_WAIT_L(0); PG8_BAR; PG8_MMA(1, 0, At, B0); PG8_MMA(1, 1, At, B1); PG8_BAR; PG8_SCHED;
            PG8_LDB(B0, 1, 0); PG8_LDB(B1, 1, 1); PG8_SCHED; PG8_LDA(At, 1, 0); PG8_STAGE(PG8_SA(0, 1), a2 + hstep, voffA);
            PG8_WAIT_V(8); PG8_WAIT_L(0); PG8_BAR; PG8_MMA(0, 0, At, B0); PG8_MMA(0, 1, At, B1); PG8_BAR; PG8_SCHED;
            PG8_LDA(At, 1, 1); PG8_STAGE(PG8_SB(1, 0), b3, voffB); PG8_STAGE(PG8_SB(1, 1), b3 + hstep, voffB); PG8_STAGE(PG8_SA(1, 0), a3, voffA);
            PG8_WAIT_V(8); PG8_WAIT_L(0); PG8_BAR; PG8_MMA(1, 0, At, B0); PG8_MMA(1, 1, At, B1); PG8_BAR; PG8_SCHED;
            } else {
            PG8_LDB(B0, 0, 0); PG8_SCHED; PG8_LDA(At, 0, 0); PG8_STAGE(PG8_SA(1, 1), a1 + hstep, voffA);
            PG8_WAIT_L(8); PG8_BAR; PG8_WAIT_L(0); PG8_MMA(0, 0, At, B0); PG8_BAR; PG8_SCHED;
            PG8_LDB(B1, 0, 1); PG8_STAGE(PG8_SB(0, 0), b2, voffB);
            PG8_BAR; PG8_WAIT_L(0); PG8_MMA(0, 1, At, B1); PG8_BAR;
            PG8_LDA(At, 0, 1); PG8_STAGE(PG8_SA(0, 0), a2, voffA);
            PG8_BAR; PG8_WAIT_L(0); PG8_MMA(1, 0, At, B0); PG8_BAR; PG8_SCHED;
            PG8_STAGE(PG8_SB(0, 1), b2 + hstep, voffB);
            PG8_WAIT_V(6); PG8_BAR; PG8_MMA(1, 1, At, B1); PG8_BAR;
            PG8_LDB(B0, 1, 0); PG8_SCHED; PG8_LDA(At, 1, 0); PG8_STAGE(PG8_SA(0, 1), a2 + hstep, voffA);
            PG8_WAIT_L(8); PG8_BAR; PG8_WAIT_L(0); PG8_MMA(0, 0, At, B0); PG8_BAR; PG8_SCHED;
            PG8_LDB(B1, 1, 1); PG8_STAGE(PG8_SB(1, 0), b3, voffB);
            PG8_BAR; PG8_WAIT_L(0); PG8_MMA(0, 1, At, B1); PG8_BAR;
            PG8_LDA(At, 1, 1); PG8_STAGE(PG8_SA(1, 0), a3, voffA);
            PG8_BAR; PG8_WAIT_L(0); PG8_MMA(1, 0, At, B0); PG8_BAR; PG8_SCHED;
            PG8_STAGE(PG8_SB(1, 1), b3 + hstep, voffB);
            PG8_WAIT_V(6); PG8_BAR; PG8_MMA(1, 1, At, B1); PG8_BAR;
            }
        }
        if constexpr (ALIGN_EPI) { if (wr == 0) PG8_BAR; }
        if constexpr (!Epi::AFTER_DRAIN) { E(acc, cur, wr, wc, fr, fq); S.done(cur); }
        if (!has_next) break;
#pragma unroll
        for (int a = 0; a < 2; ++a)
#pragma unroll
            for (int b = 0; b < 2; ++b)
#pragma unroll
                for (int m = 0; m < 4; ++m)
#pragma unroll
                    for (int n = 0; n < 2; ++n) acc[a][b][m][n] = (f32x4){0.f, 0.f, 0.f, 0.f};
        cur = nxt; cA = nA; cB = nB; ++ui;
        if constexpr (ALIGN_EPI) { if (wr == 1) PG8_BAR; }
    }
    PG8_WAIT_V(0);
    if constexpr (!ALIGN_EPI) { if (wr == 0) PG8_BAR; }
    PG8_BAR;
    if constexpr (Epi::AFTER_DRAIN) { E.fused(acc, cur, wr, wc, fr, fq, lds, wid, lane); S.done(cur); }
#undef PG8_SA
#undef PG8_SB
#undef PG8_STAGE
#undef PG8_LDA
#undef PG8_LDB
#undef PG8_MMA
#undef PG8_WAIT_V
#undef PG8_WAIT_L
#undef PG8_BAR
#undef PG8_SCHED
}
}

#define LAS __attribute__((address_space(3)))
typedef unsigned short bf16_t;
typedef short bf16x8 __attribute__((ext_vector_type(8)));
typedef float f32x4 __attribute__((ext_vector_type(4)));
typedef float f32x16 __attribute__((ext_vector_type(16)));
typedef unsigned u32x4 __attribute__((ext_vector_type(4)));
typedef unsigned u32x2 __attribute__((ext_vector_type(2)));

constexpr int NB = 2, SEQ = 8192, MTOK = NB * SEQ, DM = 1024, NZ = 3600, NZP = 3840, DEPTH = 2;
constexpr int C_QA = 0, C_KA = 256, C_VA = 512, C_GA = 768, C_QB = 1024, C_KB = 1280, C_VB = 1536, C_GB = 1792;
constexpr int C_CA = 2048, C_CG = 2304, C_GC = 2560, C_QD = 2816, C_KD = 2944, C_VD = 3072, C_LR = 3328, C_GD = 3344;
constexpr float EPS = 1e-6f, LOG2E = 1.4426950408889634f, QSCALE = 0.125f * LOG2E;
constexpr int NTHR = 512, NWAVES = 8;
constexpr int LDS_BYTES = 155648;

#ifndef REP_PHASE
#define REP_PHASE -1
#endif
#ifndef N_LAUNCH_MODE
#define N_LAUNCH_MODE 1
#endif

constexpr size_t MiB = 1u << 20;
constexpr size_t WS_CTL = 0, CTL_ZERO_BYTES = 32 * 1024;
constexpr size_t WS_SSQ0 = 256 * 1024, WS_SSQ1 = 384 * 1024;
constexpr size_t WS_KM = 512 * 1024;
constexpr size_t WS_WIN = 1 * MiB;
constexpr size_t WIN_L = (size_t)NZP * DM * 2;
constexpr size_t WS_WOUT = 16 * MiB;
constexpr size_t WOUT_L = (size_t)DM * DM * 2;
constexpr size_t WS_WPW = 20 * MiB;
constexpr size_t WPW_L = 256 * 256 * 2;
constexpr size_t WS_BL = 20 * MiB + 768 * 1024;
constexpr size_t WS_DST = 21 * MiB;
constexpr size_t WS_KV = 23 * MiB;
constexpr size_t WS_PO = 32 * MiB;
constexpr size_t WS_H = 64 * MiB;
constexpr size_t WS_CC = 96 * MiB;
constexpr size_t WS_Z = 128 * MiB;
constexpr size_t WS_LIST = 248 * MiB;
constexpr size_t WS_END = 256 * MiB;
constexpr int C_DO = C_CA;
constexpr int C_PS = NZ;

__device__ __forceinline__ float bf2f(unsigned v) { return __uint_as_float(v << 16); }
typedef float f32x2c_t __attribute__((ext_vector_type(2))); typedef __bf16 bf16x2c_t __attribute__((ext_vector_type(2)));
__device__ __forceinline__ unsigned cvtpk_(float lo, float hi) { f32x2c_t v = {lo, hi}; bf16x2c_t b = __builtin_convertvector(v, bf16x2c_t); return __builtin_bit_cast(unsigned, b); }
__device__ __forceinline__ unsigned pk2(float lo, float hi) { return cvtpk_(lo, hi); }
__device__ __forceinline__ unsigned f2bf(float f) { return cvtpk_(f, 0.f) & 0xffffu; }
__device__ __forceinline__ void unpack8(const u32x4 a, float (&x)[8]) {
#pragma unroll
    for (int k = 0; k < 4; ++k) { x[2 * k] = bf2f(a[k] & 0xffffu); x[2 * k + 1] = bf2f(a[k] >> 16); }
}
__device__ __forceinline__ float wave_sum(float v) {
    return wave64_sum(v);
}
__device__ __forceinline__ float sigmoidf_(float x) { return __builtin_amdgcn_rcpf(1.0f + __expf(-x)); }
__device__ __forceinline__ float siluf_(float x) { return x * __builtin_amdgcn_rcpf(1.0f + __expf(-x)); }
__device__ __forceinline__ float logsigmoidf_(float x) { return x < 0.f ? x - log1pf(__expf(x)) : -log1pf(__expf(-x)); }
__device__ __forceinline__ int crow(int r, int hi) { return (r & 3) + 8 * (r >> 2) + 4 * hi; }
__device__ __forceinline__ float ex2(float x) { return __builtin_amdgcn_exp2f(x); }


struct LayerP {
    const float *norm_g, *qga, *kga, *qgb, *kgb, *conv_w, *conv_b, *ln_g, *ln_b, *pw_b, *gate_w, *gate_b, *gla_g;
    const bf16_t *WinT, *WoutT, *WpwT;
    const float* xin; float* xout;
};
struct Frame {
    LAS unsigned char* lds;
    int tid, lane, wave, G, bid;
    unsigned* ctl;
    bf16_t *H, *Z, *CC, *DOp, *PO; float *KMP, *BL, *DST, *KV, *PS; unsigned* LIST;
};

__device__ __forceinline__ void transpose_item(const float* W, int K, int N, int NPb, bf16_t* WT, LAS float* scr, int item, int lane, const float* kscale = nullptr) {
    const int nblk = NPb, kb = item / nblk, nb = item % nblk, k0 = 64 * kb, n0 = 32 * nb;
    const int nn = n0 + (lane & 31);
    float wv[32];
#pragma unroll
    for (int i = 0; i < 32; ++i) { const int kk = 2 * i + (lane >> 5); wv[i] = (nn < N) ? __builtin_nontemporal_load(W + (size_t)(k0 + kk) * N + nn) : 0.f; }
    if (kscale) {
#pragma unroll
        for (int i = 0; i < 32; ++i) wv[i] *= kscale[k0 + 2 * i + (lane >> 5)]; }
#pragma unroll
    for (int i = 0; i < 32; ++i) scr[(2 * i + (lane >> 5)) * 33 + (lane & 31)] = wv[i];
    asm volatile("s_waitcnt lgkmcnt(0)" ::: "memory");
    const int c = lane & 7;
#pragma unroll
    for (int j = 0; j < 4; ++j) { const int n = (lane >> 3) + 8 * j; const LAS float* s = scr + (8 * c) * 33 + n;
        u32x4 o; o.x = pk2(s[0 * 33], s[1 * 33]); o.y = pk2(s[2 * 33], s[3 * 33]); o.z = pk2(s[4 * 33], s[5 * 33]); o.w = pk2(s[6 * 33], s[7 * 33]);
        *(u32x4*)(WT + (size_t)(n0 + n) * K + k0 + 8 * c) = o; }
    asm volatile("s_waitcnt lgkmcnt(0)" ::: "memory");
}
__device__ __forceinline__ void cvt_row(const float* xrow, bf16_t* orow, float* ssq_out, int lane) {
    const f32x4* xr = (const f32x4*)xrow + lane;
    f32x4 v[4]; float s = 0.f;
#pragma unroll
    for (int j = 0; j < 4; ++j) { v[j] = xr[64 * j]; s += (v[j].x * v[j].x + v[j].y * v[j].y) + (v[j].z * v[j].z + v[j].w * v[j].w); }
    unsigned long long* o8 = (unsigned long long*)orow + lane;
#pragma unroll
    for (int j = 0; j < 4; ++j) o8[64 * j] = (unsigned long long)pk2(v[j].x, v[j].y) | ((unsigned long long)pk2(v[j].z, v[j].w) << 32);
    s = wave_sum(s);
    if (lane == 0) *ssq_out = s;
}

__device__ __forceinline__ void cvt_row2(const float* xrow, bf16_t* orow, float* ssq_out, size_t rstride, int lane) {
    f32x4 v[2][4];
#pragma unroll
    for (int t = 0; t < 2; ++t)
#pragma unroll
        for (int j = 0; j < 4; ++j) v[t][j] = __builtin_nontemporal_load((const f32x4*)(xrow + t * rstride * DM) + lane + 64 * j);
#pragma unroll
    for (int t = 0; t < 2; ++t) { float s = 0.f;
        unsigned long long* o8 = (unsigned long long*)(orow + t * rstride * DM) + lane;
#pragma unroll
        for (int j = 0; j < 4; ++j) { s += (v[t][j].x * v[t][j].x + v[t][j].y * v[t][j].y) + (v[t][j].z * v[t][j].z + v[t][j].w * v[t][j].w);
            o8[64 * j] = (unsigned long long)pk2(v[t][j].x, v[t][j].y) | ((unsigned long long)pk2(v[t][j].z, v[t][j].w) << 32); }
        s = wave_sum(s);
        if (lane == 0) ssq_out[t * rstride] = s; }
}

__device__ __forceinline__ float logsigmoid_fast(float x) { return fminf(x, 0.f) - __logf(1.0f + __expf(-fabsf(x))); }
constexpr int GL_BC = 0;
constexpr int GL_V = 64 * 132;
constexpr int GL_LR = GL_V + 64 * 260;
constexpr int GL_TOT = GL_LR + 64 * 20;
constexpr int GL_END = GL_TOT + 512;
static_assert(GL_END * 4 <= 140 * 1024, "GLA LDS");

__device__ __forceinline__ void gla_kv_item(const Frame& F, const LayerP& P, int it) {
    LAS float* S = (LAS float*)F.lds; LAS float* bcS = S + GL_BC; LAS float* vS = S + GL_V; LAS float* lrS = S + GL_LR; LAS float* totS = S + GL_TOT;
    const int m0 = it * 64, tid = F.tid, lane = F.lane;
    unsigned lrv; { const int idx = tid * 2, row = idx >> 4, c = idx & 15; lrv = *(const unsigned*)(F.Z + (size_t)(m0 + row) * NZP + C_LR + c); }
    const int cc = tid & 127, jg = tid >> 7;
    float wv[16];
#pragma unroll
    for (int r = 0; r < 16; ++r) wv[r] = P.gate_w[r * 128 + cc];
    const float bias = P.gate_b[cc];
    u32x4 qx[2], kx[2], vx[4];
#pragma unroll
    for (int i = 0; i < 2; ++i) { const int q = tid + 512 * i, j = q >> 4, c8 = q & 15; const bf16_t* zr = F.Z + (size_t)(m0 + j) * NZP + 8 * c8;
        qx[i] = *(const u32x4*)(zr + C_QD); kx[i] = *(const u32x4*)(zr + C_KD); }
#pragma unroll
    for (int i = 0; i < 4; ++i) { const int q = tid + 512 * i, j = q >> 5, c8 = q & 31; vx[i] = *(const u32x4*)(F.Z + (size_t)(m0 + j) * NZP + C_VD + 8 * c8); }
    __syncthreads();
    { const int idx = tid * 2, row = idx >> 4, c = idx & 15; lrS[row * 20 + c] = bf2f(lrv & 0xffffu); lrS[row * 20 + c + 1] = bf2f(lrv >> 16); }
#pragma unroll
    for (int i = 0; i < 4; ++i) { const int q = tid + 512 * i, j = q >> 5, c8 = q & 31; float x[8]; unpack8(vx[i], x);
        *(LAS f32x4*)(vS + j * 260 + 8 * c8) = (f32x4){x[0], x[1], x[2], x[3]}; *(LAS f32x4*)(vS + j * 260 + 8 * c8 + 4) = (f32x4){x[4], x[5], x[6], x[7]}; }
    __syncthreads();
    float loc[16]; float run = 0.f;
#pragma unroll
    for (int i = 0; i < 16; ++i) { const int j = jg * 16 + i; float x = bias;
#pragma unroll
        for (int r4 = 0; r4 < 4; ++r4) { const f32x4 lv = *(const LAS f32x4*)(lrS + j * 20 + 4 * r4);
            x += lv.x * wv[4 * r4] + lv.y * wv[4 * r4 + 1] + lv.z * wv[4 * r4 + 2] + lv.w * wv[4 * r4 + 3]; }
        run += logsigmoid_fast(x) * (1.0f / 16.0f); loc[i] = run; }
    totS[jg * 128 + cc] = run;
    __syncthreads();
    float off = 0.f;
    for (int gg = 0; gg < jg; ++gg) off += totS[gg * 128 + cc];
#pragma unroll
    for (int i = 0; i < 16; ++i) bcS[(jg * 16 + i) * 132 + cc] = off + loc[i];
    __syncthreads();
    float eb[2][8];
#pragma unroll
    for (int i = 0; i < 2; ++i) { const int c8 = (tid + 512 * i) & 15;
#pragma unroll
        for (int e = 0; e < 8; ++e) eb[i][e] = __expf(bcS[63 * 132 + 8 * c8 + e]); }
    if (tid < 128) F.BL[(size_t)it * 128 + tid] = bcS[63 * 132 + tid];
    __syncthreads();
#pragma unroll
    for (int i = 0; i < 2; ++i) { const int q = tid + 512 * i, j = q >> 4, c8 = q & 15; float xq[8], xk[8], yq[8], yk[8]; unpack8(qx[i], xq); unpack8(kx[i], xk);
        const f32x4 b0 = *(const LAS f32x4*)(bcS + j * 132 + 8 * c8), b1 = *(const LAS f32x4*)(bcS + j * 132 + 8 * c8 + 4);
        const float bcv[8] = {b0.x, b0.y, b0.z, b0.w, b1.x, b1.y, b1.z, b1.w}; float kh[8];
#pragma unroll
        for (int e = 0; e < 8; ++e) { const float e1 = __expf(bcv[e]), e2 = __builtin_amdgcn_rcpf(e1);
            yq[e] = xq[e] * 0.17677669529663687f * e1; yk[e] = xk[e] * e2;
            kh[e] = xk[e] * (eb[i][e] * e2); }
        *(LAS f32x4*)(bcS + j * 132 + 8 * c8) = (f32x4){kh[0], kh[1], kh[2], kh[3]}; *(LAS f32x4*)(bcS + j * 132 + 8 * c8 + 4) = (f32x4){kh[4], kh[5], kh[6], kh[7]};
        bf16_t* zr = F.Z + (size_t)(m0 + j) * NZP + 8 * c8;
        u32x4 o; o.x = pk2(yq[0], yq[1]); o.y = pk2(yq[2], yq[3]); o.z = pk2(yq[4], yq[5]); o.w = pk2(yq[6], yq[7]); *(u32x4*)(zr + C_QD) = o;
        o.x = pk2(yk[0], yk[1]); o.y = pk2(yk[2], yk[3]); o.z = pk2(yk[4], yk[5]); o.w = pk2(yk[6], yk[7]); *(u32x4*)(zr + C_KD) = o; }
    __syncthreads();
    const int h = F.wave >> 1, vh = F.wave & 1;
    f32x16 acc;
#pragma unroll
    for (int r = 0; r < 16; ++r) acc[r] = 0.f;
#pragma unroll 8
    for (int s = 0; s < 32; ++s) { const int ja = 2 * s + (lane >> 5);
        const float a = bcS[ja * 132 + h * 32 + (lane & 31)];
        const float b = vS[ja * 260 + h * 64 + 32 * vh + (lane & 31)];
        acc = __builtin_amdgcn_mfma_f32_32x32x2f32(a, b, acc, 0, 0, 0); }
    float* kvp = F.KV + ((size_t)it * 4 + h) * 2048;
#pragma unroll
    for (int r = 0; r < 16; ++r) { const int d = crow(r, lane >> 5); kvp[d * 64 + 32 * vh + (lane & 31)] = acc[r]; }
}

constexpr int GO_Q = 0;
constexpr int GO_K = 64 * 136 * 2;
constexpr int GO_VT = 2 * 64 * 136 * 2;
constexpr int GO_OUT = GO_VT + 256 * 72 * 2;
static_assert(GO_OUT + 64 * 260 * 4 <= 140 * 1024, "GLA out LDS");
__device__ __forceinline__ void gla_out_item(const Frame& F, const LayerP& P, int it) {
    LAS bf16_t* QtS = (LAS bf16_t*)(F.lds + GO_Q); LAS bf16_t* KtS = (LAS bf16_t*)(F.lds + GO_K); LAS bf16_t* VT = (LAS bf16_t*)(F.lds + GO_VT); LAS float* oS = (LAS float*)(F.lds + GO_OUT);
    const int m0 = it * 64, tid = F.tid, lane = F.lane, hf = lane >> 5, l31 = lane & 31;
    const int h = F.wave >> 1, ih = F.wave & 1;
    u32x4 qx[2], kx[2], vx[2][2], gx[4];
#pragma unroll
    for (int i = 0; i < 2; ++i) { const int q = tid + 512 * i, j = q >> 4, c8 = q & 15; const bf16_t* zr = F.Z + (size_t)(m0 + j) * NZP + 8 * c8;
        qx[i] = *(const u32x4*)(zr + C_QD); kx[i] = *(const u32x4*)(zr + C_KD); }
#pragma unroll
    for (int i = 0; i < 2; ++i) { const int q = tid + 512 * i, rp = q & 31, c8 = q >> 5; const bf16_t* zr = F.Z + (size_t)(m0 + 2 * rp) * NZP + C_VD + 8 * c8;
        vx[i][0] = *(const u32x4*)zr; vx[i][1] = *(const u32x4*)(zr + NZP); }
#pragma unroll
    for (int i = 0; i < 4; ++i) { const int q = tid + 512 * i, j = q >> 5, c8 = q & 31; gx[i] = *(const u32x4*)(F.Z + (size_t)(m0 + j) * NZP + C_GD + 8 * c8); }
    float sta[2][2][8];
    { const float* st = F.KV + ((size_t)it * 4 + h) * 2048;
#pragma unroll
      for (int vt = 0; vt < 2; ++vt)
#pragma unroll
          for (int s = 0; s < 2; ++s)
#pragma unroll
              for (int jj = 0; jj < 8; ++jj) sta[vt][s][jj] = st[(16 * s + 8 * hf + jj) * 64 + 32 * vt + l31]; }
    float gn[2][16];
#pragma unroll
    for (int vt = 0; vt < 2; ++vt)
#pragma unroll
        for (int r = 0; r < 16; ++r) gn[vt][r] = P.gla_g[32 * vt + crow(r, hf)];
    __syncthreads();
#pragma unroll
    for (int i = 0; i < 2; ++i) { const int q = tid + 512 * i, j = q >> 4, c8 = q & 15;
        *(LAS u32x4*)(QtS + j * 136 + 8 * c8) = qx[i]; *(LAS u32x4*)(KtS + j * 136 + 8 * c8) = kx[i]; }
#pragma unroll
    for (int i = 0; i < 2; ++i) { const int q = tid + 512 * i, rp = q & 31, c8 = q >> 5;
#pragma unroll
        for (int k = 0; k < 4; ++k) { const unsigned a = vx[i][0][k], b = vx[i][1][k];
            *(LAS unsigned*)(VT + (8 * c8 + 2 * k) * 72 + 2 * rp) = (a & 0xffffu) | (b << 16);
            *(LAS unsigned*)(VT + (8 * c8 + 2 * k + 1) * 72 + 2 * rp) = (a >> 16) | (b & 0xffff0000u); } }
    __syncthreads();
    bf16x8 qB[2];
#pragma unroll
    for (int s = 0; s < 2; ++s) qB[s] = *(const LAS bf16x8*)(QtS + (32 * ih + l31) * 136 + h * 32 + 16 * s + 8 * hf);
    f32x16 aT[2];
#pragma unroll
    for (int jt = 0; jt < 2; ++jt) {
#pragma unroll
        for (int r = 0; r < 16; ++r) aT[jt][r] = 0.f;
        if (jt <= ih) {
#pragma unroll
            for (int s = 0; s < 2; ++s) { const bf16x8 a = *(const LAS bf16x8*)(KtS + (32 * jt + l31) * 136 + h * 32 + 16 * s + 8 * hf);
                aT[jt] = __builtin_amdgcn_mfma_f32_32x32x16_bf16(a, qB[s], aT[jt], 0, 0, 0); }
#pragma unroll
            for (int r = 0; r < 16; ++r) { const int j = 32 * jt + crow(r, hf), i = 32 * ih + l31; if (j > i) aT[jt][r] = 0.f; }
        }
    }
    f32x16 oT[2];
#pragma unroll
    for (int vt = 0; vt < 2; ++vt) {
#pragma unroll
        for (int r = 0; r < 16; ++r) oT[vt][r] = 0.f;
#pragma unroll
        for (int s = 0; s < 2; ++s) { u32x4 sw; sw.x = cvtpk_(sta[vt][s][0], sta[vt][s][1]); sw.y = cvtpk_(sta[vt][s][2], sta[vt][s][3]); sw.z = cvtpk_(sta[vt][s][4], sta[vt][s][5]); sw.w = cvtpk_(sta[vt][s][6], sta[vt][s][7]);
            oT[vt] = __builtin_amdgcn_mfma_f32_32x32x16_bf16(__builtin_bit_cast(bf16x8, sw), qB[s], oT[vt], 0, 0, 0); }
#pragma unroll
        for (int jt = 0; jt < 2; ++jt) {
            if (jt <= ih) {
#pragma unroll
                for (int s = 0; s < 2; ++s) {
                    u32x4 pw; pw.x = cvtpk_(aT[jt][8 * s + 0], aT[jt][8 * s + 1]); pw.y = cvtpk_(aT[jt][8 * s + 2], aT[jt][8 * s + 3]); pw.z = cvtpk_(aT[jt][8 * s + 4], aT[jt][8 * s + 5]); pw.w = cvtpk_(aT[jt][8 * s + 6], aT[jt][8 * s + 7]);
                    const LAS bf16_t* vp = VT + (h * 64 + 32 * vt + l31) * 72 + 32 * jt + 16 * s + 4 * hf;
                    const u32x2 v0 = *(const LAS u32x2*)vp, v1 = *(const LAS u32x2*)(vp + 8);
                    u32x4 vv; vv.x = v0.x; vv.y = v0.y; vv.z = v1.x; vv.w = v1.y;
                    oT[vt] = __builtin_amdgcn_mfma_f32_32x32x16_bf16(__builtin_bit_cast(bf16x8, vv), __builtin_bit_cast(bf16x8, pw), oT[vt], 0, 0, 0); }
            }
        }
    }
    float ss = 0.f;
#pragma unroll
    for (int vt = 0; vt < 2; ++vt)
#pragma unroll
        for (int r = 0; r < 16; ++r) ss += oT[vt][r] * oT[vt][r];
    ss = xor32_sum(ss);
    const float rinv = __builtin_amdgcn_rsqf(ss * (1.0f / 64.0f) + EPS);
#pragma unroll
    for (int vt = 0; vt < 2; ++vt)
#pragma unroll
        for (int r = 0; r < 16; ++r) oS[(32 * ih + l31) * 260 + h * 64 + 32 * vt + crow(r, hf)] = (oT[vt][r] * rinv) * gn[vt][r];
    __syncthreads();
#pragma unroll
    for (int i = 0; i < 4; ++i) { const int q = tid + 512 * i, j = q >> 5, c8 = q & 31; float gg[8]; unpack8(gx[i], gg); float y[8];
        const f32x4 t0 = *(const LAS f32x4*)(oS + j * 260 + 8 * c8), t1 = *(const LAS f32x4*)(oS + j * 260 + 8 * c8 + 4); const float tv[8] = {t0.x, t0.y, t0.z, t0.w, t1.x, t1.y, t1.z, t1.w};
#pragma unroll
        for (int e = 0; e < 8; ++e) y[e] = tv[e] * siluf_(gg[e]);
        u32x4 o; o.x = pk2(y[0], y[1]); o.y = pk2(y[2], y[3]); o.z = pk2(y[4], y[5]); o.w = pk2(y[6], y[7]);
        *(u32x4*)(F.CC + (size_t)(m0 + j) * DM + 768 + 8 * c8) = o; }
}

constexpr int CV_U = 0;
constexpr int CV_A = 94 * 256 * 4;
static_assert(CV_A + 64 * 264 * 2 <= 140 * 1024, "conv LDS");
__device__ __forceinline__ void conv_item(const Frame& F, const LayerP& P, int it) {
    LAS float* uS = (LAS float*)F.lds; LAS bf16_t* aS = (LAS bf16_t*)(F.lds + CV_A);
    const int tid = F.tid, lane = F.lane, w = F.wave;
    const int b = it >> 7, t0 = (it & 127) * 64, m0 = it * 64;
    u32x4 ua[6], ug[6];
#pragma unroll
    for (int i = 0; i < 6; ++i) { const int q = tid + 512 * i, r = q >> 5, c8 = q & 31, tt = t0 - 30 + r;
        ua[i] = (u32x4){0u, 0u, 0u, 0u}; ug[i] = (u32x4){0u, 0u, 0u, 0u};
        if (q < 94 * 32 && tt >= 0) { const bf16_t* zr = F.Z + (size_t)(b * SEQ + tt) * NZP + 8 * c8; ua[i] = *(const u32x4*)(zr + C_CA); ug[i] = *(const u32x4*)(zr + C_CG); } }
    typedef float f32x2v __attribute__((ext_vector_type(2)));
    const int cp = tid & 127, tq = tid >> 7;

    __syncthreads();
#pragma unroll
    for (int i = 0; i < 6; ++i) { const int q = tid + 512 * i, r = q >> 5, c8 = q & 31;
        if (q < 94 * 32) { float xa[8], xg[8]; unpack8(ua[i], xa); unpack8(ug[i], xg);
#pragma unroll
            for (int e = 0; e < 8; ++e) xa[e] = xa[e] * sigmoidf_(xg[e]);
            *(LAS f32x4*)(uS + r * 256 + 8 * c8) = (f32x4){xa[0], xa[1], xa[2], xa[3]}; *(LAS f32x4*)(uS + r * 256 + 8 * c8 + 4) = (f32x4){xa[4], xa[5], xa[6], xa[7]}; } }
    __syncthreads();
    {
        f32x2v wk[31];
#pragma unroll
        for (int k = 0; k < 31; ++k) wk[k] = *(const f32x2v*)(P.conv_w + k * 256 + 2 * cp);
        const f32x2v cbias = *(const f32x2v*)(P.conv_b + 2 * cp);
#pragma nounroll
        for (int hh = 0; hh < 2; ++hh) { const int t0r = 16 * tq + 8 * hh;
            f32x2v u[38];
#pragma unroll
            for (int r = 0; r < 38; ++r) u[r] = *(const LAS f32x2v*)(uS + (t0r + r) * 256 + 2 * cp);
#pragma unroll
            for (int i = 0; i < 8; ++i) { f32x2v acc = wk[0] * u[i];
#pragma unroll
                for (int k = 1; k < 31; ++k) acc = __builtin_elementwise_fma(wk[k], u[i + k], acc);
                acc = acc + cbias;
                *(LAS unsigned*)(aS + (t0r + i) * 264 + 2 * cp) = pk2(acc.x, acc.y); } }
    }
    asm volatile("" ::: "memory"); __builtin_amdgcn_sched_barrier(0);
    const int n0 = 32 * w, fr = lane & 15, fq = lane >> 4;
    bf16x8 bfr[8][2];
#pragma unroll
    for (int ks = 0; ks < 8; ++ks)
#pragma unroll
        for (int nt = 0; nt < 2; ++nt) bfr[ks][nt] = *(const bf16x8*)(P.WpwT + (size_t)(n0 + 16 * nt + fr) * 256 + 32 * ks + 8 * fq);
    u32x4 gx[4];
#pragma unroll
    for (int i = 0; i < 4; ++i) { const int q = tid + 512 * i, j = q >> 5, c8 = q & 31; gx[i] = *(const u32x4*)(F.Z + (size_t)(m0 + j) * NZP + C_GC + 8 * c8); }
    float lg[4], lb[4];
#pragma unroll
    for (int j = 0; j < 4; ++j) { lg[j] = P.ln_g[lane + 64 * j]; lb[j] = P.ln_b[lane + 64 * j]; }
    __syncthreads();
#pragma unroll 2
    for (int i = 0; i < 8; ++i) { const int row = 8 * w + i;
        float x[4]; float s = 0.f;
#pragma unroll
        for (int j = 0; j < 4; ++j) { x[j] = bf2f(aS[row * 264 + lane + 64 * j]); s += x[j]; }
        const float mean = wave_sum(s) * (1.0f / 256.0f); float s2 = 0.f;
#pragma unroll
        for (int j = 0; j < 4; ++j) { x[j] -= mean; s2 += x[j] * x[j]; }
        const float rstd = __builtin_amdgcn_rsqf(wave_sum(s2) * (1.0f / 256.0f) + EPS);
#pragma unroll
        for (int j = 0; j < 4; ++j) { const float un = (x[j] * rstd) * lg[j] + lb[j];
            aS[row * 264 + lane + 64 * j] = (bf16_t)f2bf(siluf_(un)); } }
    __syncthreads();
    f32x4 acc[4][2];
#pragma unroll
    for (int m = 0; m < 4; ++m)
#pragma unroll
        for (int nt = 0; nt < 2; ++nt) acc[m][nt] = (f32x4){0.f, 0.f, 0.f, 0.f};
#pragma unroll
    for (int ks = 0; ks < 8; ++ks) {
#pragma unroll
        for (int m = 0; m < 4; ++m) { const bf16x8 af = *(const LAS bf16x8*)(aS + (16 * m + fr) * 264 + 32 * ks + 8 * fq);
#pragma unroll
            for (int nt = 0; nt < 2; ++nt) acc[m][nt] = __builtin_amdgcn_mfma_f32_16x16x32_bf16(af, bfr[ks][nt], acc[m][nt], 0, 0, 0); } }
#pragma unroll
    for (int m = 0; m < 4; ++m)
#pragma unroll
        for (int nt = 0; nt < 2; ++nt) { const int col = n0 + 16 * nt + fr; const float pb = P.pw_b[col];
#pragma unroll
            for (int r = 0; r < 4; ++r) uS[(16 * m + 4 * fq + r) * 260 + col] = acc[m][nt][r] + pb; }
    __syncthreads();
#pragma unroll
    for (int i = 0; i < 4; ++i) { const int q = tid + 512 * i, j = q >> 5, c8 = q & 31; float gg[8]; unpack8(gx[i], gg); float y[8];
        const f32x4 t0 = *(const LAS f32x4*)(uS + j * 260 + 8 * c8), t1 = *(const LAS f32x4*)(uS + j * 260 + 8 * c8 + 4); const float tv[8] = {t0.x, t0.y, t0.z, t0.w, t1.x, t1.y, t1.z, t1.w};
#pragma unroll
        for (int e = 0; e < 8; ++e) y[e] = tv[e] * siluf_(gg[e]);
        u32x4 o; o.x = pk2(y[0], y[1]); o.y = pk2(y[2], y[3]); o.z = pk2(y[4], y[5]); o.w = pk2(y[6], y[7]);
        *(u32x4*)(F.CC + (size_t)(m0 + j) * DM + 512 + 8 * c8) = o; }
}

typedef float f32x2_t __attribute__((ext_vector_type(2))); typedef __bf16 bf16x2_t __attribute__((ext_vector_type(2)));
__device__ __forceinline__ unsigned cvtpk(float lo, float hi) { f32x2_t v = {lo, hi}; bf16x2_t b = __builtin_convertvector(v, bf16x2_t); return __builtin_bit_cast(unsigned, b); }

struct AttnState { float m, l; f32x16 oT[2]; };
__device__ __forceinline__ void attn_init(AttnState& st) {
    st.m = -INFINITY; st.l = 0.f;
#pragma unroll
    for (int d0 = 0; d0 < 2; ++d0)
#pragma unroll
        for (int r = 0; r < 16; ++r) st.oT[d0][r] = 0.f;
}
__device__ __forceinline__ f32x16 attn_qk(const LAS bf16_t* Ks, int krow0, const bf16x8 (&qf)[4], const f32x16& cb, int l31, int hf) {
    f32x16 p = cb;
    bf16x8 a[4];
#pragma unroll
    for (int d0 = 0; d0 < 4; ++d0) a[d0] = *(const LAS bf16x8*)(Ks + (krow0 + l31) * 72 + 16 * d0 + 8 * hf);
    __builtin_amdgcn_s_setprio(1);
#pragma unroll
    for (int d0 = 0; d0 < 4; ++d0) p = __builtin_amdgcn_mfma_f32_32x32x16_bf16(a[d0], qf[d0], p, 0, 0, 0);
    __builtin_amdgcn_s_setprio(0);
    return p;
}
__device__ __forceinline__ float xhalf_max(float v) { const auto rr = __builtin_amdgcn_permlane32_swap(__float_as_uint(v), __float_as_uint(v), false, false); return fmaxf(__uint_as_float(rr[0]), __uint_as_float(rr[1])); }
__device__ __forceinline__ float xhalf_sum(float v) { const auto rr = __builtin_amdgcn_permlane32_swap(__float_as_uint(v), __float_as_uint(v), false, false); return __uint_as_float(rr[0]) + __uint_as_float(rr[1]); }
__device__ __forceinline__ void attn_softmax_pv(AttnState& st, f32x16 p, const LAS bf16_t* Vt, int vpitch, int kcol0, float coff, bool MASKED, int lo, int hi, int l31, int hf) {
    if (MASKED) {
#pragma unroll
        for (int r = 0; r < 16; ++r) { const int c = crow(r, hf); if (c < lo || c > hi) p[r] = -INFINITY; }
    }
    float mx = fmaxf(fmaxf(p[0], p[1]), p[2]);
#pragma unroll
    for (int r = 3; r < 15; r += 2) mx = fmaxf(fmaxf(mx, p[r]), p[r + 1]);
    mx = fmaxf(mx, p[15]);
    mx += coff;
    mx = xhalf_max(mx);
    if (__any(mx > st.m)) {
        const float mnew = fmaxf(st.m, mx);
        const float alpha = ex2(st.m - mnew);
        st.l *= alpha; st.m = mnew;
#pragma unroll
        for (int d0 = 0; d0 < 2; ++d0)
#pragma unroll
            for (int r = 0; r < 16; ++r) st.oT[d0][r] *= alpha;
    }
    const float c = coff - st.m;
    float ls = 0.f;
#pragma unroll
    for (int r = 0; r < 16; ++r) { p[r] = ex2(p[r] + c); ls += p[r]; }
    st.l += ls;
#pragma unroll
    for (int s = 0; s < 2; ++s) {
        u32x4 pw; pw.x = cvtpk(p[8 * s + 0], p[8 * s + 1]); pw.y = cvtpk(p[8 * s + 2], p[8 * s + 3]); pw.z = cvtpk(p[8 * s + 4], p[8 * s + 5]); pw.w = cvtpk(p[8 * s + 6], p[8 * s + 7]);
        const bf16x8 pb = __builtin_bit_cast(bf16x8, pw);
#pragma unroll
        for (int d0 = 0; d0 < 2; ++d0) {
            const LAS bf16_t* vp = Vt + (32 * d0 + l31) * vpitch + kcol0 + 16 * s + 4 * hf;
            const u32x2 v0 = *(const LAS u32x2*)vp, v1 = *(const LAS u32x2*)(vp + 8);
            u32x4 vv; vv.x = v0.x; vv.y = v0.y; vv.z = v1.x; vv.w = v1.y;
            st.oT[d0] = __builtin_amdgcn_mfma_f32_32x32x16_bf16(__builtin_bit_cast(bf16x8, vv), pb, st.oT[d0], 0, 0, 0); }
    }
}
struct TileP { int kk0; float coff; bool masked; int lo, hi; };
__device__ __forceinline__ void attn_pair(AttnState& st, const LAS bf16_t* Ks, const LAS bf16_t* Vt, int vpitch, const bf16x8 (&qf)[4], const f32x16& cb, const TileP A, const TileP B, int l31, int hf) {
    f32x16 pA = attn_qk(Ks, A.kk0, qf, cb, l31, hf);
    f32x16 pB = attn_qk(Ks, B.kk0, qf, cb, l31, hf);
    if (A.masked) {
#pragma unroll
        for (int r = 0; r < 16; ++r) { const int c = crow(r, hf); if (c < A.lo || c > A.hi) pA[r] = -INFINITY; }
    }
    if (B.masked) {
#pragma unroll
        for (int r = 0; r < 16; ++r) { const int c = crow(r, hf); if (c < B.lo || c > B.hi) pB[r] = -INFINITY; }
    }
    float ma = fmaxf(fmaxf(pA[0], pA[1]), pA[2]), mb = fmaxf(fmaxf(pB[0], pB[1]), pB[2]);
#pragma unroll
    for (int r = 3; r < 15; r += 2) { ma = fmaxf(fmaxf(ma, pA[r]), pA[r + 1]); mb = fmaxf(fmaxf(mb, pB[r]), pB[r + 1]); }
    ma = fmaxf(ma, pA[15]) + A.coff; mb = fmaxf(mb, pB[15]) + B.coff;
    const float mx = xhalf_max(fmaxf(ma, mb));
    if (__any(mx > st.m)) {
        const float mnew = fmaxf(st.m, mx);
        const float alpha = ex2(st.m - mnew);
        st.l *= alpha; st.m = mnew;
#pragma unroll
        for (int d0 = 0; d0 < 2; ++d0)
#pragma unroll
            for (int r = 0; r < 16; ++r) st.oT[d0][r] *= alpha;
    }
    const float ca = A.coff - st.m, cbb = B.coff - st.m;
    float ls = 0.f;
#pragma unroll
    for (int r = 0; r < 16; ++r) { pA[r] = ex2(pA[r] + ca); ls += pA[r]; }
#pragma unroll
    for (int s = 0; s < 2; ++s) {
        u32x4 pw; pw.x = cvtpk(pA[8 * s + 0], pA[8 * s + 1]); pw.y = cvtpk(pA[8 * s + 2], pA[8 * s + 3]); pw.z = cvtpk(pA[8 * s + 4], pA[8 * s + 5]); pw.w = cvtpk(pA[8 * s + 6], pA[8 * s + 7]);
        const bf16x8 pb = __builtin_bit_cast(bf16x8, pw);
#pragma unroll
        for (int d0 = 0; d0 < 2; ++d0) {
            const LAS bf16_t* vp = Vt + (32 * d0 + l31) * vpitch + A.kk0 + 16 * s + 4 * hf;
            const u32x2 v0 = *(const LAS u32x2*)vp, v1 = *(const LAS u32x2*)(vp + 8);
            u32x4 vv; vv.x = v0.x; vv.y = v0.y; vv.z = v1.x; vv.w = v1.y;
            st.oT[d0] = __builtin_amdgcn_mfma_f32_32x32x16_bf16(__builtin_bit_cast(bf16x8, vv), pb, st.oT[d0], 0, 0, 0); }
    }
#pragma unroll
    for (int r = 0; r < 16; ++r) { pB[r] = ex2(pB[r] + cbb); ls += pB[r]; }
    st.l += ls;
#pragma unroll
    for (int s = 0; s < 2; ++s) {
        u32x4 pw; pw.x = cvtpk(pB[8 * s + 0], pB[8 * s + 1]); pw.y = cvtpk(pB[8 * s + 2], pB[8 * s + 3]); pw.z = cvtpk(pB[8 * s + 4], pB[8 * s + 5]); pw.w = cvtpk(pB[8 * s + 6], pB[8 * s + 7]);
        const bf16x8 pb = __builtin_bit_cast(bf16x8, pw);
#pragma unroll
        for (int d0 = 0; d0 < 2; ++d0) {
            const LAS bf16_t* vp = Vt + (32 * d0 + l31) * vpitch + B.kk0 + 16 * s + 4 * hf;
            const u32x2 v0 = *(const LAS u32x2*)vp, v1 = *(const LAS u32x2*)(vp + 8);
            u32x4 vv; vv.x = v0.x; vv.y = v0.y; vv.z = v1.x; vv.w = v1.y;
            st.oT[d0] = __builtin_amdgcn_mfma_f32_32x32x16_bf16(__builtin_bit_cast(bf16x8, vv), pb, st.oT[d0], 0, 0, 0); }
    }
}
__device__ __forceinline__ void attn_store_row(const AttnState& st, float scale, bf16_t* dst, int hf) {
#pragma unroll
    for (int d0 = 0; d0 < 2; ++d0)
#pragma unroll
        for (int g = 0; g < 4; ++g) { u32x2 w; w.x = pk2(st.oT[d0][4 * g] * scale, st.oT[d0][4 * g + 1] * scale); w.y = pk2(st.oT[d0][4 * g + 2] * scale, st.oT[d0][4 * g + 3] * scale);
            *(u32x2*)(dst + 32 * d0 + 8 * g + 4 * hf) = w; }
}

constexpr int MB_KS = 0;
constexpr int MB_VT = 256 * 72 * 2;
constexpr int MB_KM = MB_VT + 64 * 260 * 2;
constexpr int MB_VP = 260;
constexpr int DL_KS = 0;
constexpr int DL_VT = 384 * 72 * 2;
constexpr int DL_VP = 388;
constexpr int AT_PREF = 120 * 1024;
static_assert(DL_VT + 64 * 388 * 2 <= AT_PREF && MB_KM + 32 * 64 * 4 <= AT_PREF, "attention LDS");
constexpr int LIST_CAP = 8192;

__device__ __forceinline__ void moba_topk_unit(const Frame& F, const LayerP& P, int b, int h, int qb, unsigned* cnt  , unsigned* list  ) {
    LAS float* kmS = (LAS float*)(F.lds + MB_KM);
    const int tid = F.tid, lane = F.lane, w = F.wave, l31 = lane & 31, hf = lane >> 5, bh = b * 4 + h;
    __syncthreads();
    for (int q = tid; q < qb * 64; q += 512) { const int n = q >> 6, d = q & 63;
        kmS[q] = __hip_atomic_load(F.KMP + ((size_t)(b * 32 + n)) * 256 + h * 64 + d, __ATOMIC_RELAXED, __HIP_MEMORY_SCOPE_AGENT) * (1.0f / 256.0f); }
    const int qpos = qb * 256 + 32 * w + l31;
    const size_t grow = (size_t)b * SEQ + qpos;
    float qv[32];
#pragma unroll
    for (int d0 = 0; d0 < 4; ++d0) { const u32x4 a = *(const u32x4*)(F.Z + grow * NZP + C_QA + h * 64 + 16 * d0 + 8 * hf);
#pragma unroll
        for (int k = 0; k < 4; ++k) { qv[d0 * 8 + 2 * k] = bf2f(a[k] & 0xffffu); qv[d0 * 8 + 2 * k + 1] = bf2f(a[k] >> 16); } }
    __syncthreads();
    float v0 = -INFINITY, v1 = -INFINITY, v2 = -INFINITY; int i0 = -1, i1 = -1, i2 = -1;
    for (int n = 0; n < qb; ++n) { float g = 0.f;
#pragma unroll
        for (int d0 = 0; d0 < 4; ++d0) { const f32x4 k0 = *(const LAS f32x4*)(kmS + n * 64 + 16 * d0 + 8 * hf), k1 = *(const LAS f32x4*)(kmS + n * 64 + 16 * d0 + 8 * hf + 4);
            g += qv[d0 * 8 + 0] * k0.x + qv[d0 * 8 + 1] * k0.y + qv[d0 * 8 + 2] * k0.z + qv[d0 * 8 + 3] * k0.w + qv[d0 * 8 + 4] * k1.x + qv[d0 * 8 + 5] * k1.y + qv[d0 * 8 + 6] * k1.z + qv[d0 * 8 + 7] * k1.w; }
        g = xor32_sum(g);
        if (g > v0) { v2 = v1; i2 = i1; v1 = v0; i1 = i0; v0 = g; i0 = n; }
        else if (g > v1) { v2 = v1; i2 = i1; v1 = g; i1 = n; }
        else if (g > v2) { v2 = g; i2 = n; } }
    float gq = fabsf(P.qga[lane]), gk = fabsf(P.kga[lane]);
    gq = wave64_max(gq); gk = wave64_max(gk);
    const float B2 = 2.04f * 64.0f * gq * gk * QSCALE, slope2 = exp2f(-(float)(2 * h + 1)) * LOG2E;
    const bool z0 = i0 >= 0 && (B2 - slope2 * (float)(qpos - 256 * i0 - 255)) < -152.0f;
    const bool z1 = i1 >= 0 && (B2 - slope2 * (float)(qpos - 256 * i1 - 255)) < -152.0f;
    const bool z2 = i2 >= 0 && (B2 - slope2 * (float)(qpos - 256 * i2 - 255)) < -152.0f;
    if (z0) i0 = -1;
    if (z1) i1 = -1;
    if (z2) i2 = -1;
    unsigned mymask = 0u;
    for (int n = 0; n < qb; ++n) {
        const unsigned long long mask = __ballot(hf == 0 && (n == i0 || n == i1 || n == i2));
        if (lane == n) mymask = (unsigned)mask;
    }
    unsigned mybase = 0u;
    if (mymask != 0u) mybase = atomicAdd(cnt + bh * 32 + lane, (unsigned)__popc(mymask));
    {
        const unsigned below = (1u << l31) - 1u;
        const int sel[3] = {i0, i1, i2};
#pragma unroll
        for (int k = 0; k < 3; ++k) {
            const int n = sel[k] < 0 ? 0 : sel[k];
            const unsigned mk = (unsigned)__shfl((int)mymask, n), bs = (unsigned)__shfl((int)mybase, n);
            if (hf == 0 && sel[k] >= 0) { const int pos = (int)bs + __popc(mk & below);
                if (pos < LIST_CAP) list[((size_t)bh * 32 + n) * LIST_CAP + pos] = ((unsigned)qpos << 2) | (unsigned)k; }
        }
    }
    if (hf == 0) { float* ps = F.PS + grow * (NZP / 2) + h * 8;
        float ninf = -1e30f, zer = 0.f; asm volatile("" : "+v"(ninf), "+v"(zer));
        if (i0 < 0) { ps[0] = ninf; ps[1] = zer; }
        if (i1 < 0) { ps[2] = ninf; ps[3] = zer; }
        if (i2 < 0) { ps[4] = ninf; ps[5] = zer; } }
}

constexpr int AT_KS = 0, AT_VT = 384 * 72 * 2, AT_VP = 388;
struct AttDesc {
    int kind;
    int b, h, n, tile, cnt, pr;
    int pat, dil, g, u;
    int nrows, first_valid; long long row0, rstride;
    int kcol, vcol;
};
__device__ __forceinline__ AttDesc att_decode(int j, int total, const LAS int* pref, const unsigned* cnt) {
    AttDesc D; D.kind = 0; D.b = 0; D.h = 0; D.n = 0; D.tile = 0; D.cnt = 0; D.pr = 0; D.pat = 0; D.dil = 1; D.g = 0; D.u = 0;
    if (j < total + 256) {
        int pr, tile;
        if (j < total) { int lo = 0, hi = 255;
            while (lo < hi) { const int mid = (lo + hi + 1) >> 1; if (pref[mid] <= j) lo = mid; else hi = mid - 1; }
            pr = lo; tile = j - pref[pr] + 1; D.kind = 0;
        } else { const int u = j - total; pr = (u & 7) * 32 + (u >> 3); tile = 0; D.kind = 1; }
        D.cnt = pref[272 + pr];
        D.pr = pr; D.tile = tile; D.b = pr >> 7; D.h = (pr >> 5) & 3; D.n = pr & 31;
        D.nrows = 256; D.first_valid = 0; D.row0 = (long long)D.b * SEQ + D.n * 256; D.rstride = 1; D.kcol = C_KA + D.h * 64; D.vcol = C_VA + D.h * 64;
    } else {
        const int q = j - total - 256; D.kind = 2; D.pat = q >> 8; const int r = q & 255; D.b = (r >> 2) & 1; D.h = r & 3; const int uidx = r >> 3;
        D.dil = (D.pat == 0) ? 1 : (D.pat == 1 ? 4 : 16);
        const int upg = 32 / D.dil; D.g = uidx / upg; D.u = uidx % upg;
        const int i0 = 256 * D.u - 128;
        D.nrows = 384; D.first_valid = (i0 < 0) ? 128 : 0; D.row0 = (long long)D.b * SEQ + (long long)i0 * D.dil + D.g; D.rstride = D.dil; D.kcol = C_KB + D.h * 64; D.vcol = C_VB + D.h * 64;
    }
    return D;
}
struct StageRegs { u32x4 kx[2][2], vx[2][2]; };
__device__ __forceinline__ void att_stage_issue(StageRegs& R, int tid, const bf16_t* Z, const AttDesc& D) {
#pragma unroll
    for (int i = 0; i < 2; ++i) { const int q = tid + 512 * i, r = (q >> 3) * 2, c8 = q & 7;
#pragma unroll
        for (int e = 0; e < 2; ++e) { R.kx[i][e] = (u32x4){0u, 0u, 0u, 0u}; R.vx[i][e] = (u32x4){0u, 0u, 0u, 0u};
            if (r + e >= D.first_valid) { const bf16_t* zr = Z + (size_t)(D.row0 + (long long)(r + e) * D.rstride) * NZP + 8 * c8;
                R.kx[i][e] = *(const u32x4*)(zr + D.kcol); R.vx[i][e] = *(const u32x4*)(zr + D.vcol); } } }
}
__device__ __forceinline__ void att_stage_put(const u32x4 (&kx)[2], const u32x4 (&vx)[2], int r, int c8, LAS bf16_t* Ks, LAS bf16_t* Vt) {
    *(LAS u32x4*)(Ks + r * 72 + 8 * c8) = kx[0]; *(LAS u32x4*)(Ks + (r + 1) * 72 + 8 * c8) = kx[1];
#pragma unroll
    for (int k = 0; k < 4; ++k) { const unsigned a = vx[0][k], b = vx[1][k];
        *(LAS unsigned*)(Vt + (8 * c8 + 2 * k) * AT_VP + r) = (a & 0xffffu) | (b << 16);
        *(LAS unsigned*)(Vt + (8 * c8 + 2 * k + 1) * AT_VP + r) = (a >> 16) | (b & 0xffff0000u); }
}
struct StageTail { u32x4 k3[2], v3[2]; };
__device__ __forceinline__ void att_stage_tail_issue(StageTail& T3, int tid, const bf16_t* Z, const AttDesc& D) {
    const int q3 = tid + 1024, r3 = (q3 >> 3) * 2, c83 = q3 & 7;
#pragma unroll
    for (int e = 0; e < 2; ++e) { T3.k3[e] = (u32x4){0u, 0u, 0u, 0u}; T3.v3[e] = (u32x4){0u, 0u, 0u, 0u};
        if (D.nrows > 256) { const bf16_t* zr = Z + (size_t)(D.row0 + (long long)(r3 + e) * D.rstride) * NZP + 8 * c83; T3.k3[e] = *(const u32x4*)(zr + D.kcol); T3.v3[e] = *(const u32x4*)(zr + D.vcol); } }
}
__device__ __forceinline__ void att_stage_write(const StageRegs& R, const StageTail& T3, int tid, const AttDesc& D, LAS bf16_t* Ks, LAS bf16_t* Vt) {
#pragma unroll
    for (int i = 0; i < 2; ++i) { const int q = tid + 512 * i, r = (q >> 3) * 2, c8 = q & 7; att_stage_put(R.kx[i], R.vx[i], r, c8, Ks, Vt); }
    if (D.nrows > 256) { const int q3 = tid + 1024, r3 = (q3 >> 3) * 2, c83 = q3 & 7; att_stage_put(T3.k3, T3.v3, r3, c83, Ks, Vt); }
}
__device__ __forceinline__ unsigned att_entry_issue(const AttDesc& D, const unsigned* LIST, int w, int l31) {
    if (D.kind == 2) return 0u;
    const int idx0 = D.tile * 256 + 32 * w;
    if (idx0 >= D.cnt) return 0u;
    const int idx = idx0 + l31;
    return LIST[(size_t)D.pr * LIST_CAP + (idx < D.cnt ? idx : idx0)];
}
__device__ __forceinline__ void att_compute(const Frame& F, const AttDesc& D, const int mode  , unsigned entry, const bf16x8 (&qf)[4], size_t grow, int qpos) {
    const LAS bf16_t* Ks = (const LAS bf16_t*)(F.lds + AT_KS); const LAS bf16_t* Vt = (const LAS bf16_t*)(F.lds + AT_VT);
    const int lane = F.lane, w = F.wave, l31 = lane & 31, hf = lane >> 5;
    const bool dilk = mode == 2, own = mode == 1;
    const int idx0 = D.tile * 256 + 32 * w;
    if (mode == 0 && idx0 >= D.cnt) return;
    const float slope2 = dilk ? exp2f(-(float)(2 * D.h + 2)) * LOG2E * (float)D.dil : exp2f(-(float)(2 * D.h + 1)) * LOG2E;
    f32x16 cb;
#pragma unroll
    for (int r = 0; r < 16; ++r) cb[r] = slope2 * (float)crow(r, hf);
    const int i0 = 256 * D.u - 128;
    AttnState st; attn_init(st);
    int jmin = 0; if (dilk) { jmin = (-i0 - 32 * w + 31) >> 5; jmin = jmin < 0 ? 0 : jmin; }
    const int ntile = dilk ? (5 - jmin) : (own ? (w + 1) : 8);
    auto tile_params = [&](int s) -> TileP { TileP T;
        if (dilk) { const int j = 4 - s; T.kk0 = 32 * w + 32 * j; T.coff = -slope2 * (float)(l31 + 128 - 32 * j); T.masked = (j == 4 || j == 0); T.lo = l31 - 32 * j; T.hi = l31 + 128 - 32 * j; }
        else { T.kk0 = 32 * s; T.coff = slope2 * (float)(D.n * 256 + 32 * s - qpos); T.masked = own && (s == w); T.lo = -1; T.hi = l31; }
        return T; };
    int s = 0;
#pragma nounroll
    for (; s + 1 < ntile; s += 2) attn_pair(st, Ks, Vt, AT_VP, qf, cb, tile_params(s), tile_params(s + 1), l31, hf);
    if (s < ntile) { const TileP T = tile_params(s);
        const f32x16 pc = attn_qk(Ks, T.kk0, qf, cb, l31, hf);
        attn_softmax_pv(st, pc, Vt, AT_VP, T.kk0, T.coff, T.masked, T.lo, T.hi, l31, hf); }
    const float ltot = xhalf_sum(st.l);
    if (dilk) {
        attn_store_row(st, __builtin_amdgcn_rcpf(ltot), F.DOp + grow * NZP + D.pat * 256 + D.h * 64, hf);
        if (hf == 0) { float* sp = F.DST + (((size_t)D.pat * MTOK + grow) * 4 + D.h) * 2; sp[0] = st.m; sp[1] = ltot; }
    } else {
        const bool valid = own || (idx0 + l31 < D.cnt);
        const int slot = own ? 3 : (int)(entry & 3u);
        if (valid) {
            attn_store_row(st, __builtin_amdgcn_rcpf(ltot), F.PO + (((size_t)slot * MTOK + grow) * 4 + D.h) * 64, hf);
            if (hf == 0) { float* ps = F.PS + grow * (NZP / 2) + D.h * 8 + slot * 2; ps[0] = st.m; ps[1] = ltot; } }
    }
}
__device__ __forceinline__ void att_phase(const Frame& F, const unsigned* cnt, unsigned* dctr  ) {
    LAS int* pref = (LAS int*)(F.lds + AT_PREF);
    LAS bf16_t* Ks = (LAS bf16_t*)(F.lds + AT_KS); LAS bf16_t* Vt = (LAS bf16_t*)(F.lds + AT_VT);
    const int lane = F.lane, w = F.wave, l31 = lane & 31, hf = lane >> 5;
    LAS int* dq = pref + 530;
    __syncthreads();
    if (F.tid == 0) dq[0] = (int)atomicAdd(dctr, 1u);
    {
        int T = 0;
        if (F.tid < 256) { int c = (int)__hip_atomic_load(cnt + F.tid, __ATOMIC_RELAXED, __HIP_MEMORY_SCOPE_AGENT); c = c > LIST_CAP ? LIST_CAP : c; pref[272 + F.tid] = c; T = ((c + 255) >> 8) - 1; T = T < 0 ? 0 : T; }
        int x = T;
#pragma unroll
        for (int o = 1; o < 64; o <<= 1) { const int y = __shfl_up(x, o); if (lane >= o) x += y; }
        if (lane == 63) pref[264 + w] = x;
        __syncthreads();
        int off = 0;
        for (int ww = 0; ww < w; ++ww) off += pref[264 + ww];
        if (F.tid < 256) pref[F.tid] = x + off - T;
        if (F.tid == 255) pref[256] = x + off;
        __syncthreads();
    }
    const int total = pref[256], NS = total + 256;
    const int vcu = (F.G % 8 == 0) ? (F.bid % 8) * (F.G / 8) + F.bid / 8 : F.bid;
    int j = vcu, nd = 0; bool isdyn = false;
    if (j >= NS) { const int d = dq[0]; nd = 1; isdyn = true; if (d >= 768) return; j = NS + d; if (F.tid == 0) dq[1] = (int)atomicAdd(dctr, 1u); }
    AttDesc D = att_decode(j, total, pref, cnt);
    StageRegs R; att_stage_issue(R, F.tid, F.Z, D);
    unsigned entry = att_entry_issue(D, F.LIST, w, l31);
    for (;;) {
        int qpos; size_t grow; int qcol;
        if (D.kind == 2) { const int iq = 256 * D.u + 32 * w + l31; qpos = iq; grow = (size_t)D.b * SEQ + (size_t)iq * D.dil + D.g; qcol = C_QB + D.h * 64; }
        else { qpos = (D.kind == 1) ? (D.n * 256 + 32 * w + l31) : (int)(entry >> 2); grow = (size_t)D.b * SEQ + qpos; qcol = C_QA + D.h * 64; }
        bf16x8 qf[4];
#pragma unroll
        for (int d0 = 0; d0 < 4; ++d0) qf[d0] = *(const bf16x8*)(F.Z + grow * NZP + qcol + 16 * d0 + 8 * hf);
        const bool two = (D.kind == 1) && (D.cnt > 0);
        const int qpos2 = (int)(entry >> 2); const size_t grow2 = (size_t)D.b * SEQ + qpos2;
        StageTail T3; att_stage_tail_issue(T3, F.tid, F.Z, D);
        __syncthreads();
        att_stage_write(R, T3, F.tid, D, Ks, Vt);
        __syncthreads();
        int jn; bool have_n; int fd = 0; bool fetched = false;
        if (!isdyn && j + F.G < NS) { jn = j + F.G; have_n = true; }
        else { const int d = dq[nd & 1]; ++nd; isdyn = true; have_n = d < 768; jn = NS + d;
            if (have_n) { fetched = true; if (F.tid == 0) fd = (int)atomicAdd(dctr, 1u); } }
        AttDesc Dn = D; unsigned entry_n = 0u;
        if (have_n) { Dn = att_decode(jn, total, pref, cnt); att_stage_issue(R, F.tid, F.Z, Dn); entry_n = att_entry_issue(Dn, F.LIST, w, l31); }
        const int npass = two ? 2 : 1;
#pragma nounroll
        for (int pass = 0; pass < npass; ++pass) {
            const int mode = (pass == 1) ? 0 : D.kind;
            att_compute(F, D, mode, entry, qf, pass ? grow2 : grow, pass ? qpos2 : qpos);
            if (pass + 1 < npass) {
#pragma unroll
                for (int d0 = 0; d0 < 4; ++d0) qf[d0] = *(const bf16x8*)(F.Z + grow2 * NZP + qcol + 16 * d0 + 8 * hf); }
        }
        if (fetched && F.tid == 0) dq[nd & 1] = fd;
        if (!have_n) break;
        D = Dn; entry = entry_n; j = jn;
    }
    __syncthreads();
}

template <int NP, int NB>
__device__ __forceinline__ void combine_items(const Frame& F, int item0, int istride, int nitems, const bf16_t* PO, size_t o_row, size_t o_head, size_t o_part, const float* PS, size_t s_row, size_t s_head, size_t s_part, int zgate_col, int cc_col) {
    float m[NB][NP], l[NB][NP]; u32x4 ox[NB][NP], gz[NB];
#pragma unroll
    for (int k = 0; k < NB; ++k) { const int item = item0 + k * istride; const int idx = (item < nitems ? item : item0) * 512 + F.tid; const size_t row = (size_t)(idx >> 5); const int h = (idx >> 3) & 3, c8 = idx & 7;
#pragma unroll
        for (int pp = 0; pp < NP; ++pp) { const float* sp = PS + row * s_row + h * s_head + pp * s_part; m[k][pp] = sp[0]; l[k][pp] = sp[1]; }
        gz[k] = *(const u32x4*)(F.Z + row * NZP + zgate_col + h * 64 + 8 * c8); }
#pragma unroll
    for (int k = 0; k < NB; ++k) { const int item = item0 + k * istride; const int idx = (item < nitems ? item : item0) * 512 + F.tid; const size_t row = (size_t)(idx >> 5); const int h = (idx >> 3) & 3, c8 = idx & 7;
#pragma unroll
        for (int pp = 0; pp < NP; ++pp) { ox[k][pp] = (u32x4){0u, 0u, 0u, 0u};
            if (l[k][pp] > 0.f) ox[k][pp] = __builtin_nontemporal_load((const u32x4*)(PO + row * o_row + h * o_head + pp * o_part + 8 * c8)); } }
#pragma unroll
    for (int k = 0; k < NB; ++k) { const int item = item0 + k * istride; if (item >= nitems) continue;
        const int idx = item * 512 + F.tid; const size_t row = (size_t)(idx >> 5); const int h = (idx >> 3) & 3, c8 = idx & 7;
        float mm = m[k][0];
#pragma unroll
        for (int pp = 1; pp < NP; ++pp) mm = fmaxf(mm, m[k][pp]);
        float wsum = 0.f; float o[8];
#pragma unroll
        for (int e = 0; e < 8; ++e) o[e] = 0.f;
#pragma unroll
        for (int pp = 0; pp < NP; ++pp) { const float wgt = (l[k][pp] > 0.f) ? l[k][pp] * ex2(m[k][pp] - mm) : 0.f; wsum += wgt;
            float x[8]; unpack8(ox[k][pp], x);
#pragma unroll
            for (int e = 0; e < 8; ++e) o[e] += wgt * x[e]; }
        const float rw = __builtin_amdgcn_rcpf(wsum);
        float gx[8]; unpack8(gz[k], gx);
        float y[8];
#pragma unroll
        for (int e = 0; e < 8; ++e) y[e] = o[e] * rw * siluf_(gx[e]);
        u32x4 ov; ov.x = pk2(y[0], y[1]); ov.y = pk2(y[2], y[3]); ov.z = pk2(y[4], y[5]); ov.w = pk2(y[6], y[7]);
        *(u32x4*)(F.CC + row * DM + cc_col + h * 64 + 8 * c8) = ov; }
}

__device__ __forceinline__ void gla_scan_item2(const Frame& F, int sc, const int rep = 0) {
    LAS float* S = (LAS float*)F.lds;
    const int lane = F.lane, w = F.wave;
    const int gidx = sc * 64 + lane, b = gidx >> 13, rem = gidx & 8191, hd = rem >> 6;
    float* kv = F.KV + ((size_t)b * 128 + 16 * w) * 8192 + rem; const float* bl = F.BL + ((size_t)b * 128 + 16 * w) * 128 + hd;
    float kvv[16], dec[16];
#pragma unroll
    for (int u = 0; u < 16; ++u) { kvv[u] = kv[(size_t)u * 8192]; dec[u] = bl[u * 128]; }
    float A = 1.f, Sx = 0.f;
#pragma unroll
    for (int u = 0; u < 16; ++u) { dec[u] = __expf(dec[u]); Sx = dec[u] * Sx + kvv[u]; A *= dec[u]; }
    __syncthreads();
    S[(w * 2 + 0) * 64 + lane] = A; S[(w * 2 + 1) * 64 + lane] = Sx;
    __syncthreads();
    float X = 0.f;
    for (int ww = 0; ww < w; ++ww) X = S[(ww * 2) * 64 + lane] * X + S[(ww * 2 + 1) * 64 + lane];
#pragma unroll
    for (int u = 0; u < 16; ++u) { if (!rep) kv[(size_t)u * 8192] = X; X = dec[u] * X + kvv[u]; }
    if (rep) asm volatile("" :: "v"(X));
    __syncthreads();
}

#define XB_TMO      128
#define XB_XCNT(j)  (256  + 64 * (j))
#define XB_XSUB(j)  (1280 + 64 * (j))
#define XB_XGEN(j)  (2304 + 64 * (j))
#define XB_TOP      3328
#define XB_TOPGEN   3392
#define XCD_BAR_WORDS 3456
#define XB_SPIN_CAP (1u << 18)

__device__ __forceinline__ unsigned xb_ld(unsigned* p)              { return __hip_atomic_load(p, __ATOMIC_RELAXED, __HIP_MEMORY_SCOPE_AGENT); }
__device__ __forceinline__ unsigned xb_add(unsigned* p, unsigned v) { return __hip_atomic_fetch_add(p, v, __ATOMIC_RELAXED, __HIP_MEMORY_SCOPE_AGENT); }
__device__ __forceinline__ unsigned xb_xcc_id() { return (unsigned)__builtin_amdgcn_s_getreg((3 << 11) | 20) & 0xFu; }
#define XB_SPIN(cond, bar) do { unsigned _sp = 0; while (cond) { __builtin_amdgcn_s_sleep(1); \
    if ((++_sp & 255u) == 0u) { if (xb_ld(&(bar)[XB_TMO])) break; if (_sp > XB_SPIN_CAP) { atomicAdd(&(bar)[XB_TMO], 1u); break; } } } } while (0)

struct XcdBarrier {
    unsigned* bar; unsigned x;
    volatile LAS unsigned* st;
};

__device__ __forceinline__ XcdBarrier xcd_barrier_post(unsigned* bar, volatile LAS unsigned* st) {
    XcdBarrier b; b.bar = bar; b.x = xb_xcc_id(); b.st = st;
    if (threadIdx.x == 0) (void)xb_add(&bar[XB_XCNT(b.x)], 1u);
    return b;
}
__device__ __forceinline__ void xcd_barrier_complete(unsigned* bar, unsigned x, unsigned& nloc, unsigned& nx) {
    const unsigned G = gridDim.x * gridDim.y * gridDim.z;
    unsigned sum, cnt, mine, sp = 0u;
    for (;;) {
        sum = 0u; cnt = 0u; mine = 0u;
#pragma unroll
        for (unsigned j = 0; j < 16; ++j) { const unsigned c = xb_ld(&bar[XB_XCNT(j)]); sum += c; cnt += (c > 0u) ? 1u : 0u; mine = (j == x) ? c : mine; }
        if (sum == G) break;
        __builtin_amdgcn_s_sleep(1);
        if ((++sp & 255u) == 0u) { if (xb_ld(&bar[XB_TMO])) break; if (sp > XB_SPIN_CAP) { atomicAdd(&bar[XB_TMO], 1u); break; } }
    }
    nloc = mine > 0u ? mine : 1u; nx = cnt > 0u ? cnt : 1u;
}

__device__ __forceinline__ void xcd_barrier(const XcdBarrier& b) {
    asm volatile("s_waitcnt vmcnt(0)" ::: "memory");
    __syncthreads();
    if (threadIdx.x == 0) {
        unsigned* bar = b.bar;
        __builtin_amdgcn_s_waitcnt(0);
        unsigned nloc = b.st[0], nx = b.st[1];
        if (nloc == 0u) { xcd_barrier_complete(bar, b.x, nloc, nx); b.st[0] = nloc; b.st[1] = nx; }
        const unsigned old = xb_add(&bar[XB_XSUB(b.x)], 1u);
        const unsigned gen = old / nloc;
        if (old + 1u == (gen + 1u) * nloc) {
            __builtin_amdgcn_fence(__ATOMIC_RELEASE, "agent");
            asm volatile("s_waitcnt vmcnt(0)" ::: "memory");
            const unsigned og = xb_add(&bar[XB_TOP], 1u);
            const unsigned tg = og / nx;
            if (og + 1u == (tg + 1u) * nx) xb_add(&bar[XB_TOPGEN], 1u);
            else XB_SPIN(xb_ld(&bar[XB_TOPGEN]) == tg, bar);
            __builtin_amdgcn_fence(__ATOMIC_ACQUIRE, "agent");
            xb_add(&bar[XB_XGEN(b.x)], 1u);
            asm volatile("s_waitcnt vmcnt(0)" ::: "memory");
        } else {
            XB_SPIN(xb_ld(&bar[XB_XGEN(b.x)]) == gen, bar);
            __builtin_amdgcn_fence(__ATOMIC_ACQUIRE, "agent");
            asm volatile("s_waitcnt vmcnt(0)" ::: "memory");
        }
    }
    __syncthreads();
}

struct Args { const float* in[17]; float* out; unsigned char* ws; int ph_lo, ph_hi, coop, pad; };

constexpr int W_I_IN = 16 * (NZP / 32), W_I_OUT = 16 * 32, W_I_PW = 4 * 8, W_ITEMS_L = W_I_IN + W_I_OUT + W_I_PW;
__device__ __forceinline__ void weight_copy_item(const float* w_in, const float* w_out, const float* w_pw, const float* norm_g, unsigned char* ws, int ll, int r, LAS float* scr, int lane) {
    if (r < W_I_IN) { transpose_item(w_in + (size_t)ll * DM * NZ, DM, NZ, NZP / 32, (bf16_t*)(ws + WS_WIN + ll * WIN_L), scr, r, lane, norm_g + ll * DM); return; } r -= W_I_IN;
    if (r < W_I_OUT) { transpose_item(w_out + (size_t)ll * DM * DM, DM, DM, 32, (bf16_t*)(ws + WS_WOUT + ll * WOUT_L), scr, r, lane); return; } r -= W_I_OUT;
    transpose_item(w_pw + (size_t)ll * 65536, 256, 256, 8, (bf16_t*)(ws + WS_WPW + ll * WPW_L), scr, r, lane);
}
template <int K> __device__ __forceinline__ void run_phase(const int l, LAS unsigned char* lds_base, LAS int* s_item, const int rep = 0) {
        typedef const __attribute__((address_space(4))) Args* ArgP;
        ArgP ap = (ArgP)__builtin_amdgcn_kernarg_segment_ptr(); asm volatile("" : "+s"(ap));
        Frame F;
        F.lds = lds_base;
        { int t_ = threadIdx.x; asm volatile("" : "+v"(t_)); F.tid = t_; F.lane = t_ & 63; F.wave = __builtin_amdgcn_readfirstlane(t_ >> 6); }
        { int g_ = gridDim.x, b_ = blockIdx.x; asm volatile("" : "+s"(g_), "+s"(b_)); F.G = g_; F.bid = b_; }
        unsigned char* ws = ap->ws;
        F.ctl = (unsigned*)(ws + WS_CTL);
        F.H = (bf16_t*)(ws + WS_H); F.Z = (bf16_t*)(ws + WS_Z); F.CC = (bf16_t*)(ws + WS_CC); F.DOp = F.Z + C_DO;
        F.KMP = (float*)(ws + WS_KM + (size_t)l * 65536); F.BL = (float*)(ws + WS_BL); F.DST = (float*)(ws + WS_DST); F.KV = (float*)(ws + WS_KV);
        F.PO = (bf16_t*)(ws + WS_PO); F.PS = (float*)(F.Z + C_PS); F.LIST = (unsigned*)(ws + WS_LIST);
        LayerP P;
        P.norm_g = ap->in[1] + l * DM;
        P.qga = ap->in[3] + l * 64; P.kga = ap->in[4] + l * 64; P.qgb = ap->in[5] + l * 64; P.kgb = ap->in[6] + l * 64;
        P.conv_w = ap->in[7] + l * 31 * 256; P.conv_b = ap->in[8] + l * 256; P.ln_g = ap->in[9] + l * 256; P.ln_b = ap->in[10] + l * 256;
        P.pw_b = ap->in[12] + l * 256; P.gate_w = ap->in[13] + l * 16 * 128; P.gate_b = ap->in[14] + l * 128; P.gla_g = ap->in[15] + l * 64;
        P.WinT = (const bf16_t*)(ws + WS_WIN + l * WIN_L); P.WoutT = (const bf16_t*)(ws + WS_WOUT + l * WOUT_L); P.WpwT = (const bf16_t*)(ws + WS_WPW + l * WPW_L);
        P.xin = (l == 0) ? ap->in[0] : ap->out; P.xout = ap->out;

        if constexpr (K == 0) {
            const int gw = F.bid * NWAVES + F.wave, NGW = F.G * NWAVES;
            if (l == 0) {
                float* z1 = (float*)(ws + WS_SSQ1); float* z2 = (float*)(ws + WS_KM);
                for (int i = F.bid * NTHR + F.tid; i < MTOK + 2 * 16384; i += F.G * NTHR) { if (i < MTOK) z1[i] = 0.f; else z2[i - MTOK] = 0.f; }
            }
            if (l == 0) {
                LAS float* scr = (LAS float*)(F.lds + F.wave * 16384);
                for (int it = gw; it < W_I_IN; it += NGW) weight_copy_item(ap->in[2], ap->in[16], ap->in[11], ap->in[1], ws, 0, it, scr, F.lane);
            }
            if (l == 0) for (int m = gw; m < MTOK; m += 2 * NGW) cvt_row2(P.xin + (size_t)m * DM, F.H + (size_t)m * DM, (float*)(ws + WS_SSQ0) + m, (size_t)NGW, F.lane);
        } else if constexpr (K == 1) {
            pg8::Gemm g{F.H, P.WinT, MTOK, NZP, DM}; pg8::StaticOrder S; S.init(MTOK, NZP, F.G, F.bid);
            pg8::EpiZ E{F.Z, NZP, (const float*)(ws + (l == 0 ? WS_SSQ0 : WS_SSQ1)), 1.0f / DM, EPS, (LAS float*)(F.lds + 135168), P.qga, P.kga, P.qgb, P.kgb, (float*)(ws + WS_KM + (size_t)l * 65536), QSCALE, NZ};
            pg8::gemm_phase<pg8::EpiZ, pg8::StaticOrder, true, true>(F.lds, g, S, E);
            if (l == 0) {
                const int nu = (MTOK / 256) * (NZP / 256), base_u = nu / F.G, rem_u = nu % F.G;
                const int nfree = (rem_u == 0) ? F.G : (F.G - rem_u), fidx = (rem_u == 0) ? F.bid : (F.bid - rem_u);
                if (fidx >= 0) { LAS float* scr = (LAS float*)(F.lds + F.wave * 16384);
                    const int nw_ = nfree * NWAVES, w0_ = fidx * NWAVES + F.wave;
                    for (int it = W_I_IN + w0_; it < W_ITEMS_L; it += nw_) weight_copy_item(ap->in[2], ap->in[16], ap->in[11], ap->in[1], ws, 0, it, scr, F.lane);
                    for (int it = w0_; it < W_ITEMS_L; it += nw_) weight_copy_item(ap->in[2], ap->in[16], ap->in[11], ap->in[1], ws, 1, it, scr, F.lane); }
                (void)base_u;
            }
        } else if constexpr (K == 2) {
            if (!rep) for (int it = F.bid; it < 256; it += F.G) gla_kv_item(F, P, it);
            if (!rep) { unsigned* cnt = F.ctl + 1024 + l * 256;
                for (int it = F.bid; it < 256; it += F.G) moba_topk_unit(F, P, (it >> 2) & 1, it & 3, 31 - (it >> 3), cnt, F.LIST); }
            { const int nr_ = (REP_PHASE == -8) ? 5 : 1; for (int it = F.bid; it < 256 * nr_; it += F.G) conv_item(F, P, it & 255); }
        } else if constexpr (K == 4) {
            if (!rep) for (int it = F.bid; it < 256; it += F.G) gla_scan_item2(F, it);
            att_phase(F, F.ctl + 1024 + l * 256, F.ctl + 2048 + l * 64);
        } else if constexpr (K == 5) {
            { const int nrep_ = (REP_PHASE == -2) ? 4 : 1; for (int it = F.bid; it < 256 * nrep_; it += F.G) gla_out_item(F, P, it & 255); }
            for (int it = F.bid; it < 1024; it += 4 * F.G) combine_items<4, 4>(F, it, F.G, 1024, F.PO, 256, 64, (size_t)MTOK * 256, F.PS, NZP / 2, 8, 2, C_GA, 0);
            for (int it = F.bid; it < 1024; it += 4 * F.G) combine_items<3, 4>(F, it, F.G, 1024, F.DOp, NZP, 64, 256, F.DST, 8, 2, (size_t)MTOK * 8, C_GB, 256);
        } else {
            pg8::Gemm g{F.CC, P.WoutT, MTOK, DM, DM}; pg8::StaticOrder S; S.init(MTOK, DM, F.G, F.bid);
            if (l == 0) { pg8::EpiResX E{F.H, (float*)(ws + WS_SSQ1), DM};
                pg8::gemm_phase<pg8::EpiResX, pg8::StaticOrder, true, true>(F.lds, g, S, E); }
            else { pg8::EpiRes E{F.H, P.xout, DM};
                pg8::gemm_phase<pg8::EpiRes, pg8::StaticOrder, true, true>(F.lds, g, S, E); }
        }
}

__global__ void __launch_bounds__(NTHR, 2) hybrid_fwd(Args args) {
    extern __shared__ __attribute__((aligned(16))) unsigned char lds_raw[];
    cg::grid_group grid = cg::this_grid();
    LAS unsigned char* lds_base = (LAS unsigned char*)lds_raw;
    LAS int* s_item = (LAS int*)(lds_base + LDS_BYTES - 64);
    const int ph_lo = args.ph_lo, ph_hi = args.ph_hi, coop = args.coop;
    volatile LAS unsigned* bst = (volatile LAS unsigned*)(lds_base + LDS_BYTES - 32);
    if (threadIdx.x == 0) { bst[0] = 0u; bst[1] = 0u; }
    __syncthreads();
    XcdBarrier bar; bar.bar = (unsigned*)(args.ws + WS_CTL) + 4096; bar.x = 0; bar.st = bst;
    if (coop) bar = xcd_barrier_post((unsigned*)(args.ws + WS_CTL) + 4096, bst);
#define GRID_BAR() do { if (coop == 2) grid.sync(); else if (coop == 1) xcd_barrier(bar); } while (0)
    if (REP_PHASE == -3 && coop) { for (int zz = 0; zz < 20; ++zz) GRID_BAR(); }
#ifndef ONLY_K
#define ONLY_K -1
#endif
#define RUN(PH) if ((ONLY_K < 0 || ((PH) % 7) == ONLY_K) && ph_lo <= (PH) && (PH) < ph_hi) { run_phase<(PH) % 7>((PH) / 7, lds_base, s_item); \
        if ((PH) == REP_PHASE) { GRID_BAR(); run_phase<(PH) % 7>((PH) / 7, lds_base, s_item, 1); } \
        if ((PH) + 1 < ph_hi) GRID_BAR(); }
#ifdef LAYER_LOOP
    RUN(0)
#define RUNL(KK) { const int ph_ = 7 * lyr + (KK); if ((ONLY_K < 0 || (KK) == ONLY_K) && ph_lo <= ph_ && ph_ < ph_hi) { run_phase<(KK)>(lyr, lds_base, s_item); \
        if (ph_ == REP_PHASE) { GRID_BAR(); run_phase<(KK)>(lyr, lds_base, s_item, 1); } \
        if (ph_ + 1 < ph_hi) GRID_BAR(); } }
#pragma nounroll
    for (int lyr_ = 0; lyr_ < 2; ++lyr_) { int lyr = lyr_; asm volatile("" : "+s"(lyr)); RUNL(1) RUNL(2) RUNL(4) RUNL(5) RUNL(6) }
#undef RUNL
#else
    RUN(0) RUN(1) RUN(2) RUN(4) RUN(5) RUN(6) RUN(8) RUN(9) RUN(11) RUN(12) RUN(13)
#endif
#undef RUN
#undef GRID_BAR
}

extern "C" void kernel_launch(void* const* d_in, const int* in_sizes, int n_in, void* d_out, int out_size, void* d_ws, size_t ws_size, hipStream_t stream) {
    static int grid = 0;
    if (grid == 0) {
        if (n_in != 17 || out_size != MTOK * DM || ws_size < WS_END) { fprintf(stderr, "kernel_launch: unexpected shapes (n_in %d out %d ws %zu)\n", n_in, out_size, ws_size); grid = -1; return; }
        int dev = 0, cus = 0, per_cu = 0;
        hipGetDevice(&dev); hipDeviceGetAttribute(&cus, hipDeviceAttributeMultiprocessorCount, dev);
        if (hipFuncSetAttribute((const void*)hybrid_fwd, hipFuncAttributeMaxDynamicSharedMemorySize, LDS_BYTES) != hipSuccess) { fprintf(stderr, "kernel_launch: hipFuncSetAttribute failed\n"); grid = -1; return; }
        if (hipOccupancyMaxActiveBlocksPerMultiprocessor(&per_cu, (const void*)hybrid_fwd, NTHR, LDS_BYTES) != hipSuccess || per_cu < 1) { fprintf(stderr, "kernel_launch: occupancy query gives %d\n", per_cu); per_cu = 1; }
        (void)hipGetLastError();
        if (per_cu > 1) per_cu = 1;
        grid = cus * per_cu;
    }
    if (grid < 0) return;
    hipMemsetAsync((char*)d_ws + WS_CTL, 0, CTL_ZERO_BYTES, stream);
    Args a{};
    for (int i = 0; i < 17; ++i) a.in[i] = (const float*)d_in[i];
    a.out = (float*)d_out; a.ws = (unsigned char*)d_ws;
#if N_LAUNCH_MODE == 1
    a.ph_lo = 0; a.ph_hi = 14; a.coop = 1;
    void* kargs[] = {&a};
    hipError_t e = hipLaunchCooperativeKernel((const void*)hybrid_fwd, dim3(grid), dim3(NTHR), kargs, LDS_BYTES, stream);
    if (e != hipSuccess) fprintf(stderr, "cooperative launch failed: %s (grid %d)\n", hipGetErrorString(e), grid);
#else
    for (int ph = 0; ph < 14; ++ph) { a.ph_lo = ph; a.ph_hi = ph + 1; a.coop = 0;
        hipLaunchKernelGGL(hybrid_fwd, dim3(grid), dim3(NTHR), LDS_BYTES, stream, a); }
#endif
}
```

```cpp
#include <hip/hip_runtime.h>
#include <hip/hip_cooperative_groups.h>
#include <cstdio>
#include <cstdint>
namespace cg = cooperative_groups;
template <int CTRL> __device__ __forceinline__ float xl_dpp(float v) { return __int_as_float(__builtin_amdgcn_update_dpp(0, __float_as_int(v), CTRL, 0xF, 0xF, true)); }
__device__ __forceinline__ float row16_sum(float v) { v += xl_dpp<0xB1>(v); v += xl_dpp<0x4E>(v); v += xl_dpp<0x141>(v); v += xl_dpp<0x140>(v); return v; }
__device__ __forceinline__ float row16_max(float v) { v = fmaxf(v, xl_dpp<0xB1>(v)); v = fmaxf(v, xl_dpp<0x4E>(v)); v = fmaxf(v, xl_dpp<0x141>(v)); v = fmaxf(v, xl_dpp<0x140>(v)); return v; }
__device__ __forceinline__ float xor16_sum(float v) { const auto r = __builtin_amdgcn_permlane16_swap(__float_as_uint(v), __float_as_uint(v), false, false); return __uint_as_float(r[0]) + __uint_as_float(r[1]); }
__device__ __forceinline__ float xor32_sum(float v) { const auto r = __builtin_amdgcn_permlane32_swap(__float_as_uint(v), __float_as_uint(v), false, false); return __uint_as_float(r[0]) + __uint_as_float(r[1]); }
__device__ __forceinline__ float wave64_sum(float v) { v = row16_sum(v);
    return (__int_as_float(__builtin_amdgcn_readlane(__float_as_int(v), 0)) + __int_as_float(__builtin_amdgcn_readlane(__float_as_int(v), 16))) + (__int_as_float(__builtin_amdgcn_readlane(__float_as_int(v), 32)) + __int_as_float(__builtin_amdgcn_readlane(__float_as_int(v), 48))); }
__device__ __forceinline__ float wave64_max(float v) { v = row16_max(v);
    return fmaxf(fmaxf(__int_as_float(__builtin_amdgcn_readlane(__float_as_int(v), 0)), __int_as_float(__builtin_amdgcn_readlane(__float_as_int(v), 16))), fmaxf(__int_as_float(__builtin_amdgcn_readlane(__float_as_int(v), 32)), __int_as_float(__builtin_amdgcn_readlane(__float_as_int(v), 48)))); }
namespace pg8 {
#define PG8_LAS __attribute__((address_space(3)))
typedef unsigned short bf16_t;
typedef short bf16x8 __attribute__((ext_vector_type(8)));
typedef float f32x4 __attribute__((ext_vector_type(4)));
typedef unsigned u32x4 __attribute__((ext_vector_type(4)));
constexpr int BM = 256, BK = 64, HALF = 128, HTB = HALF * BK * 2  , STAGE_BYTES = 8 * HTB, NXCD = 8, WGM = 8;

__host__ __device__ __forceinline__ int lds_byte(int r, int c) { const int st = (r >> 4) * 2 + (c >> 5), rr = r & 15, cc = c & 31, ob = rr * 64 + cc * 2; return st * 1024 + (ob ^ (((ob >> 9) & 1) << 5)); }
__host__ __device__ __forceinline__ void stage_rc(int b, int& R, int& C) { const int st = b / 1024, sb = b % 1024, swz = sb ^ (((sb >> 9) & 1) << 5); R = (st >> 1) * 16 + swz / 64; C = (st & 1) * 32 + (swz % 64) / 2; }
__host__ __device__ __forceinline__ int perm32(int rho) { const int n = rho >> 4, i = rho & 15; return 8 * (i >> 2) + 4 * n + (i & 3); }

struct Unit { int pm, pn; };
struct Gemm { const bf16_t* A; const bf16_t* Bt; int M, N, K; };

struct StaticOrder {
    int nM, nN, nwg, G, c;
    __host__ __device__ void init(int M, int N, int G_, int c_) { nM = M / BM; nN = N / BM; nwg = nM * nN; G = G_; c = c_; }
    __host__ __device__ bool next(int i, Unit& u) const {
        const long L = (long)i * G + c; if (L >= nwg) return false;
        int wgid = (int)L; { const int q = nwg / NXCD, r = nwg % NXCD, xcd = wgid % NXCD, off = wgid / NXCD; wgid = (xcd < r ? xcd * (q + 1) : r * (q + 1) + (xcd - r) * q) + off; }
        const int nig = WGM * nN, gid = wgid / nig, fm = gid * WGM, gsz = (nM - fm) < WGM ? (nM - fm) : WGM;
        u.pm = fm + ((wgid % nig) % gsz); u.pn = (wgid % nig) / gsz; return true;
    }
    __device__ __forceinline__ void a_ready(const Unit&) const {}
    __device__ __forceinline__ void done(const Unit&) const {}
};

__device__ __forceinline__ unsigned cvt_pk_bf16(float lo, float hi) { unsigned r; asm volatile("v_cvt_pk_bf16_f32 %0, %1, %2" : "=v"(r) : "v"(lo), "v"(hi)); return r; }
struct EpiZ {
    static constexpr bool PERM = true, AFTER_DRAIN = false;
    bf16_t* O; int ldc; const float* ssq; float inv_k, eps;
    PG8_LAS float* xch; const float *qga, *kga, *qgb, *kgb; float* km; float qscale; int ncols;
    __device__ __forceinline__ void operator()(const f32x4 (&acc)[2][2][4][2], const Unit& u, int wr, int wc, int fr, int fq) const {
        const int row0 = u.pm * BM + wr * 64 + fr; const int col0 = u.pn * BM + wc * 32 + 8 * fq;
        const int kind = (u.pn == 0) ? 1 : (u.pn == 1) ? 2 : (u.pn == 4) ? 3 : (u.pn == 5) ? 4 : 0;
        float sc[2][4];
#pragma unroll
        for (int ai = 0; ai < 2; ++ai)
#pragma unroll
            for (int m = 0; m < 4; ++m) sc[ai][m] = __builtin_amdgcn_rsqf(__hip_atomic_load(ssq + row0 + ai * HALF + m * 16, __ATOMIC_RELAXED, __HIP_MEMORY_SCOPE_AGENT) * inv_k + eps);
        const int wave = wr * 4 + wc;
        const float* gp = (kind == 1) ? qga : (kind == 2) ? kga : (kind == 3) ? qgb : kgb;
        const float gs = (kind & 1) ? qscale : 1.0f;
        float g[8];
#pragma unroll
        for (int e2 = 0; e2 < 8; ++e2) g[e2] = gp[32 * (wc & 1) + 8 * fq + e2] * gs;
        if (kind != 0) {
#pragma unroll
            for (int ai = 0; ai < 2; ++ai)
#pragma unroll
                for (int m = 0; m < 4; ++m)
#pragma unroll
                    for (int bj = 0; bj < 2; ++bj) { const f32x4 v0 = acc[ai][bj][m][0] * sc[ai][m], v1 = acc[ai][bj][m][1] * sc[ai][m];
                        float s = (v0[0] * v0[0] + v0[1] * v0[1]) + (v0[2] * v0[2] + v0[3] * v0[3]) + (v1[0] * v1[0] + v1[1] * v1[1]) + (v1[2] * v1[2] + v1[3] * v1[3]);
                        s = xor16_sum(s); s = xor32_sum(s);
                        if (fq == 0) xch[((wave * 2 + ai) * 4 + m) * 32 + bj * 16 + fr] = s; }
        }
        asm volatile("s_waitcnt lgkmcnt(0)" ::: "memory"); __builtin_amdgcn_s_barrier(); asm volatile("" ::: "memory");
        if (kind == 0) {
#pragma unroll
            for (int ai = 0; ai < 2; ++ai)
#pragma unroll
                for (int m = 0; m < 4; ++m) { bf16_t* rowp = O + (size_t)(row0 + ai * HALF + m * 16) * ldc + col0;
#pragma unroll
                    for (int bj = 0; bj < 2; ++bj) { const f32x4 v0 = acc[ai][bj][m][0] * sc[ai][m], v1 = acc[ai][bj][m][1] * sc[ai][m];
                        u32x4 w; w.x = cvt_pk_bf16(v0[0], v0[1]); w.y = cvt_pk_bf16(v0[2], v0[3]); w.z = cvt_pk_bf16(v1[0], v1[1]); w.w = cvt_pk_bf16(v1[2], v1[3]);
                        if (col0 + bj * HALF < ncols) *(u32x4*)(rowp + bj * HALF) = w; } }
            return;
        }
        float kacc[2][8];
#pragma unroll
        for (int bj = 0; bj < 2; ++bj)
#pragma unroll
            for (int e2 = 0; e2 < 8; ++e2) kacc[bj][e2] = 0.f;
        const int we = wave & ~1;
#pragma unroll
        for (int ai = 0; ai < 2; ++ai)
#pragma unroll
            for (int m = 0; m < 4; ++m) { bf16_t* rowp = O + (size_t)(row0 + ai * HALF + m * 16) * ldc + col0;
#pragma unroll
                for (int bj = 0; bj < 2; ++bj) {
                    const float tot = xch[((we * 2 + ai) * 4 + m) * 32 + bj * 16 + fr] + xch[(((we + 1) * 2 + ai) * 4 + m) * 32 + bj * 16 + fr];
                    const float rh = sc[ai][m] * __builtin_amdgcn_rsqf(tot * (1.0f / 64.0f) + eps);
                    f32x4 v0 = acc[ai][bj][m][0] * rh, v1 = acc[ai][bj][m][1] * rh;
                    v0[0] *= g[0]; v0[1] *= g[1]; v0[2] *= g[2]; v0[3] *= g[3]; v1[0] *= g[4]; v1[1] *= g[5]; v1[2] *= g[6]; v1[3] *= g[7];
                    if (kind == 2) { kacc[bj][0] += v0[0]; kacc[bj][1] += v0[1]; kacc[bj][2] += v0[2]; kacc[bj][3] += v0[3]; kacc[bj][4] += v1[0]; kacc[bj][5] += v1[1]; kacc[bj][6] += v1[2]; kacc[bj][7] += v1[3]; }
                    u32x4 w; w.x = cvt_pk_bf16(v0[0], v0[1]); w.y = cvt_pk_bf16(v0[2], v0[3]); w.z = cvt_pk_bf16(v1[0], v1[1]); w.w = cvt_pk_bf16(v1[2], v1[3]);
                    *(u32x4*)(rowp + bj * HALF) = w; } }
        if (kind == 2) {
#pragma unroll
            for (int bj = 0; bj < 2; ++bj)
#pragma unroll
                for (int e2 = 0; e2 < 8; ++e2) { float s = kacc[bj][e2];
                    s = row16_sum(s);
                    if (fr == 0) atomicAdd(km + (size_t)u.pm * 256 + bj * HALF + wc * 32 + 8 * fq + e2, s); }
        }
    }
};
struct EpiResX {
    static constexpr bool PERM = false, AFTER_DRAIN = false;
    bf16_t* xb; float* ssq; int ldc;
    __device__ __forceinline__ void operator()(const f32x4 (&acc)[2][2][4][2], const Unit& u, int wr, int wc, int fr, int fq) const {
        const int col0 = u.pn * BM + wc * 32 + 4 * fq;
#pragma unroll
        for (int ai = 0; ai < 2; ++ai) {
            unsigned long long bs[4][2][2];
#pragma unroll
            for (int m = 0; m < 4; ++m) { const size_t off = (size_t)(u.pm * BM + ai * HALF + wr * 64 + m * 16 + fr) * ldc + col0;
#pragma unroll
                for (int bj = 0; bj < 2; ++bj)
#pragma unroll
                    for (int n = 0; n < 2; ++n) bs[m][bj][n] = *(const unsigned long long*)(xb + off + bj * HALF + n * 16); }
            asm volatile("" ::: "memory");
#pragma unroll
            for (int m = 0; m < 4; ++m) { const int row = u.pm * BM + ai * HALF + wr * 64 + m * 16 + fr; const size_t off = (size_t)row * ldc + col0;
                float s = 0.f;
#pragma unroll
                for (int bj = 0; bj < 2; ++bj)
#pragma unroll
                    for (int n = 0; n < 2; ++n) { const unsigned long long wv = bs[m][bj][n]; const unsigned lo = (unsigned)wv, hi = (unsigned)(wv >> 32);
                        f32x4 r; r[0] = __uint_as_float(lo << 16); r[1] = __uint_as_float(lo & 0xffff0000u); r[2] = __uint_as_float(hi << 16); r[3] = __uint_as_float(hi & 0xffff0000u);
                        const f32x4 x1 = r + acc[ai][bj][m][n];
                        unsigned long long w = (unsigned long long)cvt_pk_bf16(x1[0], x1[1]) | ((unsigned long long)cvt_pk_bf16(x1[2], x1[3]) << 32);
                        *(unsigned long long*)(xb + off + bj * HALF + n * 16) = w;
                        s += (x1[0] * x1[0] + x1[1] * x1[1]) + (x1[2] * x1[2] + x1[3] * x1[3]); }
                s = xor16_sum(s); s = xor32_sum(s);
                if (fq == 0) atomicAdd(ssq + row, s); }
            asm volatile("" ::: "memory");
        }
    }
};
struct EpiRes {
    static constexpr bool PERM = false, AFTER_DRAIN = false;
    const bf16_t* xb; float* out; int ldc;
    __device__ __forceinline__ void operator()(const f32x4 (&acc)[2][2][4][2], const Unit& u, int wr, int wc, int fr, int fq) const {
        const int col0 = u.pn * BM + wc * 32 + 4 * fq;
        unsigned long long bs[2][4][2][2];
#pragma unroll
        for (int ai = 0; ai < 2; ++ai)
#pragma unroll
            for (int m = 0; m < 4; ++m) { const size_t off = (size_t)(u.pm * BM + ai * HALF + wr * 64 + m * 16 + fr) * ldc + col0;
#pragma unroll
                for (int bj = 0; bj < 2; ++bj)
#pragma unroll
                    for (int n = 0; n < 2; ++n) bs[ai][m][bj][n] = *(const unsigned long long*)(xb + off + bj * HALF + n * 16); }
        asm volatile("" ::: "memory");
#pragma unroll
        for (int ai = 0; ai < 2; ++ai)
#pragma unroll
            for (int m = 0; m < 4; ++m) { const size_t off = (size_t)(u.pm * BM + ai * HALF + wr * 64 + m * 16 + fr) * ldc + col0;
#pragma unroll
                for (int bj = 0; bj < 2; ++bj)
#pragma unroll
                    for (int n = 0; n < 2; ++n) { const unsigned long long w = bs[ai][m][bj][n]; const unsigned lo = (unsigned)w, hi = (unsigned)(w >> 32);
                        f32x4 r; r[0] = __uint_as_float(lo << 16); r[1] = __uint_as_float(lo & 0xffff0000u); r[2] = __uint_as_float(hi << 16); r[3] = __uint_as_float(hi & 0xffff0000u);
                        *(f32x4*)(out + off + bj * HALF + n * 16) = r + acc[ai][bj][m][n]; } }
    }
};
template <class Epi, class Sched, bool ALIGN_EPI = false, bool SP2 = false>
__device__ __forceinline__ void gemm_phase(PG8_LAS unsigned char* lds, const Gemm g, const Sched& S, const Epi& E) {
    int tid_l = threadIdx.x; asm volatile("" : "+v"(tid_l));
    const int tid = tid_l, wid = __builtin_amdgcn_readfirstlane(tid >> 6), lane = tid & 63, wr = wid >> 2, wc = wid & 3, fr = lane & 15, fq = lane >> 4;
    const int K = g.K, nt = K / BK;
    unsigned voffA[2], voffB[2];
#pragma unroll
    for (int i = 0; i < 2; ++i) { int R, C; stage_rc(tid * 16 + i * 8192, R, C); const int Rb = Epi::PERM ? ((R & ~31) + perm32(R & 31)) : R;
        voffA[i] = (unsigned)(R * K + C) * 2u; voffB[i] = (unsigned)(Rb * K + C) * 2u; }
    const size_t kstep = (size_t)(BK * 2);
    const size_t hstep = (size_t)HALF * K * 2;
    const size_t tstep = 2 * hstep;
    const unsigned ldsw = (unsigned)wid * 1024u;
    const int aoff = lds_byte(wr * 64 + fr, fq * 8), boff = lds_byte(wc * 32 + fr, fq * 8);
#define PG8_SA(b, h) (((b) * 2 + (h)) * HTB)
#define PG8_SB(b, h) ((4 + (b) * 2 + (h)) * HTB)
#define PG8_STAGE(bufoff, gbase, voff) do { _Pragma("unroll") for (int _i = 0; _i < 2; ++_i) \
        __builtin_amdgcn_global_load_lds((const unsigned*)((const char*)(gbase) + (voff)[_i]), (PG8_LAS unsigned*)(lds + (bufoff) + ldsw + _i * 8192), 16, 0, 0); } while (0)
#define PG8_LDA(dst, b, h) do { _Pragma("unroll") for (int m = 0; m < 4; ++m) _Pragma("unroll") for (int k = 0; k < 2; ++k) dst[m][k] = *(const PG8_LAS bf16x8*)(lds + PG8_SA(b, h) + aoff + m * 2048 + k * 1024); } while (0)
#define PG8_LDB(dst, b, h) do { _Pragma("unroll") for (int n = 0; n < 2; ++n) _Pragma("unroll") for (int k = 0; k < 2; ++k) dst[n][k] = *(const PG8_LAS bf16x8*)(lds + PG8_SB(b, h) + boff + n * 2048 + k * 1024); } while (0)
#define PG8_MMA(ai, bj, At, Bt) do { __builtin_amdgcn_s_setprio(1); _Pragma("unroll") for (int m = 0; m < 4; ++m) _Pragma("unroll") for (int n = 0; n < 2; ++n) _Pragma("unroll") for (int k = 0; k < 2; ++k) \
        acc[ai][bj][m][n] = __builtin_amdgcn_mfma_f32_16x16x32_bf16(Bt[n][k], At[m][k], acc[ai][bj][m][n], 0, 0, 0); __builtin_amdgcn_s_setprio(0); } while (0)
#define PG8_WAIT_V(n) asm volatile("s_waitcnt vmcnt(" #n ")" ::: "memory")
#define PG8_WAIT_L(n) asm volatile("s_waitcnt lgkmcnt(" #n ")" ::: "memory")
#define PG8_BAR __builtin_amdgcn_s_barrier()
#define PG8_SCHED __builtin_amdgcn_sched_barrier(0)
    Unit cur, nxt; int ui = 0;
    if (!S.next(0, cur)) return;
    f32x4 acc[2][2][4][2];
#pragma unroll
    for (int a = 0; a < 2; ++a)
#pragma unroll
        for (int b = 0; b < 2; ++b)
#pragma unroll
            for (int m = 0; m < 4; ++m)
#pragma unroll
                for (int n = 0; n < 2; ++n) acc[a][b][m][n] = (f32x4){0.f, 0.f, 0.f, 0.f};
    bf16x8 At[4][2], B0[2][2], B1[2][2];
    const char* cA = (const char*)g.A + (size_t)cur.pm * tstep; const char* cB = (const char*)g.Bt + (size_t)cur.pn * tstep;
    S.a_ready(cur);
    if constexpr (SP2) {
        PG8_STAGE(PG8_SB(0, 0), cB, voffB); PG8_STAGE(PG8_SB(0, 1), cB + hstep, voffB); PG8_STAGE(PG8_SA(0, 0), cA, voffA); PG8_STAGE(PG8_SA(0, 1), cA + hstep, voffA);
        if (wr == 1) PG8_BAR;
        PG8_WAIT_V(2); PG8_BAR;
        PG8_STAGE(PG8_SB(1, 0), cB + kstep, voffB); PG8_STAGE(PG8_SA(1, 0), cA + kstep, voffA); PG8_STAGE(PG8_SB(1, 1), cB + hstep + kstep, voffB);
        PG8_WAIT_V(6); PG8_BAR;
    } else {
        PG8_STAGE(PG8_SB(0, 0), cB, voffB); PG8_STAGE(PG8_SA(0, 0), cA, voffA); PG8_STAGE(PG8_SB(0, 1), cB + hstep, voffB); PG8_STAGE(PG8_SA(0, 1), cA + hstep, voffA);
        if (wr == 1) PG8_BAR;
        PG8_WAIT_V(4); PG8_BAR;
        PG8_STAGE(PG8_SB(1, 0), cB + kstep, voffB); PG8_STAGE(PG8_SA(1, 0), cA + kstep, voffA); PG8_STAGE(PG8_SB(1, 1), cB + hstep + kstep, voffB);
        PG8_WAIT_V(6); PG8_BAR;
    }
    for (;;) {
        const bool has_next = S.next(ui + 1, nxt);
        const char* nA = has_next ? (const char*)g.A + (size_t)nxt.pm * tstep : cA; const char* nB = has_next ? (const char*)g.Bt + (size_t)nxt.pn * tstep : cB;
        for (int t = 0; t < nt; t += 2) {
            const bool last = (t == nt - 2);
            const char* a1 = cA + (size_t)(t + 1) * kstep;
            const char* a2 = last ? nA : cA + (size_t)(t + 2) * kstep; const char* b2 = last ? nB : cB + (size_t)(t + 2) * kstep;
            const char* a3 = a2 + kstep; const char* b3 = b2 + kstep;
            if (last && has_next) S.a_ready(nxt);
            if constexpr (SP2) {
            PG8_LDB(B0, 0, 0); PG8_LDB(B1, 0, 1); PG8_SCHED; PG8_LDA(At, 0, 0); PG8_STAGE(PG8_SA(1, 1), a1 + hstep, voffA);
            PG8_WAIT_V(8); PG8_WAIT_L(0); PG8_BAR; PG8_MMA(0, 0, At, B0); PG8_MMA(0, 1, At, B1); PG8_BAR; PG8_SCHED;
            PG8_LDA(At, 0, 1); PG8_STAGE(PG8_SB(0, 0), b2, voffB); PG8_STAGE(PG8_SB(0, 1), b2 + hstep, voffB); PG8_STAGE(PG8_SA(0, 0), a2, voffA);
            PG8_WAIT_V(8); PG8_WAIT_L(0); PG8_BAR; PG8_MMA(1, 0, At, B0); PG8_MMA(1, 1, At, B1); PG8_BAR; PG8_SCHED;
            PG8_LDB(B0, 1, 0); PG8_LDB(B1, 1, 1); PG8_SCHED; PG8_LDA(At, 1, 0); PG8_STAGE(PG8_SA(0, 1), a2 + hstep, voffA);
            PG8_WAIT_V(8); PG8_WAIT_L(0); PG8_BAR; PG8_MMA(0, 0, At, B0); PG8_MMA(0, 1, At, B1); PG8_BAR; PG8_SCHED;
            PG8_LDA(At, 1, 1); PG8_STAGE(PG8_SB(1, 0), b3, voffB); PG8_STAGE(PG8_SB(1, 1), b3 + hstep, voffB); PG8_STAGE(PG8_SA(1, 0), a3, voffA);
            PG8_WAIT_V(8); PG8_WAIT_L(0); PG8_BAR; PG8_MMA(1, 0, At, B0); PG8_MMA(1, 1, At, B1); PG8_BAR; PG8_SCHED;
            } else {
            PG8_LDB(B0, 0, 0); PG8_SCHED; PG8_LDA(At, 0, 0); PG8_STAGE(PG8_SA(1, 1), a1 + hstep, voffA);
            PG8_WAIT_L(8); PG8_BAR; PG8_WAIT_L(0); PG8_MMA(0, 0, At, B0); PG8_BAR; PG8_SCHED;
            PG8_LDB(B1, 0, 1); PG8_STAGE(PG8_SB(0, 0), b2, voffB);
            PG8_BAR; PG8_WAIT_L(0); PG8_MMA(0, 1, At, B1); PG8_BAR;
            PG8_LDA(At, 0, 1); PG8_STAGE(PG8_SA(0, 0), a2, voffA);
            PG8_BAR; PG8_WAIT_L(0); PG8_MMA(1, 0, At, B0); PG8_BAR; PG8_SCHED;
            PG8_STAGE(PG8_SB(0, 1), b2 + hstep, voffB);
            PG8_WAIT_V(6); PG8_BAR; PG8_MMA(1, 1, At, B1); PG8_BAR;
            PG8_LDB(B0, 1, 0); PG8_SCHED; PG8_LDA(At, 1, 0); PG8_STAGE(PG8_SA(0, 1), a2 + hstep, voffA);
            PG8_WAIT_L(8); PG8_BAR; PG8_WAIT_L(0); PG8_MMA(0, 0, At, B0); PG8_BAR; PG8_SCHED;
            PG8_LDB(B1, 1, 1); PG8_STAGE(PG8_SB(1, 0), b3, voffB);
            PG8_BAR; PG8_WAIT_L(0); PG8_MMA(0, 1, At, B1); PG8_BAR;
            PG8_LDA(At, 1, 1); PG8_STAGE(PG8_SA(1, 0), a3, voffA);
            PG8_BAR; PG8_WAIT_L(0); PG8_MMA(1, 0, At, B0); PG8_BAR; PG8_SCHED;
            PG8_STAGE(PG8_SB(1, 1), b3 + hstep, voffB);
            PG8_WAIT_V(6); PG8_BAR; PG8_MMA(1, 1, At, B1); PG8_BAR;
            }
        }
        if constexpr (ALIGN_EPI) { if (wr == 0) PG8_BAR; }
        if constexpr (!Epi::AFTER_DRAIN) { E(acc, cur, wr, wc, fr, fq); S.done(cur); }
        if (!has_next) break;
#pragma unroll
        for (int a = 0; a < 2; ++a)
#pragma unroll
            for (int b = 0; b < 2; ++b)
#pragma unroll
                for (int m = 0; m < 4; ++m)
#pragma unroll
                    for (int n = 0; n < 2; ++n) acc[a][b][m][n] = (f32x4){0.f, 0.f, 0.f, 0.f};
        cur = nxt; cA = nA; cB = nB; ++ui;
        if constexpr (ALIGN_EPI) { if (wr == 1) PG8_BAR; }
    }
    PG8_WAIT_V(0);
    if constexpr (!ALIGN_EPI) { if (wr == 0) PG8_BAR; }
    PG8_BAR;
    if constexpr (Epi::AFTER_DRAIN) { E.fused(acc, cur, wr, wc, fr, fq, lds, wid, lane); S.done(cur); }
#undef PG8_SA
#undef PG8_SB
#undef PG8_STAGE
#undef PG8_LDA
#undef PG8_LDB
#undef PG8_MMA
#undef PG8_WAIT_V
#undef PG8_WAIT_L
#undef PG8_BAR
#undef PG8_SCHED
}
}

#define LAS __attribute__((address_space(3)))
typedef unsigned short bf16_t;
typedef short bf16x8 __attribute__((ext_vector_type(8)));
typedef float f32x4 __attribute__((ext_vector_type(4)));
typedef float f32x16 __attribute__((ext_vector_type(16)));
typedef unsigned u32x4 __attribute__((ext_vector_type(4)));
typedef unsigned u32x2 __attribute__((ext_vector_type(2)));

constexpr int NB = 2, SEQ = 8192, MTOK = NB * SEQ, DM = 1024, NZ = 3600, NZP = 3840, DEPTH = 2;
constexpr int C_QA = 0, C_KA = 256, C_VA = 512, C_GA = 768, C_QB = 1024, C_KB = 1280, C_VB = 1536, C_GB = 1792;
constexpr int C_CA = 2048, C_CG = 2304, C_GC = 2560, C_QD = 2816, C_KD = 2944, C_VD = 3072, C_LR = 3328, C_GD = 3344;
constexpr float EPS = 1e-6f, LOG2E = 1.4426950408889634f, QSCALE = 0.125f * LOG2E;
constexpr int NTHR = 512, NWAVES = 8;
constexpr int LDS_BYTES = 155648;

#ifndef REP_PHASE
#define REP_PHASE -1
#endif
#ifndef N_LAUNCH_MODE
#define N_LAUNCH_MODE 1
#endif

constexpr size_t MiB = 1u << 20;
constexpr size_t WS_CTL = 0, CTL_ZERO_BYTES = 32 * 1024;
constexpr size_t WS_SSQ0 = 256 * 1024, WS_SSQ1 = 384 * 1024;
constexpr size_t WS_KM = 512 * 1024;
constexpr size_t WS_WIN = 1 * MiB;
constexpr size_t WIN_L = (size_t)NZP * DM * 2;
constexpr size_t WS_WOUT = 16 * MiB;
constexpr size_t WOUT_L = (size_t)DM * DM * 2;
constexpr size_t WS_WPW = 20 * MiB;
constexpr size_t WPW_L = 256 * 256 * 2;
constexpr size_t WS_BL = 20 * MiB + 768 * 1024;
constexpr size_t WS_DST = 21 * MiB;
constexpr size_t WS_KV = 23 * MiB;
constexpr size_t WS_PO = 32 * MiB;
constexpr size_t WS_H = 64 * MiB;
constexpr size_t WS_CC = 96 * MiB;
constexpr size_t WS_Z = 128 * MiB;
constexpr size_t WS_LIST = 248 * MiB;
constexpr size_t WS_END = 256 * MiB;
constexpr int C_DO = C_CA;
constexpr int C_PS = NZ;

__device__ __forceinline__ float bf2f(unsigned v) { return __uint_as_float(v << 16); }
typedef float f32x2c_t __attribute__((ext_vector_type(2))); typedef __bf16 bf16x2c_t __attribute__((ext_vector_type(2)));
__device__ __forceinline__ unsigned cvtpk_(float lo, float hi) { f32x2c_t v = {lo, hi}; bf16x2c_t b = __builtin_convertvector(v, bf16x2c_t); return __builtin_bit_cast(unsigned, b); }
__device__ __forceinline__ unsigned pk2(float lo, float hi) { return cvtpk_(lo, hi); }
__device__ __forceinline__ unsigned f2bf(float f) { return cvtpk_(f, 0.f) & 0xffffu; }
__device__ __forceinline__ void unpack8(const u32x4 a, float (&x)[8]) {
#pragma unroll
    for (int k = 0; k < 4; ++k) { x[2 * k] = bf2f(a[k] & 0xffffu); x[2 * k + 1] = bf2f(a[k] >> 16); }
}
__device__ __forceinline__ float wave_sum(float v) {
    return wave64_sum(v);
}
__device__ __forceinline__ float sigmoidf_(float x) { return __builtin_amdgcn_rcpf(1.0f + __expf(-x)); }
__device__ __forceinline__ float siluf_(float x) { return x * __builtin_amdgcn_rcpf(1.0f + __expf(-x)); }
__device__ __forceinline__ float logsigmoidf_(float x) { return x < 0.f ? x - log1pf(__expf(x)) : -log1pf(__expf(-x)); }
__device__ __forceinline__ int crow(int r, int hi) { return (r & 3) + 8 * (r >> 2) + 4 * hi; }
__device__ __forceinline__ float ex2(float x) { return __builtin_amdgcn_exp2f(x); }


struct LayerP {
    const float *norm_g, *qga, *kga, *qgb, *kgb, *conv_w, *conv_b, *ln_g, *ln_b, *pw_b, *gate_w, *gate_b, *gla_g;
    const bf16_t *WinT, *WoutT, *WpwT;
    const float* xin; float* xout;
};
struct Frame {
    LAS unsigned char* lds;
    int tid, lane, wave, G, bid;
    unsigned* ctl;
    bf16_t *H, *Z, *CC, *DOp, *PO; float *KMP, *BL, *DST, *KV, *PS; unsigned* LIST;
};

__device__ __forceinline__ void transpose_item(const float* W, int K, int N, int NPb, bf16_t* WT, LAS float* scr, int item, int lane, const float* kscale = nullptr) {
    const int nblk = NPb, kb = item / nblk, nb = item % nblk, k0 = 64 * kb, n0 = 32 * nb;
    const int nn = n0 + (lane & 31);
    float wv[32];
#pragma unroll
    for (int i = 0; i < 32; ++i) { const int kk = 2 * i + (lane >> 5); wv[i] = (nn < N) ? __builtin_nontemporal_load(W + (size_t)(k0 + kk) * N + nn) : 0.f; }
    if (kscale) {
#pragma unroll
        for (int i = 0; i < 32; ++i) wv[i] *= kscale[k0 + 2 * i + (lane >> 5)]; }
#pragma unroll
    for (int i = 0; i < 32; ++i) scr[(2 * i + (lane >> 5)) * 33 + (lane & 31)] = wv[i];
    asm volatile("s_waitcnt lgkmcnt(0)" ::: "memory");
    const int c = lane & 7;
#pragma unroll
    for (int j = 0; j < 4; ++j) { const int n = (lane >> 3) + 8 * j; const LAS float* s = scr + (8 * c) * 33 + n;
        u32x4 o; o.x = pk2(s[0 * 33], s[1 * 33]); o.y = pk2(s[2 * 33], s[3 * 33]); o.z = pk2(s[4 * 33], s[5 * 33]); o.w = pk2(s[6 * 33], s[7 * 33]);
        *(u32x4*)(WT + (size_t)(n0 + n) * K + k0 + 8 * c) = o; }
    asm volatile("s_waitcnt lgkmcnt(0)" ::: "memory");
}
__device__ __forceinline__ void cvt_row(const float* xrow, bf16_t* orow, float* ssq_out, int lane) {
    const f32x4* xr = (const f32x4*)xrow + lane;
    f32x4 v[4]; float s = 0.f;
#pragma unroll
    for (int j = 0; j < 4; ++j) { v[j] = xr[64 * j]; s += (v[j].x * v[j].x + v[j].y * v[j].y) + (v[j].z * v[j].z + v[j].w * v[j].w); }
    unsigned long long* o8 = (unsigned long long*)orow + lane;
#pragma unroll
    for (int j = 0; j < 4; ++j) o8[64 * j] = (unsigned long long)pk2(v[j].x, v[j].y) | ((unsigned long long)pk2(v[j].z, v[j].w) << 32);
    s = wave_sum(s);
    if (lane == 0) *ssq_out = s;
}

__device__ __forceinline__ void cvt_row2(const float* xrow, bf16_t* orow, float* ssq_out, size_t rstride, int lane) {
    f32x4 v[2][4];
#pragma unroll
    for (int t = 0; t < 2; ++t)
#pragma unroll
        for (int j = 0; j < 4; ++j) v[t][j] = __builtin_nontemporal_load((const f32x4*)(xrow + t * rstride * DM) + lane + 64 * j);
#pragma unroll
    for (int t = 0; t < 2; ++t) { float s = 0.f;
        unsigned long long* o8 = (unsigned long long*)(orow + t * rstride * DM) + lane;
#pragma unroll
        for (int j = 0; j < 4; ++j) { s += (v[t][j].x * v[t][j].x + v[t][j].y * v[t][j].y) + (v[t][j].z * v[t][j].z + v[t][j].w * v[t][j].w);
            o8[64 * j] = (unsigned long long)pk2(v[t][j].x, v[t][j].y) | ((unsigned long long)pk2(v[t][j].z, v[t][j].w) << 32); }
        s = wave_sum(s);
        if (lane == 0) ssq_out[t * rstride] = s; }
}

__device__ __forceinline__ float logsigmoid_fast(float x) { return fminf(x, 0.f) - __logf(1.0f + __expf(-fabsf(x))); }
constexpr int GL_BC = 0;
constexpr int GL_V = 64 * 132;
constexpr int GL_LR = GL_V + 64 * 260;
constexpr int GL_TOT = GL_LR + 64 * 20;
constexpr int GL_END = GL_TOT + 512;
static_assert(GL_END * 4 <= 140 * 1024, "GLA LDS");

__device__ __forceinline__ void gla_kv_item(const Frame& F, const LayerP& P, int it) {
    LAS float* S = (LAS float*)F.lds; LAS float* bcS = S + GL_BC; LAS float* vS = S + GL_V; LAS float* lrS = S + GL_LR; LAS float* totS = S + GL_TOT;
    const int m0 = it * 64, tid = F.tid, lane = F.lane;
    unsigned lrv; { const int idx = tid * 2, row = idx >> 4, c = idx & 15; lrv = *(const unsigned*)(F.Z + (size_t)(m0 + row) * NZP + C_LR + c); }
    const int cc = tid & 127, jg = tid >> 7;
    float wv[16];
#pragma unroll
    for (int r = 0; r < 16; ++r) wv[r] = P.gate_w[r * 128 + cc];
    const float bias = P.gate_b[cc];
    u32x4 qx[2], kx[2], vx[4];
#pragma unroll
    for (int i = 0; i < 2; ++i) { const int q = tid + 512 * i, j = q >> 4, c8 = q & 15; const bf16_t* zr = F.Z + (size_t)(m0 + j) * NZP + 8 * c8;
        qx[i] = *(const u32x4*)(zr + C_QD); kx[i] = *(const u32x4*)(zr + C_KD); }
#pragma unroll
    for (int i = 0; i < 4; ++i) { const int q = tid + 512 * i, j = q >> 5, c8 = q & 31; vx[i] = *(const u32x4*)(F.Z + (size_t)(m0 + j) * NZP + C_VD + 8 * c8); }
    __syncthreads();
    { const int idx = tid * 2, row = idx >> 4, c = idx & 15; lrS[row * 20 + c] = bf2f(lrv & 0xffffu); lrS[row * 20 + c + 1] = bf2f(lrv >> 16); }
#pragma unroll
    for (int i = 0; i < 4; ++i) { const int q = tid + 512 * i, j = q >> 5, c8 = q & 31; float x[8]; unpack8(vx[i], x);
        *(LAS f32x4*)(vS + j * 260 + 8 * c8) = (f32x4){x[0], x[1], x[2], x[3]}; *(LAS f32x4*)(vS + j * 260 + 8 * c8 + 4) = (f32x4){x[4], x[5], x[6], x[7]}; }
    __syncthreads();
    float loc[16]; float run = 0.f;
#pragma unroll
    for (int i = 0; i < 16; ++i) { const int j = jg * 16 + i; float x = bias;
#pragma unroll
        for (int r4 = 0; r4 < 4; ++r4) { const f32x4 lv = *(const LAS f32x4*)(lrS + j * 20 + 4 * r4);
            x += lv.x * wv[4 * r4] + lv.y * wv[4 * r4 + 1] + lv.z * wv[4 * r4 + 2] + lv.w * wv[4 * r4 + 3]; }
        run += logsigmoid_fast(x) * (1.0f / 16.0f); loc[i] = run; }
    totS[jg * 128 + cc] = run;
    __syncthreads();
    float off = 0.f;
    for (int gg = 0; gg < jg; ++gg) off += totS[gg * 128 + cc];
#pragma unroll
    for (int i = 0; i < 16; ++i) bcS[(jg * 16 + i) * 132 + cc] = off + loc[i];
    __syncthreads();
    float eb[2][8];
#pragma unroll
    for (int i = 0; i < 2; ++i) { const int c8 = (tid + 512 * i) & 15;
#pragma unroll
        for (int e = 0; e < 8; ++e) eb[i][e] = __expf(bcS[63 * 132 + 8 * c8 + e]); }
    if (tid < 128) F.BL[(size_t)it * 128 + tid] = bcS[63 * 132 + tid];
    __syncthreads();
#pragma unroll
    for (int i = 0; i < 2; ++i) { const int q = tid + 512 * i, j = q >> 4, c8 = q & 15; float xq[8], xk[8], yq[8], yk[8]; unpack8(qx[i], xq); unpack8(kx[i], xk);
        const f32x4 b0 = *(const LAS f32x4*)(bcS + j * 132 + 8 * c8), b1 = *(const LAS f32x4*)(bcS + j * 132 + 8 * c8 + 4);
        const float bcv[8] = {b0.x, b0.y, b0.z, b0.w, b1.x, b1.y, b1.z, b1.w}; float kh[8];
#pragma unroll
        for (int e = 0; e < 8; ++e) { const float e1 = __expf(bcv[e]), e2 = __builtin_amdgcn_rcpf(e1);
            yq[e] = xq[e] * 0.17677669529663687f * e1; yk[e] = xk[e] * e2;
            kh[e] = xk[e] * (eb[i][e] * e2); }
        *(LAS f32x4*)(bcS + j * 132 + 8 * c8) = (f32x4){kh[0], kh[1], kh[2], kh[3]}; *(LAS f32x4*)(bcS + j * 132 + 8 * c8 + 4) = (f32x4){kh[4], kh[5], kh[6], kh[7]};
        bf16_t* zr = F.Z + (size_t)(m0 + j) * NZP + 8 * c8;
        u32x4 o; o.x = pk2(yq[0], yq[1]); o.y = pk2(yq[2], yq[3]); o.z = pk2(yq[4], yq[5]); o.w = pk2(yq[6], yq[7]); *(u32x4*)(zr + C_QD) = o;
        o.x = pk2(yk[0], yk[1]); o.y = pk2(yk[2], yk[3]); o.z = pk2(yk[4], yk[5]); o.w = pk2(yk[6], yk[7]); *(u32x4*)(zr + C_KD) = o; }
    __syncthreads();
    const int h = F.wave >> 1, vh = F.wave & 1;
    f32x16 acc;
#pragma unroll
    for (int r = 0; r < 16; ++r) acc[r] = 0.f;
#pragma unroll 8
    for (int s = 0; s < 32; ++s) { const int ja = 2 * s + (lane >> 5);
        const float a = bcS[ja * 132 + h * 32 + (lane & 31)];
        const float b = vS[ja * 260 + h * 64 + 32 * vh + (lane & 31)];
        acc = __builtin_amdgcn_mfma_f32_32x32x2f32(a, b, acc, 0, 0, 0); }
    float* kvp = F.KV + ((size_t)it * 4 + h) * 2048;
#pragma unroll
    for (int r = 0; r < 16; ++r) { const int d = crow(r, lane >> 5); kvp[d * 64 + 32 * vh + (lane & 31)] = acc[r]; }
}

constexpr int GO_Q = 0;
constexpr int GO_K = 64 * 136 * 2;
constexpr int GO_VT = 2 * 64 * 136 * 2;
constexpr int GO_OUT = GO_VT + 256 * 72 * 2;
static_assert(GO_OUT + 64 * 260 * 4 <= 140 * 1024, "GLA out LDS");
__device__ __forceinline__ void gla_out_item(const Frame& F, const LayerP& P, int it) {
    LAS bf16_t* QtS = (LAS bf16_t*)(F.lds + GO_Q); LAS bf16_t* KtS = (LAS bf16_t*)(F.lds + GO_K); LAS bf16_t* VT = (LAS bf16_t*)(F.lds + GO_VT); LAS float* oS = (LAS float*)(F.lds + GO_OUT);
    const int m0 = it * 64, tid = F.tid, lane = F.lane, hf = lane >> 5, l31 = lane & 31;
    const int h = F.wave >> 1, ih = F.wave & 1;
    u32x4 qx[2], kx[2], vx[2][2], gx[4];
#pragma unroll
    for (int i = 0; i < 2; ++i) { const int q = tid + 512 * i, j = q >> 4, c8 = q & 15; const bf16_t* zr = F.Z + (size_t)(m0 + j) * NZP + 8 * c8;
        qx[i] = *(const u32x4*)(zr + C_QD); kx[i] = *(const u32x4*)(zr + C_KD); }
#pragma unroll
    for (int i = 0; i < 2; ++i) { const int q = tid + 512 * i, rp = q & 31, c8 = q >> 5; const bf16_t* zr = F.Z + (size_t)(m0 + 2 * rp) * NZP + C_VD + 8 * c8;
        vx[i][0] = *(const u32x4*)zr; vx[i][1] = *(const u32x4*)(zr + NZP); }
#pragma unroll
    for (int i = 0; i < 4; ++i) { const int q = tid + 512 * i, j = q >> 5, c8 = q & 31; gx[i] = *(const u32x4*)(F.Z + (size_t)(m0 + j) * NZP + C_GD + 8 * c8); }
    float sta[2][2][8];
    { const float* st = F.KV + ((size_t)it * 4 + h) * 2048;
#pragma unroll
      for (int vt = 0; vt < 2; ++vt)
#pragma unroll
          for (int s = 0; s < 2; ++s)
#pragma unroll
              for (int jj = 0; jj < 8; ++jj) sta[vt][s][jj] = st[(16 * s + 8 * hf + jj) * 64 + 32 * vt + l31]; }
    float gn[2][16];
#pragma unroll
    for (int vt = 0; vt < 2; ++vt)
#pragma unroll
        for (int r = 0; r < 16; ++r) gn[vt][r] = P.gla_g[32 * vt + crow(r, hf)];
    __syncthreads();
#pragma unroll
    for (int i = 0; i < 2; ++i) { const int q = tid + 512 * i, j = q >> 4, c8 = q & 15;
        *(LAS u32x4*)(QtS + j * 136 + 8 * c8) = qx[i]; *(LAS u32x4*)(KtS + j * 136 + 8 * c8) = kx[i]; }
#pragma unroll
    for (int i = 0; i < 2; ++i) { const int q = tid + 512 * i, rp = q & 31, c8 = q >> 5;
#pragma unroll
        for (int k = 0; k < 4; ++k) { const unsigned a = vx[i][0][k], b = vx[i][1][k];
            *(LAS unsigned*)(VT + (8 * c8 + 2 * k) * 72 + 2 * rp) = (a & 0xffffu) | (b << 16);
            *(LAS unsigned*)(VT + (8 * c8 + 2 * k + 1) * 72 + 2 * rp) = (a >> 16) | (b & 0xffff0000u); } }
    __syncthreads();
    bf16x8 qB[2];
#pragma unroll
    for (int s = 0; s < 2; ++s) qB[s] = *(const LAS bf16x8*)(QtS + (32 * ih + l31) * 136 + h * 32 + 16 * s + 8 * hf);
    f32x16 aT[2];
#pragma unroll
    for (int jt = 0; jt < 2; ++jt) {
#pragma unroll
        for (int r = 0; r < 16; ++r) aT[jt][r] = 0.f;
        if (jt <= ih) {
#pragma unroll
            for (int s = 0; s < 2; ++s) { const bf16x8 a = *(const LAS bf16x8*)(KtS + (32 * jt + l31) * 136 + h * 32 + 16 * s + 8 * hf);
                aT[jt] = __builtin_amdgcn_mfma_f32_32x32x16_bf16(a, qB[s], aT[jt], 0, 0, 0); }
#pragma unroll
            for (int r = 0; r < 16; ++r) { const int j = 32 * jt + crow(r, hf), i = 32 * ih + l31; if (j > i) aT[jt][r] = 0.f; }
        }
    }
    f32x16 oT[2];
#pragma unroll
    for (int vt = 0; vt < 2; ++vt) {
#pragma unroll
        for (int r = 0; r < 16; ++r) oT[vt][r] = 0.f;
#pragma unroll
        for (int s = 0; s < 2; ++s) { u32x4 sw; sw.x = cvtpk_(sta[vt][s][0], sta[vt][s][1]); sw.y = cvtpk_(sta[vt][s][2], sta[vt][s][3]); sw.z = cvtpk_(sta[vt][s][4], sta[vt][s][5]); sw.w = cvtpk_(sta[vt][s][6], sta[vt][s][7]);
            oT[vt] = __builtin_amdgcn_mfma_f32_32x32x16_bf16(__builtin_bit_cast(bf16x8, sw), qB[s], oT[vt], 0, 0, 0); }
#pragma unroll
        for (int jt = 0; jt < 2; ++jt) {
            if (jt <= ih) {
#pragma unroll
                for (int s = 0; s < 2; ++s) {
                    u32x4 pw; pw.x = cvtpk_(aT[jt][8 * s + 0], aT[jt][8 * s + 1]); pw.y = cvtpk_(aT[jt][8 * s + 2], aT[jt][8 * s + 3]); pw.z = cvtpk_(aT[jt][8 * s + 4], aT[jt][8 * s + 5]); pw.w = cvtpk_(aT[jt][8 * s + 6], aT[jt][8 * s + 7]);
                    const LAS bf16_t* vp = VT + (h * 64 + 32 * vt + l31) * 72 + 32 * jt + 16 * s + 4 * hf;
                    const u32x2 v0 = *(const LAS u32x2*)vp, v1 = *(const LAS u32x2*)(vp + 8);
                    u32x4 vv; vv.x = v0.x; vv.y = v0.y; vv.z = v1.x; vv.w = v1.y;
                    oT[vt] = __builtin_amdgcn_mfma_f32_32x32x16_bf16(__builtin_bit_cast(bf16x8, vv), __builtin_bit_cast(bf16x8, pw), oT[vt], 0, 0, 0); }
            }
        }
    }
    float ss = 0.f;
#pragma unroll
    for (int vt = 0; vt < 2; ++vt)
#pragma unroll
        for (int r = 0; r < 16; ++r) ss += oT[vt][r] * oT[vt][r];
    ss = xor32_sum(ss);
    const float rinv = __builtin_amdgcn_rsqf(ss * (1.0f / 64.0f) + EPS);
#pragma unroll
    for (int vt = 0; vt < 2; ++vt)
#pragma unroll
        for (int r = 0; r < 16; ++r) oS[(32 * ih + l31) * 260 + h * 64 + 32 * vt + crow(r, hf)] = (oT[vt][r] * rinv) * gn[vt][r];
    __syncthreads();
#pragma unroll
    for (int i = 0; i < 4; ++i) { const int q = tid + 512 * i, j = q >> 5, c8 = q & 31; float gg[8]; unpack8(gx[i], gg); float y[8];
        const f32x4 t0 = *(const LAS f32x4*)(oS + j * 260 + 8 * c8), t1 = *(const LAS f32x4*)(oS + j * 260 + 8 * c8 + 4); const float tv[8] = {t0.x, t0.y, t0.z, t0.w, t1.x, t1.y, t1.z, t1.w};
#pragma unroll
        for (int e = 0; e < 8; ++e) y[e] = tv[e] * siluf_(gg[e]);
        u32x4 o; o.x = pk2(y[0], y[1]); o.y = pk2(y[2], y[3]); o.z = pk2(y[4], y[5]); o.w = pk2(y[6], y[7]);
        *(u32x4*)(F.CC + (size_t)(m0 + j) * DM + 768 + 8 * c8) = o; }
}

constexpr int CV_U = 0;
constexpr int CV_A = 94 * 256 * 4;
static_assert(CV_A + 64 * 264 * 2 <= 140 * 1024, "conv LDS");
__device__ __forceinline__ void conv_item(const Frame& F, const LayerP& P, int it) {
    LAS float* uS = (LAS float*)F.lds; LAS bf16_t* aS = (LAS bf16_t*)(F.lds + CV_A);
    const int tid = F.tid, lane = F.lane, w = F.wave;
    const int b = it >> 7, t0 = (it & 127) * 64, m0 = it * 64;
    u32x4 ua[6], ug[6];
#pragma unroll
    for (int i = 0; i < 6; ++i) { const int q = tid + 512 * i, r = q >> 5, c8 = q & 31, tt = t0 - 30 + r;
        ua[i] = (u32x4){0u, 0u, 0u, 0u}; ug[i] = (u32x4){0u, 0u, 0u, 0u};
        if (q < 94 * 32 && tt >= 0) { const bf16_t* zr = F.Z + (size_t)(b * SEQ + tt) * NZP + 8 * c8; ua[i] = *(const u32x4*)(zr + C_CA); ug[i] = *(const u32x4*)(zr + C_CG); } }
    typedef float f32x2v __attribute__((ext_vector_type(2)));
    const int cp = tid & 127, tq = tid >> 7;

    __syncthreads();
#pragma unroll
    for (int i = 0; i < 6; ++i) { const int q = tid + 512 * i, r = q >> 5, c8 = q & 31;
        if (q < 94 * 32) { float xa[8], xg[8]; unpack8(ua[i], xa); unpack8(ug[i], xg);
#pragma unroll
            for (int e = 0; e < 8; ++e) xa[e] = xa[e] * sigmoidf_(xg[e]);
            *(LAS f32x4*)(uS + r * 256 + 8 * c8) = (f32x4){xa[0], xa[1], xa[2], xa[3]}; *(LAS f32x4*)(uS + r * 256 + 8 * c8 + 4) = (f32x4){xa[4], xa[5], xa[6], xa[7]}; } }
    __syncthreads();
    {
        f32x2v wk[31];
#pragma unroll
        for (int k = 0; k < 31; ++k) wk[k] = *(const f32x2v*)(P.conv_w + k * 256 + 2 * cp);
        const f32x2v cbias = *(const f32x2v*)(P.conv_b + 2 * cp);
#pragma nounroll
        for (int hh = 0; hh < 2; ++hh) { const int t0r = 16 * tq + 8 * hh;
            f32x2v u[38];
#pragma unroll
            for (int r = 0; r < 38; ++r) u[r] = *(const LAS f32x2v*)(uS + (t0r + r) * 256 + 2 * cp);
#pragma unroll
            for (int i = 0; i < 8; ++i) { f32x2v acc = wk[0] * u[i];
#pragma unroll
                for (int k = 1; k < 31; ++k) acc = __builtin_elementwise_fma(wk[k], u[i + k], acc);
                acc = acc + cbias;
                *(LAS unsigned*)(aS + (t0r + i) * 264 + 2 * cp) = pk2(acc.x, acc.y); } }
    }
    asm volatile("" ::: "memory"); __builtin_amdgcn_sched_barrier(0);
    const int n0 = 32 * w, fr = lane & 15, fq = lane >> 4;
    bf16x8 bfr[8][2];
#pragma unroll
    for (int ks = 0; ks < 8; ++ks)
#pragma unroll
        for (int nt = 0; nt < 2; ++nt) bfr[ks][nt] = *(const bf16x8*)(P.WpwT + (size_t)(n0 + 16 * nt + fr) * 256 + 32 * ks + 8 * fq);
    u32x4 gx[4];
#pragma unroll
    for (int i = 0; i < 4; ++i) { const int q = tid + 512 * i, j = q >> 5, c8 = q & 31; gx[i] = *(const u32x4*)(F.Z + (size_t)(m0 + j) * NZP + C_GC + 8 * c8); }
    float lg[4], lb[4];
#pragma unroll
    for (int j = 0; j < 4; ++j) { lg[j] = P.ln_g[lane + 64 * j]; lb[j] = P.ln_b[lane + 64 * j]; }
    __syncthreads();
#pragma unroll 2
    for (int i = 0; i < 8; ++i) { const int row = 8 * w + i;
        float x[4]; float s = 0.f;
#pragma unroll
        for (int j = 0; j < 4; ++j) { x[j] = bf2f(aS[row * 264 + lane + 64 * j]); s += x[j]; }
        const float mean = wave_sum(s) * (1.0f / 256.0f); float s2 = 0.f;
#pragma unroll
        for (int j = 0; j < 4; ++j) { x[j] -= mean; s2 += x[j] * x[j]; }
        const float rstd = __builtin_amdgcn_rsqf(wave_sum(s2) * (1.0f / 256.0f) + EPS);
#pragma unroll
        for (int j = 0; j < 4; ++j) { const float un = (x[j] * rstd) * lg[j] + lb[j];
            aS[row * 264 + lane + 64 * j] = (bf16_t)f2bf(siluf_(un)); } }
    __syncthreads();
    f32x4 acc[4][2];
#pragma unroll
    for (int m = 0; m < 4; ++m)
#pragma unroll
        for (int nt = 0; nt < 2; ++nt) acc[m][nt] = (f32x4){0.f, 0.f, 0.f, 0.f};
#pragma unroll
    for (int ks = 0; ks < 8; ++ks) {
#pragma unroll
        for (int m = 0; m < 4; ++m) { const bf16x8 af = *(const LAS bf16x8*)(aS + (16 * m + fr) * 264 + 32 * ks + 8 * fq);
#pragma unroll
            for (int nt = 0; nt < 2; ++nt) acc[m][nt] = __builtin_amdgcn_mfma_f32_16x16x32_bf16(af, bfr[ks][nt], acc[m][nt], 0, 0, 0); } }
#pragma unroll
    for (int m = 0; m < 4; ++m)
#pragma unroll
        for (int nt = 0; nt < 2; ++nt) { const int col = n0 + 16 * nt + fr; const float pb = P.pw_b[col];
#pragma unroll
            for (int r = 0; r < 4; ++r) uS[(16 * m + 4 * fq + r) * 260 + col] = acc[m][nt][r] + pb; }
    __syncthreads();
#pragma unroll
    for (int i = 0; i < 4; ++i) { const int q = tid + 512 * i, j = q >> 5, c8 = q & 31; float gg[8]; unpack8(gx[i], gg); float y[8];
        const f32x4 t0 = *(const LAS f32x4*)(uS + j * 260 + 8 * c8), t1 = *(const LAS f32x4*)(uS + j * 260 + 8 * c8 + 4); const float tv[8] = {t0.x, t0.y, t0.z, t0.w, t1.x, t1.y, t1.z, t1.w};
#pragma unroll
        for (int e = 0; e < 8; ++e) y[e] = tv[e] * siluf_(gg[e]);
        u32x4 o; o.x = pk2(y[0], y[1]); o.y = pk2(y[2], y[3]); o.z = pk2(y[4], y[5]); o.w = pk2(y[6], y[7]);
        *(u32x4*)(F.CC + (size_t)(m0 + j) * DM + 512 + 8 * c8) = o; }
}

typedef float f32x2_t __attribute__((ext_vector_type(2))); typedef __bf16 bf16x2_t __attribute__((ext_vector_type(2)));
__device__ __forceinline__ unsigned cvtpk(float lo, float hi) { f32x2_t v = {lo, hi}; bf16x2_t b = __builtin_convertvector(v, bf16x2_t); return __builtin_bit_cast(unsigned, b); }

struct AttnState { float m, l; f32x16 oT[2]; };
__device__ __forceinline__ void attn_init(AttnState& st) {
    st.m = -INFINITY; st.l = 0.f;
#pragma unroll
    for (int d0 = 0; d0 < 2; ++d0)
#pragma unroll
        for (int r = 0; r < 16; ++r) st.oT[d0][r] = 0.f;
}
typedef short v4i16_t __attribute__((ext_vector_type(4)));
__device__ __forceinline__ bf16x8 v_frag_tr(const LAS bf16_t* Vs, int kb, int d0, int lane) {
    const int hf = lane >> 5, i = lane & 15;
    const LAS bf16_t* a = Vs + (kb + 4 * hf + (i >> 2)) * 72 + 32 * d0 + 16 * ((lane >> 4) & 1) + 4 * (i & 3);
    const v4i16_t lo = __builtin_amdgcn_ds_read_tr16_b64_v4i16((LAS v4i16_t*)a);
    const v4i16_t hi = __builtin_amdgcn_ds_read_tr16_b64_v4i16((LAS v4i16_t*)(a + 8 * 72));
    return (bf16x8){lo[0], lo[1], lo[2], lo[3], hi[0], hi[1], hi[2], hi[3]};
}
__device__ __forceinline__ f32x16 attn_qk(const LAS bf16_t* Ks, int krow0, const bf16x8 (&qf)[4], const f32x16& cb, int l31, int hf) {
    f32x16 p = cb;
    bf16x8 a[4];
#pragma unroll
    for (int d0 = 0; d0 < 4; ++d0) a[d0] = *(const LAS bf16x8*)(Ks + (krow0 + l31) * 72 + 16 * d0 + 8 * hf);
    __builtin_amdgcn_s_setprio(1);
#pragma unroll
    for (int d0 = 0; d0 < 4; ++d0) p = __builtin_amdgcn_mfma_f32_32x32x16_bf16(a[d0], qf[d0], p, 0, 0, 0);
    __builtin_amdgcn_s_setprio(0);
    return p;
}
__device__ __forceinline__ float xhalf_max(float v) { const auto rr = __builtin_amdgcn_permlane32_swap(__float_as_uint(v), __float_as_uint(v), false, false); return fmaxf(__uint_as_float(rr[0]), __uint_as_float(rr[1])); }
__device__ __forceinline__ float xhalf_sum(float v) { const auto rr = __builtin_amdgcn_permlane32_swap(__float_as_uint(v), __float_as_uint(v), false, false); return __uint_as_float(rr[0]) + __uint_as_float(rr[1]); }
__device__ __forceinline__ void attn_softmax_pv(AttnState& st, f32x16 p, const LAS bf16_t* Vt, int vpitch, int kcol0, float coff, bool MASKED, int lo, int hi, int l31, int hf) {
    if (MASKED) {
#pragma unroll
        for (int r = 0; r < 16; ++r) { const int c = crow(r, hf); if (c < lo || c > hi) p[r] = -INFINITY; }
    }
    float mx = fmaxf(fmaxf(p[0], p[1]), p[2]);
#pragma unroll
    for (int r = 3; r < 15; r += 2) mx = fmaxf(fmaxf(mx, p[r]), p[r + 1]);
    mx = fmaxf(mx, p[15]);
    mx += coff;
    mx = xhalf_max(mx);
    if (__any(mx > st.m)) {
        const float mnew = fmaxf(st.m, mx);
        const float alpha = ex2(st.m - mnew);
        st.l *= alpha; st.m = mnew;
#pragma unroll
        for (int d0 = 0; d0 < 2; ++d0)
#pragma unroll
            for (int r = 0; r < 16; ++r) st.oT[d0][r] *= alpha;
    }
    const float c = coff - st.m;
    float ls = 0.f;
#pragma unroll
    for (int r = 0; r < 16; ++r) { p[r] = ex2(p[r] + c); ls += p[r]; }
    st.l += ls;
#pragma unroll
    for (int s = 0; s < 2; ++s) {
        u32x4 pw; pw.x = cvtpk(p[8 * s + 0], p[8 * s + 1]); pw.y = cvtpk(p[8 * s + 2], p[8 * s + 3]); pw.z = cvtpk(p[8 * s + 4], p[8 * s + 5]); pw.w = cvtpk(p[8 * s + 6], p[8 * s + 7]);
        const bf16x8 pb = __builtin_bit_cast(bf16x8, pw);
#pragma unroll
        for (int d0 = 0; d0 < 2; ++d0) {
            st.oT[d0] = __builtin_amdgcn_mfma_f32_32x32x16_bf16(v_frag_tr(Vt, kcol0 + 16 * s, d0, 32 * hf + l31), pb, st.oT[d0], 0, 0, 0); }
    }
}
struct TileP { int kk0; float coff; bool masked; int lo, hi; };
__device__ __forceinline__ void attn_pair(AttnState& st, const LAS bf16_t* Ks, const LAS bf16_t* Vt, int vpitch, const bf16x8 (&qf)[4], const f32x16& cb, const TileP A, const TileP B, int l31, int hf) {
    f32x16 pA = attn_qk(Ks, A.kk0, qf, cb, l31, hf);
    f32x16 pB = attn_qk(Ks, B.kk0, qf, cb, l31, hf);
    if (A.masked) {
#pragma unroll
        for (int r = 0; r < 16; ++r) { const int c = crow(r, hf); if (c < A.lo || c > A.hi) pA[r] = -INFINITY; }
    }
    if (B.masked) {
#pragma unroll
        for (int r = 0; r < 16; ++r) { const int c = crow(r, hf); if (c < B.lo || c > B.hi) pB[r] = -INFINITY; }
    }
    float ma = fmaxf(fmaxf(pA[0], pA[1]), pA[2]), mb = fmaxf(fmaxf(pB[0], pB[1]), pB[2]);
#pragma unroll
    for (int r = 3; r < 15; r += 2) { ma = fmaxf(fmaxf(ma, pA[r]), pA[r + 1]); mb = fmaxf(fmaxf(mb, pB[r]), pB[r + 1]); }
    ma = fmaxf(ma, pA[15]) + A.coff; mb = fmaxf(mb, pB[15]) + B.coff;
    const float mx = xhalf_max(fmaxf(ma, mb));
    if (__any(mx > st.m)) {
        const float mnew = fmaxf(st.m, mx);
        const float alpha = ex2(st.m - mnew);
        st.l *= alpha; st.m = mnew;
#pragma unroll
        for (int d0 = 0; d0 < 2; ++d0)
#pragma unroll
            for (int r = 0; r < 16; ++r) st.oT[d0][r] *= alpha;
    }
    const float ca = A.coff - st.m, cbb = B.coff - st.m;
    float ls = 0.f;
#pragma unroll
    for (int r = 0; r < 16; ++r) { pA[r] = ex2(pA[r] + ca); ls += pA[r]; }
#pragma unroll
    for (int s = 0; s < 2; ++s) {
        u32x4 pw; pw.x = cvtpk(pA[8 * s + 0], pA[8 * s + 1]); pw.y = cvtpk(pA[8 * s + 2], pA[8 * s + 3]); pw.z = cvtpk(pA[8 * s + 4], pA[8 * s + 5]); pw.w = cvtpk(pA[8 * s + 6], pA[8 * s + 7]);
        const bf16x8 pb = __builtin_bit_cast(bf16x8, pw);
#pragma unroll
        for (int d0 = 0; d0 < 2; ++d0) {
            st.oT[d0] = __builtin_amdgcn_mfma_f32_32x32x16_bf16(v_frag_tr(Vt, A.kk0 + 16 * s, d0, 32 * hf + l31), pb, st.oT[d0], 0, 0, 0); }
    }
#pragma unroll
    for (int r = 0; r < 16; ++r) { pB[r] = ex2(pB[r] + cbb); ls += pB[r]; }
    st.l += ls;
#pragma unroll
    for (int s = 0; s < 2; ++s) {
        u32x4 pw; pw.x = cvtpk(pB[8 * s + 0], pB[8 * s + 1]); pw.y = cvtpk(pB[8 * s + 2], pB[8 * s + 3]); pw.z = cvtpk(pB[8 * s + 4], pB[8 * s + 5]); pw.w = cvtpk(pB[8 * s + 6], pB[8 * s + 7]);
        const bf16x8 pb = __builtin_bit_cast(bf16x8, pw);
#pragma unroll
        for (int d0 = 0; d0 < 2; ++d0) {
            st.oT[d0] = __builtin_amdgcn_mfma_f32_32x32x16_bf16(v_frag_tr(Vt, B.kk0 + 16 * s, d0, 32 * hf + l31), pb, st.oT[d0], 0, 0, 0); }
    }
}
__device__ __forceinline__ void attn_store_row(const AttnState& st, float scale, bf16_t* dst, int hf) {
#pragma unroll
    for (int d0 = 0; d0 < 2; ++d0)
#pragma unroll
        for (int g = 0; g < 4; ++g) { u32x2 w; w.x = pk2(st.oT[d0][4 * g] * scale, st.oT[d0][4 * g + 1] * scale); w.y = pk2(st.oT[d0][4 * g + 2] * scale, st.oT[d0][4 * g + 3] * scale);
            *(u32x2*)(dst + 32 * d0 + 8 * g + 4 * hf) = w; }
}

constexpr int MB_KS = 0;
constexpr int MB_VT = 256 * 72 * 2;
constexpr int MB_KM = MB_VT + 64 * 260 * 2;
constexpr int MB_VP = 260;
constexpr int DL_KS = 0;
constexpr int DL_VT = 384 * 72 * 2;
constexpr int DL_VP = 388;
constexpr int AT_PREF = 120 * 1024;
static_assert(DL_VT + 64 * 388 * 2 <= AT_PREF && MB_KM + 32 * 64 * 4 <= AT_PREF, "attention LDS");
constexpr int LIST_CAP = 8192;

__device__ __forceinline__ void moba_topk_unit(const Frame& F, const LayerP& P, int b, int h, int qb, unsigned* cnt  , unsigned* list  ) {
    LAS float* kmS = (LAS float*)(F.lds + MB_KM);
    const int tid = F.tid, lane = F.lane, w = F.wave, l31 = lane & 31, hf = lane >> 5, bh = b * 4 + h;
    __syncthreads();
    for (int q = tid; q < qb * 64; q += 512) { const int n = q >> 6, d = q & 63;
        kmS[q] = __hip_atomic_load(F.KMP + ((size_t)(b * 32 + n)) * 256 + h * 64 + d, __ATOMIC_RELAXED, __HIP_MEMORY_SCOPE_AGENT) * (1.0f / 256.0f); }
    const int qpos = qb * 256 + 32 * w + l31;
    const size_t grow = (size_t)b * SEQ + qpos;
    float qv[32];
#pragma unroll
    for (int d0 = 0; d0 < 4; ++d0) { const u32x4 a = *(const u32x4*)(F.Z + grow * NZP + C_QA + h * 64 + 16 * d0 + 8 * hf);
#pragma unroll
        for (int k = 0; k < 4; ++k) { qv[d0 * 8 + 2 * k] = bf2f(a[k] & 0xffffu); qv[d0 * 8 + 2 * k + 1] = bf2f(a[k] >> 16); } }
    __syncthreads();
    float v0 = -INFINITY, v1 = -INFINITY, v2 = -INFINITY; int i0 = -1, i1 = -1, i2 = -1;
    for (int n = 0; n < qb; ++n) { float g = 0.f;
#pragma unroll
        for (int d0 = 0; d0 < 4; ++d0) { const f32x4 k0 = *(const LAS f32x4*)(kmS + n * 64 + 16 * d0 + 8 * hf), k1 = *(const LAS f32x4*)(kmS + n * 64 + 16 * d0 + 8 * hf + 4);
            g += qv[d0 * 8 + 0] * k0.x + qv[d0 * 8 + 1] * k0.y + qv[d0 * 8 + 2] * k0.z + qv[d0 * 8 + 3] * k0.w + qv[d0 * 8 + 4] * k1.x + qv[d0 * 8 + 5] * k1.y + qv[d0 * 8 + 6] * k1.z + qv[d0 * 8 + 7] * k1.w; }
        g = xor32_sum(g);
        if (g > v0) { v2 = v1; i2 = i1; v1 = v0; i1 = i0; v0 = g; i0 = n; }
        else if (g > v1) { v2 = v1; i2 = i1; v1 = g; i1 = n; }
        else if (g > v2) { v2 = g; i2 = n; } }
    float gq = fabsf(P.qga[lane]), gk = fabsf(P.kga[lane]);
    gq = wave64_max(gq); gk = wave64_max(gk);
    const float B2 = 2.04f * 64.0f * gq * gk * QSCALE, slope2 = exp2f(-(float)(2 * h + 1)) * LOG2E;
    const bool z0 = i0 >= 0 && (B2 - slope2 * (float)(qpos - 256 * i0 - 255)) < -152.0f;
    const bool z1 = i1 >= 0 && (B2 - slope2 * (float)(qpos - 256 * i1 - 255)) < -152.0f;
    const bool z2 = i2 >= 0 && (B2 - slope2 * (float)(qpos - 256 * i2 - 255)) < -152.0f;
    if (z0) i0 = -1;
    if (z1) i1 = -1;
    if (z2) i2 = -1;
    unsigned mymask = 0u;
    for (int n = 0; n < qb; ++n) {
        const unsigned long long mask = __ballot(hf == 0 && (n == i0 || n == i1 || n == i2));
        if (lane == n) mymask = (unsigned)mask;
    }
    unsigned mybase = 0u;
    if (mymask != 0u) mybase = atomicAdd(cnt + bh * 32 + lane, (unsigned)__popc(mymask));
    {
        const unsigned below = (1u << l31) - 1u;
        const int sel[3] = {i0, i1, i2};
#pragma unroll
        for (int k = 0; k < 3; ++k) {
            const int n = sel[k] < 0 ? 0 : sel[k];
            const unsigned mk = (unsigned)__shfl((int)mymask, n), bs = (unsigned)__shfl((int)mybase, n);
            if (hf == 0 && sel[k] >= 0) { const int pos = (int)bs + __popc(mk & below);
                if (pos < LIST_CAP) list[((size_t)bh * 32 + n) * LIST_CAP + pos] = ((unsigned)qpos << 2) | (unsigned)k; }
        }
    }
    if (hf == 0) { float* ps = F.PS + grow * (NZP / 2) + h * 8;
        float ninf = -1e30f, zer = 0.f; asm volatile("" : "+v"(ninf), "+v"(zer));
        if (i0 < 0) { ps[0] = ninf; ps[1] = zer; }
        if (i1 < 0) { ps[2] = ninf; ps[3] = zer; }
        if (i2 < 0) { ps[4] = ninf; ps[5] = zer; } }
}

constexpr int AT_KS = 0, AT_VT = 384 * 72 * 2, AT_VP = 72;
struct AttDesc {
    int kind;
    int b, h, n, tile, cnt, pr;
    int pat, dil, g, u;
    int nrows, first_valid; long long row0, rstride;
    int kcol, vcol;
};
__device__ __forceinline__ AttDesc att_decode(int j, int total, const LAS int* pref, const unsigned* cnt) {
    AttDesc D; D.kind = 0; D.b = 0; D.h = 0; D.n = 0; D.tile = 0; D.cnt = 0; D.pr = 0; D.pat = 0; D.dil = 1; D.g = 0; D.u = 0;
    if (j < total + 256) {
        int pr, tile;
        if (j < total) { int lo = 0, hi = 255;
            while (lo < hi) { const int mid = (lo + hi + 1) >> 1; if (pref[mid] <= j) lo = mid; else hi = mid - 1; }
            pr = lo; tile = j - pref[pr] + 1; D.kind = 0;
        } else { const int u = j - total; pr = (u & 7) * 32 + (u >> 3); tile = 0; D.kind = 1; }
        D.cnt = pref[272 + pr];
        D.pr = pr; D.tile = tile; D.b = pr >> 7; D.h = (pr >> 5) & 3; D.n = pr & 31;
        D.nrows = 256; D.first_valid = 0; D.row0 = (long long)D.b * SEQ + D.n * 256; D.rstride = 1; D.kcol = C_KA + D.h * 64; D.vcol = C_VA + D.h * 64;
    } else {
        const int q = j - total - 256; D.kind = 2; D.pat = q >> 8; const int r = q & 255; D.b = (r >> 2) & 1; D.h = r & 3; const int uidx = r >> 3;
        D.dil = (D.pat == 0) ? 1 : (D.pat == 1 ? 4 : 16);
        const int upg = 32 / D.dil; D.g = uidx / upg; D.u = uidx % upg;
        const int i0 = 256 * D.u - 128;
        D.nrows = 384; D.first_valid = (i0 < 0) ? 128 : 0; D.row0 = (long long)D.b * SEQ + (long long)i0 * D.dil + D.g; D.rstride = D.dil; D.kcol = C_KB + D.h * 64; D.vcol = C_VB + D.h * 64;
    }
    return D;
}
struct StageRegs { u32x4 kx[2][2], vx[2][2]; };
__device__ __forceinline__ void att_stage_issue(StageRegs& R, int tid, const bf16_t* Z, const AttDesc& D) {
#pragma unroll
    for (int i = 0; i < 2; ++i) { const int q = tid + 512 * i, r = (q >> 3) * 2, c8 = q & 7;
#pragma unroll
        for (int e = 0; e < 2; ++e) { R.kx[i][e] = (u32x4){0u, 0u, 0u, 0u}; R.vx[i][e] = (u32x4){0u, 0u, 0u, 0u};
            if (r + e >= D.first_valid) { const bf16_t* zr = Z + (size_t)(D.row0 + (long long)(r + e) * D.rstride) * NZP + 8 * c8;
                R.kx[i][e] = *(const u32x4*)(zr + D.kcol); R.vx[i][e] = *(const u32x4*)(zr + D.vcol); } } }
}
__device__ __forceinline__ void att_stage_put(const u32x4 (&kx)[2], const u32x4 (&vx)[2], int r, int c8, LAS bf16_t* Ks, LAS bf16_t* Vt) {
    *(LAS u32x4*)(Ks + r * 72 + 8 * c8) = kx[0]; *(LAS u32x4*)(Ks + (r + 1) * 72 + 8 * c8) = kx[1];
    *(LAS u32x4*)(Vt + r * 72 + 8 * c8) = vx[0]; *(LAS u32x4*)(Vt + (r + 1) * 72 + 8 * c8) = vx[1];
}
struct StageTail { u32x4 k3[2], v3[2]; };
__device__ __forceinline__ void att_stage_tail_issue(StageTail& T3, int tid, const bf16_t* Z, const AttDesc& D) {
    const int q3 = tid + 1024, r3 = (q3 >> 3) * 2, c83 = q3 & 7;
#pragma unroll
    for (int e = 0; e < 2; ++e) { T3.k3[e] = (u32x4){0u, 0u, 0u, 0u}; T3.v3[e] = (u32x4){0u, 0u, 0u, 0u};
        if (D.nrows > 256) { const bf16_t* zr = Z + (size_t)(D.row0 + (long long)(r3 + e) * D.rstride) * NZP + 8 * c83; T3.k3[e] = *(const u32x4*)(zr + D.kcol); T3.v3[e] = *(const u32x4*)(zr + D.vcol); } }
}
__device__ __forceinline__ void att_stage_write(const StageRegs& R, const StageTail& T3, int tid, const AttDesc& D, LAS bf16_t* Ks, LAS bf16_t* Vt) {
#pragma unroll
    for (int i = 0; i < 2; ++i) { const int q = tid + 512 * i, r = (q >> 3) * 2, c8 = q & 7; att_stage_put(R.kx[i], R.vx[i], r, c8, Ks, Vt); }
    if (D.nrows > 256) { const int q3 = tid + 1024, r3 = (q3 >> 3) * 2, c83 = q3 & 7; att_stage_put(T3.k3, T3.v3, r3, c83, Ks, Vt); }
}
__device__ __forceinline__ unsigned att_entry_issue(const AttDesc& D, const unsigned* LIST, int w, int l31) {
    if (D.kind == 2) return 0u;
    const int idx0 = D.tile * 256 + 32 * w;
    if (idx0 >= D.cnt) return 0u;
    const int idx = idx0 + l31;
    return LIST[(size_t)D.pr * LIST_CAP + (idx < D.cnt ? idx : idx0)];
}
__device__ __forceinline__ void att_compute(const Frame& F, const AttDesc& D, const int mode  , unsigned entry, const bf16x8 (&qf)[4], size_t grow, int qpos) {
    const LAS bf16_t* Ks = (const LAS bf16_t*)(F.lds + AT_KS); const LAS bf16_t* Vt = (const LAS bf16_t*)(F.lds + AT_VT);
    const int lane = F.lane, w = F.wave, l31 = lane & 31, hf = lane >> 5;
    const bool dilk = mode == 2, own = mode == 1;
    const int idx0 = D.tile * 256 + 32 * w;
    if (mode == 0 && idx0 >= D.cnt) return;
    const float slope2 = dilk ? exp2f(-(float)(2 * D.h + 2)) * LOG2E * (float)D.dil : exp2f(-(float)(2 * D.h + 1)) * LOG2E;
    f32x16 cb;
#pragma unroll
    for (int r = 0; r < 16; ++r) cb[r] = slope2 * (float)crow(r, hf);
    const int i0 = 256 * D.u - 128;
    AttnState st; attn_init(st);
    int jmin = 0; if (dilk) { jmin = (-i0 - 32 * w + 31) >> 5; jmin = jmin < 0 ? 0 : jmin; }
    const int ntile = dilk ? (5 - jmin) : (own ? (w + 1) : 8);
    auto tile_params = [&](int s) -> TileP { TileP T;
        if (dilk) { const int j = 4 - s; T.kk0 = 32 * w + 32 * j; T.coff = -slope2 * (float)(l31 + 128 - 32 * j); T.masked = (j == 4 || j == 0); T.lo = l31 - 32 * j; T.hi = l31 + 128 - 32 * j; }
        else { T.kk0 = 32 * s; T.coff = slope2 * (float)(D.n * 256 + 32 * s - qpos); T.masked = own && (s == w); T.lo = -1; T.hi = l31; }
        return T; };
    int s = 0;
#pragma nounroll
    for (; s + 1 < ntile; s += 2) attn_pair(st, Ks, Vt, AT_VP, qf, cb, tile_params(s), tile_params(s + 1), l31, hf);
    if (s < ntile) { const TileP T = tile_params(s);
        const f32x16 pc = attn_qk(Ks, T.kk0, qf, cb, l31, hf);
        attn_softmax_pv(st, pc, Vt, AT_VP, T.kk0, T.coff, T.masked, T.lo, T.hi, l31, hf); }
    const float ltot = xhalf_sum(st.l);
    if (dilk) {
        attn_store_row(st, __builtin_amdgcn_rcpf(ltot), F.DOp + grow * NZP + D.pat * 256 + D.h * 64, hf);
        if (hf == 0) { float* sp = F.DST + (((size_t)D.pat * MTOK + grow) * 4 + D.h) * 2; sp[0] = st.m; sp[1] = ltot; }
    } else {
        const bool valid = own || (idx0 + l31 < D.cnt);
        const int slot = own ? 3 : (int)(entry & 3u);
        if (valid) {
            attn_store_row(st, __builtin_amdgcn_rcpf(ltot), F.PO + (((size_t)slot * MTOK + grow) * 4 + D.h) * 64, hf);
            if (hf == 0) { float* ps = F.PS + grow * (NZP / 2) + D.h * 8 + slot * 2; ps[0] = st.m; ps[1] = ltot; } }
    }
}
__device__ __forceinline__ void att_phase(const Frame& F, const unsigned* cnt, unsigned* dctr  ) {
    LAS int* pref = (LAS int*)(F.lds + AT_PREF);
    LAS bf16_t* Ks = (LAS bf16_t*)(F.lds + AT_KS); LAS bf16_t* Vt = (LAS bf16_t*)(F.lds + AT_VT);
    const int lane = F.lane, w = F.wave, l31 = lane & 31, hf = lane >> 5;
    LAS int* dq = pref + 530;
    __syncthreads();
    if (F.tid == 0) dq[0] = (int)atomicAdd(dctr, 1u);
    {
        int T = 0;
        if (F.tid < 256) { int c = (int)__hip_atomic_load(cnt + F.tid, __ATOMIC_RELAXED, __HIP_MEMORY_SCOPE_AGENT); c = c > LIST_CAP ? LIST_CAP : c; pref[272 + F.tid] = c; T = ((c + 255) >> 8) - 1; T = T < 0 ? 0 : T; }
        int x = T;
#pragma unroll
        for (int o = 1; o < 64; o <<= 1) { const int y = __shfl_up(x, o); if (lane >= o) x += y; }
        if (lane == 63) pref[264 + w] = x;
        __syncthreads();
        int off = 0;
        for (int ww = 0; ww < w; ++ww) off += pref[264 + ww];
        if (F.tid < 256) pref[F.tid] = x + off - T;
        if (F.tid == 255) pref[256] = x + off;
        __syncthreads();
    }
    const int total = pref[256], NS = total + 256;
    const int vcu = (F.G % 8 == 0) ? (F.bid % 8) * (F.G / 8) + F.bid / 8 : F.bid;
    int j = vcu, nd = 0; bool isdyn = false;
    if (j >= NS) { const int d = dq[0]; nd = 1; isdyn = true; if (d >= 768) return; j = NS + d; if (F.tid == 0) dq[1] = (int)atomicAdd(dctr, 1u); }
    AttDesc D = att_decode(j, total, pref, cnt);
    StageRegs R; att_stage_issue(R, F.tid, F.Z, D);
    unsigned entry = att_entry_issue(D, F.LIST, w, l31);
    for (;;) {
        int qpos; size_t grow; int qcol;
        if (D.kind == 2) { const int iq = 256 * D.u + 32 * w + l31; qpos = iq; grow = (size_t)D.b * SEQ + (size_t)iq * D.dil + D.g; qcol = C_QB + D.h * 64; }
        else { qpos = (D.kind == 1) ? (D.n * 256 + 32 * w + l31) : (int)(entry >> 2); grow = (size_t)D.b * SEQ + qpos; qcol = C_QA + D.h * 64; }
        bf16x8 qf[4];
#pragma unroll
        for (int d0 = 0; d0 < 4; ++d0) qf[d0] = *(const bf16x8*)(F.Z + grow * NZP + qcol + 16 * d0 + 8 * hf);
        const bool two = (D.kind == 1) && (D.cnt > 0);
        const int qpos2 = (int)(entry >> 2); const size_t grow2 = (size_t)D.b * SEQ + qpos2;
        StageTail T3; att_stage_tail_issue(T3, F.tid, F.Z, D);
        __syncthreads();
        att_stage_write(R, T3, F.tid, D, Ks, Vt);
        __syncthreads();
        int jn; bool have_n; int fd = 0; bool fetched = false;
        if (!isdyn && j + F.G < NS) { jn = j + F.G; have_n = true; }
        else { const int d = dq[nd & 1]; ++nd; isdyn = true; have_n = d < 768; jn = NS + d;
            if (have_n) { fetched = true; if (F.tid == 0) fd = (int)atomicAdd(dctr, 1u); } }
        AttDesc Dn = D; unsigned entry_n = 0u;
        if (have_n) { Dn = att_decode(jn, total, pref, cnt); att_stage_issue(R, F.tid, F.Z, Dn); entry_n = att_entry_issue(Dn, F.LIST, w, l31); }
        const int npass = two ? 2 : 1;
#pragma nounroll
        for (int pass = 0; pass < npass; ++pass) {
            const int mode = (pass == 1) ? 0 : D.kind;
            att_compute(F, D, mode, entry, qf, pass ? grow2 : grow, pass ? qpos2 : qpos);
            if (pass + 1 < npass) {
#pragma unroll
                for (int d0 = 0; d0 < 4; ++d0) qf[d0] = *(const bf16x8*)(F.Z + grow2 * NZP + qcol + 16 * d0 + 8 * hf); }
        }
        if (fetched && F.tid == 0) dq[nd & 1] = fd;
        if (!have_n) break;
        D = Dn; entry = entry_n; j = jn;
    }
    __syncthreads();
}

template <int NP, int NB>
__device__ __forceinline__ void combine_items(const Frame& F, int item0, int istride, int nitems, const bf16_t* PO, size_t o_row, size_t o_head, size_t o_part, const float* PS, size_t s_row, size_t s_head, size_t s_part, int zgate_col, int cc_col) {
    float m[NB][NP], l[NB][NP]; u32x4 ox[NB][NP], gz[NB];
#pragma unroll
    for (int k = 0; k < NB; ++k) { const int item = item0 + k * istride; const int idx = (item < nitems ? item : item0) * 512 + F.tid; const size_t row = (size_t)(idx >> 5); const int h = (idx >> 3) & 3, c8 = idx & 7;
#pragma unroll
        for (int pp = 0; pp < NP; ++pp) { const float* sp = PS + row * s_row + h * s_head + pp * s_part; m[k][pp] = sp[0]; l[k][pp] = sp[1]; }
        gz[k] = *(const u32x4*)(F.Z + row * NZP + zgate_col + h * 64 + 8 * c8); }
#pragma unroll
    for (int k = 0; k < NB; ++k) { const int item = item0 + k * istride; const int idx = (item < nitems ? item : item0) * 512 + F.tid; const size_t row = (size_t)(idx >> 5); const int h = (idx >> 3) & 3, c8 = idx & 7;
#pragma unroll
        for (int pp = 0; pp < NP; ++pp) { ox[k][pp] = (u32x4){0u, 0u, 0u, 0u};
            if (l[k][pp] > 0.f) ox[k][pp] = __builtin_nontemporal_load((const u32x4*)(PO + row * o_row + h * o_head + pp * o_part + 8 * c8)); } }
#pragma unroll
    for (int k = 0; k < NB; ++k) { const int item = item0 + k * istride; if (item >= nitems) continue;
        const int idx = item * 512 + F.tid; const size_t row = (size_t)(idx >> 5); const int h = (idx >> 3) & 3, c8 = idx & 7;
        float mm = m[k][0];
#pragma unroll
        for (int pp = 1; pp < NP; ++pp) mm = fmaxf(mm, m[k][pp]);
        float wsum = 0.f; float o[8];
#pragma unroll
        for (int e = 0; e < 8; ++e) o[e] = 0.f;
#pragma unroll
        for (int pp = 0; pp < NP; ++pp) { const float wgt = (l[k][pp] > 0.f) ? l[k][pp] * ex2(m[k][pp] - mm) : 0.f; wsum += wgt;
            float x[8]; unpack8(ox[k][pp], x);
#pragma unroll
            for (int e = 0; e < 8; ++e) o[e] += wgt * x[e]; }
        const float rw = __builtin_amdgcn_rcpf(wsum);
        float gx[8]; unpack8(gz[k], gx);
        float y[8];
#pragma unroll
        for (int e = 0; e < 8; ++e) y[e] = o[e] * rw * siluf_(gx[e]);
        u32x4 ov; ov.x = pk2(y[0], y[1]); ov.y = pk2(y[2], y[3]); ov.z = pk2(y[4], y[5]); ov.w = pk2(y[6], y[7]);
        *(u32x4*)(F.CC + row * DM + cc_col + h * 64 + 8 * c8) = ov; }
}

__device__ __forceinline__ void gla_scan_item2(const Frame& F, int sc, const int rep = 0) {
    LAS float* S = (LAS float*)F.lds;
    const int lane = F.lane, w = F.wave;
    const int gidx = sc * 64 + lane, b = gidx >> 13, rem = gidx & 8191, hd = rem >> 6;
    float* kv = F.KV + ((size_t)b * 128 + 16 * w) * 8192 + rem; const float* bl = F.BL + ((size_t)b * 128 + 16 * w) * 128 + hd;
    float kvv[16], dec[16];
#pragma unroll
    for (int u = 0; u < 16; ++u) { kvv[u] = kv[(size_t)u * 8192]; dec[u] = bl[u * 128]; }
    float A = 1.f, Sx = 0.f;
#pragma unroll
    for (int u = 0; u < 16; ++u) { dec[u] = __expf(dec[u]); Sx = dec[u] * Sx + kvv[u]; A *= dec[u]; }
    __syncthreads();
    S[(w * 2 + 0) * 64 + lane] = A; S[(w * 2 + 1) * 64 + lane] = Sx;
    __syncthreads();
    float X = 0.f;
    for (int ww = 0; ww < w; ++ww) X = S[(ww * 2) * 64 + lane] * X + S[(ww * 2 + 1) * 64 + lane];
#pragma unroll
    for (int u = 0; u < 16; ++u) { if (!rep) kv[(size_t)u * 8192] = X; X = dec[u] * X + kvv[u]; }
    if (rep) asm volatile("" :: "v"(X));
    __syncthreads();
}

#define XB_TMO      128
#define XB_XCNT(j)  (256  + 64 * (j))
#define XB_XSUB(j)  (1280 + 64 * (j))
#define XB_XGEN(j)  (2304 + 64 * (j))
#define XB_TOP      3328
#define XB_TOPGEN   3392
#define XCD_BAR_WORDS 3456
#define XB_SPIN_CAP (1u << 18)

__device__ __forceinline__ unsigned xb_ld(unsigned* p)              { return __hip_atomic_load(p, __ATOMIC_RELAXED, __HIP_MEMORY_SCOPE_AGENT); }
__device__ __forceinline__ unsigned xb_add(unsigned* p, unsigned v) { return __hip_atomic_fetch_add(p, v, __ATOMIC_RELAXED, __HIP_MEMORY_SCOPE_AGENT); }
__device__ __forceinline__ unsigned xb_xcc_id() { return (unsigned)__builtin_amdgcn_s_getreg((3 << 11) | 20) & 0xFu; }
#define XB_SPIN(cond, bar) do { unsigned _sp = 0; while (cond) { __builtin_amdgcn_s_sleep(1); \
    if ((++_sp & 255u) == 0u) { if (xb_ld(&(bar)[XB_TMO])) break; if (_sp > XB_SPIN_CAP) { atomicAdd(&(bar)[XB_TMO], 1u); break; } } } } while (0)

struct XcdBarrier {
    unsigned* bar; unsigned x;
    volatile LAS unsigned* st;
};

__device__ __forceinline__ XcdBarrier xcd_barrier_post(unsigned* bar, volatile LAS unsigned* st) {
    XcdBarrier b; b.bar = bar; b.x = xb_xcc_id(); b.st = st;
    if (threadIdx.x == 0) (void)xb_add(&bar[XB_XCNT(b.x)], 1u);
    return b;
}
__device__ __forceinline__ void xcd_barrier_complete(unsigned* bar, unsigned x, unsigned& nloc, unsigned& nx) {
    const unsigned G = gridDim.x * gridDim.y * gridDim.z;
    unsigned sum, cnt, mine, sp = 0u;
    for (;;) {
        sum = 0u; cnt = 0u; mine = 0u;
#pragma unroll
        for (unsigned j = 0; j < 16; ++j) { const unsigned c = xb_ld(&bar[XB_XCNT(j)]); sum += c; cnt += (c > 0u) ? 1u : 0u; mine = (j == x) ? c : mine; }
        if (sum == G) break;
        __builtin_amdgcn_s_sleep(1);
        if ((++sp & 255u) == 0u) { if (xb_ld(&bar[XB_TMO])) break; if (sp > XB_SPIN_CAP) { atomicAdd(&bar[XB_TMO], 1u); break; } }
    }
    nloc = mine > 0u ? mine : 1u; nx = cnt > 0u ? cnt : 1u;
}

__device__ __forceinline__ void xcd_barrier(const XcdBarrier& b) {
    asm volatile("s_waitcnt vmcnt(0)" ::: "memory");
    __syncthreads();
    if (threadIdx.x == 0) {
        unsigned* bar = b.bar;
        __builtin_amdgcn_s_waitcnt(0);
        unsigned nloc = b.st[0], nx = b.st[1];
        if (nloc == 0u) { xcd_barrier_complete(bar, b.x, nloc, nx); b.st[0] = nloc; b.st[1] = nx; }
        const unsigned old = xb_add(&bar[XB_XSUB(b.x)], 1u);
        const unsigned gen = old / nloc;
        if (old + 1u == (gen + 1u) * nloc) {
            __builtin_amdgcn_fence(__ATOMIC_RELEASE, "agent");
            asm volatile("s_waitcnt vmcnt(0)" ::: "memory");
            const unsigned og = xb_add(&bar[XB_TOP], 1u);
            const unsigned tg = og / nx;
            if (og + 1u == (tg + 1u) * nx) xb_add(&bar[XB_TOPGEN], 1u);
            else XB_SPIN(xb_ld(&bar[XB_TOPGEN]) == tg, bar);
            __builtin_amdgcn_fence(__ATOMIC_ACQUIRE, "agent");
            xb_add(&bar[XB_XGEN(b.x)], 1u);
            asm volatile("s_waitcnt vmcnt(0)" ::: "memory");
        } else {
            XB_SPIN(xb_ld(&bar[XB_XGEN(b.x)]) == gen, bar);
            __builtin_amdgcn_fence(__ATOMIC_ACQUIRE, "agent");
            asm volatile("s_waitcnt vmcnt(0)" ::: "memory");
        }
    }
    __syncthreads();
}

struct Args { const float* in[17]; float* out; unsigned char* ws; int ph_lo, ph_hi, coop, pad; };

constexpr int W_I_IN = 16 * (NZP / 32), W_I_OUT = 16 * 32, W_I_PW = 4 * 8, W_ITEMS_L = W_I_IN + W_I_OUT + W_I_PW;
__device__ __forceinline__ void weight_copy_item(const float* w_in, const float* w_out, const float* w_pw, const float* norm_g, unsigned char* ws, int ll, int r, LAS float* scr, int lane) {
    if (r < W_I_IN) { transpose_item(w_in + (size_t)ll * DM * NZ, DM, NZ, NZP / 32, (bf16_t*)(ws + WS_WIN + ll * WIN_L), scr, r, lane, norm_g + ll * DM); return; } r -= W_I_IN;
    if (r < W_I_OUT) { transpose_item(w_out + (size_t)ll * DM * DM, DM, DM, 32, (bf16_t*)(ws + WS_WOUT + ll * WOUT_L), scr, r, lane); return; } r -= W_I_OUT;
    transpose_item(w_pw + (size_t)ll * 65536, 256, 256, 8, (bf16_t*)(ws + WS_WPW + ll * WPW_L), scr, r, lane);
}
template <int K> __device__ __forceinline__ void run_phase(const int l, LAS unsigned char* lds_base, LAS int* s_item, const int rep = 0) {
        typedef const __attribute__((address_space(4))) Args* ArgP;
        ArgP ap = (ArgP)__builtin_amdgcn_kernarg_segment_ptr(); asm volatile("" : "+s"(ap));
        Frame F;
        F.lds = lds_base;
        { int t_ = threadIdx.x; asm volatile("" : "+v"(t_)); F.tid = t_; F.lane = t_ & 63; F.wave = __builtin_amdgcn_readfirstlane(t_ >> 6); }
        { int g_ = gridDim.x, b_ = blockIdx.x; asm volatile("" : "+s"(g_), "+s"(b_)); F.G = g_; F.bid = b_; }
        unsigned char* ws = ap->ws;
        F.ctl = (unsigned*)(ws + WS_CTL);
        F.H = (bf16_t*)(ws + WS_H); F.Z = (bf16_t*)(ws + WS_Z); F.CC = (bf16_t*)(ws + WS_CC); F.DOp = F.Z + C_DO;
        F.KMP = (float*)(ws + WS_KM + (size_t)l * 65536); F.BL = (float*)(ws + WS_BL); F.DST = (float*)(ws + WS_DST); F.KV = (float*)(ws + WS_KV);
        F.PO = (bf16_t*)(ws + WS_PO); F.PS = (float*)(F.Z + C_PS); F.LIST = (unsigned*)(ws + WS_LIST);
        LayerP P;
        P.norm_g = ap->in[1] + l * DM;
        P.qga = ap->in[3] + l * 64; P.kga = ap->in[4] + l * 64; P.qgb = ap->in[5] + l * 64; P.kgb = ap->in[6] + l * 64;
        P.conv_w = ap->in[7] + l * 31 * 256; P.conv_b = ap->in[8] + l * 256; P.ln_g = ap->in[9] + l * 256; P.ln_b = ap->in[10] + l * 256;
        P.pw_b = ap->in[12] + l * 256; P.gate_w = ap->in[13] + l * 16 * 128; P.gate_b = ap->in[14] + l * 128; P.gla_g = ap->in[15] + l * 64;
        P.WinT = (const bf16_t*)(ws + WS_WIN + l * WIN_L); P.WoutT = (const bf16_t*)(ws + WS_WOUT + l * WOUT_L); P.WpwT = (const bf16_t*)(ws + WS_WPW + l * WPW_L);
        P.xin = (l == 0) ? ap->in[0] : ap->out; P.xout = ap->out;

        if constexpr (K == 0) {
            const int gw = F.bid * NWAVES + F.wave, NGW = F.G * NWAVES;
            if (l == 0) {
                float* z1 = (float*)(ws + WS_SSQ1); float* z2 = (float*)(ws + WS_KM);
                for (int i = F.bid * NTHR + F.tid; i < MTOK + 2 * 16384; i += F.G * NTHR) { if (i < MTOK) z1[i] = 0.f; else z2[i - MTOK] = 0.f; }
            }
            if (l == 0) {
                LAS float* scr = (LAS float*)(F.lds + F.wave * 16384);
                for (int it = gw; it < W_I_IN; it += NGW) weight_copy_item(ap->in[2], ap->in[16], ap->in[11], ap->in[1], ws, 0, it, scr, F.lane);
            }
            if (l == 0) for (int m = gw; m < MTOK; m += 2 * NGW) cvt_row2(P.xin + (size_t)m * DM, F.H + (size_t)m * DM, (float*)(ws + WS_SSQ0) + m, (size_t)NGW, F.lane);
        } else if constexpr (K == 1) {
            pg8::Gemm g{F.H, P.WinT, MTOK, NZP, DM}; pg8::StaticOrder S; S.init(MTOK, NZP, F.G, F.bid);
            pg8::EpiZ E{F.Z, NZP, (const float*)(ws + (l == 0 ? WS_SSQ0 : WS_SSQ1)), 1.0f / DM, EPS, (LAS float*)(F.lds + 135168), P.qga, P.kga, P.qgb, P.kgb, (float*)(ws + WS_KM + (size_t)l * 65536), QSCALE, NZ};
            pg8::gemm_phase<pg8::EpiZ, pg8::StaticOrder, true, true>(F.lds, g, S, E);
            if (l == 0) {
                const int nu = (MTOK / 256) * (NZP / 256), base_u = nu / F.G, rem_u = nu % F.G;
                const int nfree = (rem_u == 0) ? F.G : (F.G - rem_u), fidx = (rem_u == 0) ? F.bid : (F.bid - rem_u);
                if (fidx >= 0) { LAS float* scr = (LAS float*)(F.lds + F.wave * 16384);
                    const int nw_ = nfree * NWAVES, w0_ = fidx * NWAVES + F.wave;
                    for (int it = W_I_IN + w0_; it < W_ITEMS_L; it += nw_) weight_copy_item(ap->in[2], ap->in[16], ap->in[11], ap->in[1], ws, 0, it, scr, F.lane);
                    for (int it = w0_; it < W_ITEMS_L; it += nw_) weight_copy_item(ap->in[2], ap->in[16], ap->in[11], ap->in[1], ws, 1, it, scr, F.lane); }
                (void)base_u;
            }
        } else if constexpr (K == 2) {
            if (!rep) for (int it = F.bid; it < 256; it += F.G) gla_kv_item(F, P, it);
            if (!rep) { unsigned* cnt = F.ctl + 1024 + l * 256;
                for (int it = F.bid; it < 256; it += F.G) moba_topk_unit(F, P, (it >> 2) & 1, it & 3, 31 - (it >> 3), cnt, F.LIST); }
            { const int nr_ = (REP_PHASE == -8) ? 5 : 1; for (int it = F.bid; it < 256 * nr_; it += F.G) conv_item(F, P, it & 255); }
        } else if constexpr (K == 4) {
            if (!rep) for (int it = F.bid; it < 256; it += F.G) gla_scan_item2(F, it);
            att_phase(F, F.ctl + 1024 + l * 256, F.ctl + 2048 + l * 64);
        } else if constexpr (K == 5) {
            { const int nrep_ = (REP_PHASE == -2) ? 4 : 1; for (int it = F.bid; it < 256 * nrep_; it += F.G) gla_out_item(F, P, it & 255); }
            for (int it = F.bid; it < 1024; it += 4 * F.G) combine_items<4, 4>(F, it, F.G, 1024, F.PO, 256, 64, (size_t)MTOK * 256, F.PS, NZP / 2, 8, 2, C_GA, 0);
            for (int it = F.bid; it < 1024; it += 4 * F.G) combine_items<3, 4>(F, it, F.G, 1024, F.DOp, NZP, 64, 256, F.DST, 8, 2, (size_t)MTOK * 8, C_GB, 256);
        } else {
            pg8::Gemm g{F.CC, P.WoutT, MTOK, DM, DM}; pg8::StaticOrder S; S.init(MTOK, DM, F.G, F.bid);
            if (l == 0) { pg8::EpiResX E{F.H, (float*)(ws + WS_SSQ1), DM};
                pg8::gemm_phase<pg8::EpiResX, pg8::StaticOrder, true, true>(F.lds, g, S, E); }
            else { pg8::EpiRes E{F.H, P.xout, DM};
                pg8::gemm_phase<pg8::EpiRes, pg8::StaticOrder, true, true>(F.lds, g, S, E); }
        }
}

__global__ void __launch_bounds__(NTHR, 2) hybrid_fwd(Args args) {
    extern __shared__ __attribute__((aligned(16))) unsigned char lds_raw[];
    cg::grid_group grid = cg::this_grid();
    LAS unsigned char* lds_base = (LAS unsigned char*)lds_raw;
    LAS int* s_item = (LAS int*)(lds_base + LDS_BYTES - 64);
    const int ph_lo = args.ph_lo, ph_hi = args.ph_hi, coop = args.coop;
    volatile LAS unsigned* bst = (volatile LAS unsigned*)(lds_base + LDS_BYTES - 32);
    if (threadIdx.x == 0) { bst[0] = 0u; bst[1] = 0u; }
    __syncthreads();
    XcdBarrier bar; bar.bar = (unsigned*)(args.ws + WS_CTL) + 4096; bar.x = 0; bar.st = bst;
    if (coop) bar = xcd_barrier_post((unsigned*)(args.ws + WS_CTL) + 4096, bst);
#define GRID_BAR() do { if (coop == 2) grid.sync(); else if (coop == 1) xcd_barrier(bar); } while (0)
    if (REP_PHASE == -3 && coop) { for (int zz = 0; zz < 20; ++zz) GRID_BAR(); }
#ifndef ONLY_K
#define ONLY_K -1
#endif
#define RUN(PH) if ((ONLY_K < 0 || ((PH) % 7) == ONLY_K) && ph_lo <= (PH) && (PH) < ph_hi) { run_phase<(PH) % 7>((PH) / 7, lds_base, s_item); \
        if ((PH) == REP_PHASE) { GRID_BAR(); run_phase<(PH) % 7>((PH) / 7, lds_base, s_item, 1); } \
        if ((PH) + 1 < ph_hi) GRID_BAR(); }
#ifdef LAYER_LOOP
    RUN(0)
#define RUNL(KK) { const int ph_ = 7 * lyr + (KK); if ((ONLY_K < 0 || (KK) == ONLY_K) && ph_lo <= ph_ && ph_ < ph_hi) { run_phase<(KK)>(lyr, lds_base, s_item); \
        if (ph_ == REP_PHASE) { GRID_BAR(); run_phase<(KK)>(lyr, lds_base, s_item, 1); } \
        if (ph_ + 1 < ph_hi) GRID_BAR(); } }
#pragma nounroll
    for (int lyr_ = 0; lyr_ < 2; ++lyr_) { int lyr = lyr_; asm volatile("" : "+s"(lyr)); RUNL(1) RUNL(2) RUNL(4) RUNL(5) RUNL(6) }
#undef RUNL
#else
    RUN(0) RUN(1) RUN(2) RUN(4) RUN(5) RUN(6) RUN(8) RUN(9) RUN(11) RUN(12) RUN(13)
#endif
#undef RUN
#undef GRID_BAR
}

extern "C" void kernel_launch(void* const* d_in, const int* in_sizes, int n_in, void* d_out, int out_size, void* d_ws, size_t ws_size, hipStream_t stream) {
    static int grid = 0;
    if (grid == 0) {
        if (n_in != 17 || out_size != MTOK * DM || ws_size < WS_END) { fprintf(stderr, "kernel_launch: unexpected shapes (n_in %d out %d ws %zu)\n", n_in, out_size, ws_size); grid = -1; return; }
        int dev = 0, cus = 0, per_cu = 0;
        hipGetDevice(&dev); hipDeviceGetAttribute(&cus, hipDeviceAttributeMultiprocessorCount, dev);
        if (hipFuncSetAttribute((const void*)hybrid_fwd, hipFuncAttributeMaxDynamicSharedMemorySize, LDS_BYTES) != hipSuccess) { fprintf(stderr, "kernel_launch: hipFuncSetAttribute failed\n"); grid = -1; return; }
        if (hipOccupancyMaxActiveBlocksPerMultiprocessor(&per_cu, (const void*)hybrid_fwd, NTHR, LDS_BYTES) != hipSuccess || per_cu < 1) { fprintf(stderr, "kernel_launch: occupancy query gives %d\n", per_cu); per_cu = 1; }
        (void)hipGetLastError();
        if (per_cu > 1) per_cu = 1;
        grid = cus * per_cu;
    }
    if (grid < 0) return;
    hipMemsetAsync((char*)d_ws + WS_CTL, 0, CTL_ZERO_BYTES, stream);
    Args a{};
    for (int i = 0; i < 17; ++i) a.in[i] = (const float*)d_in[i];
    a.out = (float*)d_out; a.ws = (unsigned char*)d_ws;
#if N_LAUNCH_MODE == 1
    a.ph_lo = 0; a.ph_hi = 14; a.coop = 1;
    void* kargs[] = {&a};
    hipError_t e = hipLaunchCooperativeKernel((const void*)hybrid_fwd, dim3(grid), dim3(NTHR), kargs, LDS_BYTES, stream);
    if (e != hipSuccess) fprintf(stderr, "cooperative launch failed: %s (grid %d)\n", hipGetErrorString(e), grid);
#else
    for (int ph = 0; ph < 14; ++ph) { a.ph_lo = ph; a.ph_hi = ph + 1; a.coop = 0;
        hipLaunchKernelGGL(hybrid_fwd, dim3(grid), dim3(NTHR), LDS_BYTES, stream, a); }
#endif
}
```

```cpp
#include <hip/hip_runtime.h>
#include <hip/hip_cooperative_groups.h>
#include <cstdio>
#include <cstdint>
namespace cg = cooperative_groups;
template <int CTRL> __device__ __forceinline__ float xl_dpp(float v) { return __int_as_float(__builtin_amdgcn_update_dpp(0, __float_as_int(v), CTRL, 0xF, 0xF, true)); }
__device__ __forceinline__ float row16_sum(float v) { v += xl_dpp<0xB1>(v); v += xl_dpp<0x4E>(v); v += xl_dpp<0x141>(v); v += xl_dpp<0x140>(v); return v; }
__device__ __forceinline__ float row16_max(float v) { v = fmaxf(v, xl_dpp<0xB1>(v)); v = fmaxf(v, xl_dpp<0x4E>(v)); v = fmaxf(v, xl_dpp<0x141>(v)); v = fmaxf(v, xl_dpp<0x140>(v)); return v; }
__device__ __forceinline__ float xor16_sum(float v) { const auto r = __builtin_amdgcn_permlane16_swap(__float_as_uint(v), __float_as_uint(v), false, false); return __uint_as_float(r[0]) + __uint_as_float(r[1]); }
__device__ __forceinline__ float xor32_sum(float v) { const auto r = __builtin_amdgcn_permlane32_swap(__float_as_uint(v), __float_as_uint(v), false, false); return __uint_as_float(r[0]) + __uint_as_float(r[1]); }
__device__ __forceinline__ float wave64_sum(float v) { v = row16_sum(v);
    return (__int_as_float(__builtin_amdgcn_readlane(__float_as_int(v), 0)) + __int_as_float(__builtin_amdgcn_readlane(__float_as_int(v), 16))) + (__int_as_float(__builtin_amdgcn_readlane(__float_as_int(v), 32)) + __int_as_float(__builtin_amdgcn_readlane(__float_as_int(v), 48))); }
__device__ __forceinline__ float wave64_max(float v) { v = row16_max(v);
    return fmaxf(fmaxf(__int_as_float(__builtin_amdgcn_readlane(__float_as_int(v), 0)), __int_as_float(__builtin_amdgcn_readlane(__float_as_int(v), 16))), fmaxf(__int_as_float(__builtin_amdgcn_readlane(__float_as_int(v), 32)), __int_as_float(__builtin_amdgcn_readlane(__float_as_int(v), 48)))); }
namespace pg8 {
#define PG8_LAS __attribute__((address_space(3)))
typedef unsigned short bf16_t;
typedef short bf16x8 __attribute__((ext_vector_type(8)));
typedef float f32x4 __attribute__((ext_vector_type(4)));
typedef unsigned u32x4 __attribute__((ext_vector_type(4)));
constexpr int BM = 256, BK = 64, HALF = 128, HTB = HALF * BK * 2  , STAGE_BYTES = 8 * HTB, NXCD = 8, WGM = 8;

__host__ __device__ __forceinline__ int lds_byte(int r, int c) { const int st = (r >> 4) * 2 + (c >> 5), rr = r & 15, cc = c & 31, ob = rr * 64 + cc * 2; return st * 1024 + (ob ^ (((ob >> 9) & 1) << 5)); }
__host__ __device__ __forceinline__ void stage_rc(int b, int& R, int& C) { const int st = b / 1024, sb = b % 1024, swz = sb ^ (((sb >> 9) & 1) << 5); R = (st >> 1) * 16 + swz / 64; C = (st & 1) * 32 + (swz % 64) / 2; }
__host__ __device__ __forceinline__ int perm32(int rho) { const int n = rho >> 4, i = rho & 15; return 8 * (i >> 2) + 4 * n + (i & 3); }

struct Unit { int pm, pn; };
struct Gemm { const bf16_t* A; const bf16_t* Bt; int M, N, K; };

struct StaticOrder {
    int nM, nN, nwg, G, c;
    __host__ __device__ void init(int M, int N, int G_, int c_) { nM = M / BM; nN = N / BM; nwg = nM * nN; G = G_; c = c_; }
    __host__ __device__ bool next(int i, Unit& u) const {
        const long L = (long)i * G + c; if (L >= nwg) return false;
        int wgid = (int)L; { const int q = nwg / NXCD, r = nwg % NXCD, xcd = wgid % NXCD, off = wgid / NXCD; wgid = (xcd < r ? xcd * (q + 1) : r * (q + 1) + (xcd - r) * q) + off; }
        const int nig = WGM * nN, gid = wgid / nig, fm = gid * WGM, gsz = (nM - fm) < WGM ? (nM - fm) : WGM;
        u.pm = fm + ((wgid % nig) % gsz); u.pn = (wgid % nig) / gsz; return true;
    }
    __device__ __forceinline__ void a_ready(const Unit&) const {}
    __device__ __forceinline__ void done(const Unit&) const {}
};

__device__ __forceinline__ unsigned cvt_pk_bf16(float lo, float hi) { unsigned r; asm volatile("v_cvt_pk_bf16_f32 %0, %1, %2" : "=v"(r) : "v"(lo), "v"(hi)); return r; }
struct EpiZ {
    static constexpr bool PERM = true, AFTER_DRAIN = false;
    bf16_t* O; int ldc; const float* ssq; float inv_k, eps;
    PG8_LAS float* xch; const float *qga, *kga, *qgb, *kgb; float* km; float qscale; int ncols;
    __device__ __forceinline__ void operator()(const f32x4 (&acc)[2][2][4][2], const Unit& u, int wr, int wc, int fr, int fq) const {
        const int row0 = u.pm * BM + wr * 64 + fr; const int col0 = u.pn * BM + wc * 32 + 8 * fq;
        const int kind = (u.pn == 0) ? 1 : (u.pn == 1) ? 2 : (u.pn == 4) ? 3 : (u.pn == 5) ? 4 : 0;
        float sc[2][4];
#pragma unroll
        for (int ai = 0; ai < 2; ++ai)
#pragma unroll
            for (int m = 0; m < 4; ++m) sc[ai][m] = __builtin_amdgcn_rsqf(__hip_atomic_load(ssq + row0 + ai * HALF + m * 16, __ATOMIC_RELAXED, __HIP_MEMORY_SCOPE_AGENT) * inv_k + eps);
        const int wave = wr * 4 + wc;
        const float* gp = (kind == 1) ? qga : (kind == 2) ? kga : (kind == 3) ? qgb : kgb;
        const float gs = (kind & 1) ? qscale : 1.0f;
        float g[8];
#pragma unroll
        for (int e2 = 0; e2 < 8; ++e2) g[e2] = gp[32 * (wc & 1) + 8 * fq + e2] * gs;
        if (kind != 0) {
#pragma unroll
            for (int ai = 0; ai < 2; ++ai)
#pragma unroll
                for (int m = 0; m < 4; ++m)
#pragma unroll
                    for (int bj = 0; bj < 2; ++bj) { const f32x4 v0 = acc[ai][bj][m][0] * sc[ai][m], v1 = acc[ai][bj][m][1] * sc[ai][m];
                        float s = (v0[0] * v0[0] + v0[1] * v0[1]) + (v0[2] * v0[2] + v0[3] * v0[3]) + (v1[0] * v1[0] + v1[1] * v1[1]) + (v1[2] * v1[2] + v1[3] * v1[3]);
                        s = xor16_sum(s); s = xor32_sum(s);
                        if (fq == 0) xch[((wave * 2 + ai) * 4 + m) * 32 + bj * 16 + fr] = s; }
        }
        asm volatile("s_waitcnt lgkmcnt(0)" ::: "memory"); __builtin_amdgcn_s_barrier(); asm volatile("" ::: "memory");
        if (kind == 0) {
#pragma unroll
            for (int ai = 0; ai < 2; ++ai)
#pragma unroll
                for (int m = 0; m < 4; ++m) { bf16_t* rowp = O + (size_t)(row0 + ai * HALF + m * 16) * ldc + col0;
#pragma unroll
                    for (int bj = 0; bj < 2; ++bj) { const f32x4 v0 = acc[ai][bj][m][0] * sc[ai][m], v1 = acc[ai][bj][m][1] * sc[ai][m];
                        u32x4 w; w.x = cvt_pk_bf16(v0[0], v0[1]); w.y = cvt_pk_bf16(v0[2], v0[3]); w.z = cvt_pk_bf16(v1[0], v1[1]); w.w = cvt_pk_bf16(v1[2], v1[3]);
                        if (col0 + bj * HALF < ncols) *(u32x4*)(rowp + bj * HALF) = w; } }
            return;
        }
        float kacc[2][8];
#pragma unroll
        for (int bj = 0; bj < 2; ++bj)
#pragma unroll
            for (int e2 = 0; e2 < 8; ++e2) kacc[bj][e2] = 0.f;
        const int we = wave & ~1;
#pragma unroll
        for (int ai = 0; ai < 2; ++ai)
#pragma unroll
            for (int m = 0; m < 4; ++m) { bf16_t* rowp = O + (size_t)(row0 + ai * HALF + m * 16) * ldc + col0;
#pragma unroll
                for (int bj = 0; bj < 2; ++bj) {
                    const float tot = xch[((we * 2 + ai) * 4 + m) * 32 + bj * 16 + fr] + xch[(((we + 1) * 2 + ai) * 4 + m) * 32 + bj * 16 + fr];
                    const float rh = sc[ai][m] * __builtin_amdgcn_rsqf(tot * (1.0f / 64.0f) + eps);
                    f32x4 v0 = acc[ai][bj][m][0] * rh, v1 = acc[ai][bj][m][1] * rh;
                    v0[0] *= g[0]; v0[1] *= g[1]; v0[2] *= g[2]; v0[3] *= g[3]; v1[0] *= g[4]; v1[1] *= g[5]; v1[2] *= g[6]; v1[3] *= g[7];
                    if (kind == 2) { kacc[bj][0] += v0[0]; kacc[bj][1] += v0[1]; kacc[bj][2] += v0[2]; kacc[bj][3] += v0[3]; kacc[bj][4] += v1[0]; kacc[bj][5] += v1[1]; kacc[bj][6] += v1[2]; kacc[bj][7] += v1[3]; }
                    u32x4 w; w.x = cvt_pk_bf16(v0[0], v0[1]); w.y = cvt_pk_bf16(v0[2], v0[3]); w.z = cvt_pk_bf16(v1[0], v1[1]); w.w = cvt_pk_bf16(v1[2], v1[3]);
                    *(u32x4*)(rowp + bj * HALF) = w; } }
        if (kind == 2) {
#pragma unroll
            for (int bj = 0; bj < 2; ++bj)
#pragma unroll
                for (int e2 = 0; e2 < 8; ++e2) { float s = kacc[bj][e2];
                    s = row16_sum(s);
                    if (fr == 0) atomicAdd(km + (size_t)u.pm * 256 + bj * HALF + wc * 32 + 8 * fq + e2, s); }
        }
    }
};
struct EpiResX {
    static constexpr bool PERM = false, AFTER_DRAIN = false;
    bf16_t* xb; float* ssq; int ldc;
    __device__ __forceinline__ void operator()(const f32x4 (&acc)[2][2][4][2], const Unit& u, int wr, int wc, int fr, int fq) const {
        const int col0 = u.pn * BM + wc * 32 + 4 * fq;
#pragma unroll
        for (int ai = 0; ai < 2; ++ai) {
            unsigned long long bs[4][2][2];
#pragma unroll
            for (int m = 0; m < 4; ++m) { const size_t off = (size_t)(u.pm * BM + ai * HALF + wr * 64 + m * 16 + fr) * ldc + col0;
#pragma unroll
                for (int bj = 0; bj < 2; ++bj)
#pragma unroll
                    for (int n = 0; n < 2; ++n) bs[m][bj][n] = *(const unsigned long long*)(xb + off + bj * HALF + n * 16); }
            asm volatile("" ::: "memory");
#pragma unroll
            for (int m = 0; m < 4; ++m) { const int row = u.pm * BM + ai * HALF + wr * 64 + m * 16 + fr; const size_t off = (size_t)row * ldc + col0;
                float s = 0.f;
#pragma unroll
                for (int bj = 0; bj < 2; ++bj)
#pragma unroll
                    for (int n = 0; n < 2; ++n) { const unsigned long long wv = bs[m][bj][n]; const unsigned lo = (unsigned)wv, hi = (unsigned)(wv >> 32);
                        f32x4 r; r[0] = __uint_as_float(lo << 16); r[1] = __uint_as_float(lo & 0xffff0000u); r[2] = __uint_as_float(hi << 16); r[3] = __uint_as_float(hi & 0xffff0000u);
                        const f32x4 x1 = r + acc[ai][bj][m][n];
                        unsigned long long w = (unsigned long long)cvt_pk_bf16(x1[0], x1[1]) | ((unsigned long long)cvt_pk_bf16(x1[2], x1[3]) << 32);
                        *(unsigned long long*)(xb + off + bj * HALF + n * 16) = w;
                        s += (x1[0] * x1[0] + x1[1] * x1[1]) + (x1[2] * x1[2] + x1[3] * x1[3]); }
                s = xor16_sum(s); s = xor32_sum(s);
                if (fq == 0) atomicAdd(ssq + row, s); }
            asm volatile("" ::: "memory");
        }
    }
};
struct EpiRes {
    static constexpr bool PERM = false, AFTER_DRAIN = false;
    const bf16_t* xb; float* out; int ldc;
    __device__ __forceinline__ void operator()(const f32x4 (&acc)[2][2][4][2], const Unit& u, int wr, int wc, int fr, int fq) const {
        const int col0 = u.pn * BM + wc * 32 + 4 * fq;
        unsigned long long bs[2][4][2][2];
#pragma unroll
        for (int ai = 0; ai < 2; ++ai)
#pragma unroll
            for (int m = 0; m < 4; ++m) { const size_t off = (size_t)(u.pm * BM + ai * HALF + wr * 64 + m * 16 + fr) * ldc + col0;
#pragma unroll
                for (int bj = 0; bj < 2; ++bj)
#pragma unroll
                    for (int n = 0; n < 2; ++n) bs[ai][m][bj][n] = *(const unsigned long long*)(xb + off + bj * HALF + n * 16); }
        asm volatile("" ::: "memory");
#pragma unroll
        for (int ai = 0; ai < 2; ++ai)
#pragma unroll
            for (int m = 0; m < 4; ++m) { const size_t off = (size_t)(u.pm * BM + ai * HALF + wr * 64 + m * 16 + fr) * ldc + col0;
#pragma unroll
                for (int bj = 0; bj < 2; ++bj)
#pragma unroll
                    for (int n = 0; n < 2; ++n) { const unsigned long long w = bs[ai][m][bj][n]; const unsigned lo = (unsigned)w, hi = (unsigned)(w >> 32);
                        f32x4 r; r[0] = __uint_as_float(lo << 16); r[1] = __uint_as_float(lo & 0xffff0000u); r[2] = __uint_as_float(hi << 16); r[3] = __uint_as_float(hi & 0xffff0000u);
                        *(f32x4*)(out + off + bj * HALF + n * 16) = r + acc[ai][bj][m][n]; } }
    }
};
template <class Epi, class Sched, bool ALIGN_EPI = false, bool SP2 = false>
__device__ __forceinline__ void gemm_phase(PG8_LAS unsigned char* lds, const Gemm g, const Sched& S, const Epi& E) {
    int tid_l = threadIdx.x; asm volatile("" : "+v"(tid_l));
    const int tid = tid_l, wid = __builtin_amdgcn_readfirstlane(tid >> 6), lane = tid & 63, wr = wid >> 2, wc = wid & 3, fr = lane & 15, fq = lane >> 4;
    const int K = g.K, nt = K / BK;
    unsigned voffA[2], voffB[2];
#pragma unroll
    for (int i = 0; i < 2; ++i) { int R, C; stage_rc(tid * 16 + i * 8192, R, C); const int Rb = Epi::PERM ? ((R & ~31) + perm32(R & 31)) : R;
        voffA[i] = (unsigned)(R * K + C) * 2u; voffB[i] = (unsigned)(Rb * K + C) * 2u; }
    const size_t kstep = (size_t)(BK * 2);
    const size_t hstep = (size_t)HALF * K * 2;
    const size_t tstep = 2 * hstep;
    const unsigned ldsw = (unsigned)wid * 1024u;
    const int aoff = lds_byte(wr * 64 + fr, fq * 8), boff = lds_byte(wc * 32 + fr, fq * 8);
#define PG8_SA(b, h) (((b) * 2 + (h)) * HTB)
#define PG8_SB(b, h) ((4 + (b) * 2 + (h)) * HTB)
#define PG8_STAGE(bufoff, gbase, voff) do { _Pragma("unroll") for (int _i = 0; _i < 2; ++_i) \
        __builtin_amdgcn_global_load_lds((const unsigned*)((const char*)(gbase) + (voff)[_i]), (PG8_LAS unsigned*)(lds + (bufoff) + ldsw + _i * 8192), 16, 0, 0); } while (0)
#define PG8_LDA(dst, b, h) do { _Pragma("unroll") for (int m = 0; m < 4; ++m) _Pragma("unroll") for (int k = 0; k < 2; ++k) dst[m][k] = *(const PG8_LAS bf16x8*)(lds + PG8_SA(b, h) + aoff + m * 2048 + k * 1024); } while (0)
#define PG8_LDB(dst, b, h) do { _Pragma("unroll") for (int n = 0; n < 2; ++n) _Pragma("unroll") for (int k = 0; k < 2; ++k) dst[n][k] = *(const PG8_LAS bf16x8*)(lds + PG8_SB(b, h) + boff + n * 2048 + k * 1024); } while (0)
#define PG8_MMA(ai, bj, At, Bt) do { __builtin_amdgcn_s_setprio(1); _Pragma("unroll") for (int m = 0; m < 4; ++m) _Pragma("unroll") for (int n = 0; n < 2; ++n) _Pragma("unroll") for (int k = 0; k < 2; ++k) \
        acc[ai][bj][m][n] = __builtin_amdgcn_mfma_f32_16x16x32_bf16(Bt[n][k], At[m][k], acc[ai][bj][m][n], 0, 0, 0); __builtin_amdgcn_s_setprio(0); } while (0)
#define PG8_WAIT_V(n) asm volatile("s_waitcnt vmcnt(" #n ")" ::: "memory")
#define PG8_WAIT_L(n) asm volatile("s_waitcnt lgkmcnt(" #n ")" ::: "memory")
#define PG8_BAR __builtin_amdgcn_s_barrier()
#define PG8_SCHED __builtin_amdgcn_sched_barrier(0)
    Unit cur, nxt; int ui = 0;
    if (!S.next(0, cur)) return;
    f32x4 acc[2][2][4][2];
#pragma unroll
    for (int a = 0; a < 2; ++a)
#pragma unroll
        for (int b = 0; b < 2; ++b)
#pragma unroll
            for (int m = 0; m < 4; ++m)
#pragma unroll
                for (int n = 0; n < 2; ++n) acc[a][b][m][n] = (f32x4){0.f, 0.f, 0.f, 0.f};
    bf16x8 At[4][2], B0[2][2], B1[2][2];
    const char* cA = (const char*)g.A + (size_t)cur.pm * tstep; const char* cB = (const char*)g.Bt + (size_t)cur.pn * tstep;
    S.a_ready(cur);
    if constexpr (SP2) {
        PG8_STAGE(PG8_SB(0, 0), cB, voffB); PG8_STAGE(PG8_SB(0, 1), cB + hstep, voffB); PG8_STAGE(PG8_SA(0, 0), cA, voffA); PG8_STAGE(PG8_SA(0, 1), cA + hstep, voffA);
        if (wr == 1) PG8_BAR;
        PG8_WAIT_V(2); PG8_BAR;
        PG8_STAGE(PG8_SB(1, 0), cB + kstep, voffB); PG8_STAGE(PG8_SA(1, 0), cA + kstep, voffA); PG8_STAGE(PG8_SB(1, 1), cB + hstep + kstep, voffB);
        PG8_WAIT_V(6); PG8_BAR;
    } else {
        PG8_STAGE(PG8_SB(0, 0), cB, voffB); PG8_STAGE(PG8_SA(0, 0), cA, voffA); PG8_STAGE(PG8_SB(0, 1), cB + hstep, voffB); PG8_STAGE(PG8_SA(0, 1), cA + hstep, voffA);
        if (wr == 1) PG8_BAR;
        PG8_WAIT_V(4); PG8_BAR;
        PG8_STAGE(PG8_SB(1, 0), cB + kstep, voffB); PG8_STAGE(PG8_SA(1, 0), cA + kstep, voffA); PG8_STAGE(PG8_SB(1, 1), cB + hstep + kstep, voffB);
        PG8_WAIT_V(6); PG8_BAR;
    }
    for (;;) {
        const bool has_next = S.next(ui + 1, nxt);
        const char* nA = has_next ? (const char*)g.A + (size_t)nxt.pm * tstep : cA; const char* nB = has_next ? (const char*)g.Bt + (size_t)nxt.pn * tstep : cB;
        for (int t = 0; t < nt; t += 2) {
            const bool last = (t == nt - 2);
            const char* a1 = cA + (size_t)(t + 1) * kstep;
            const char* a2 = last ? nA : cA + (size_t)(t + 2) * kstep; const char* b2 = last ? nB : cB + (size_t)(t + 2) * kstep;
            const char* a3 = a2 + kstep; const char* b3 = b2 + kstep;
            if (last && has_next) S.a_ready(nxt);
            if constexpr (SP2) {
            PG8_LDB(B0, 0, 0); PG8_LDB(B1, 0, 1); PG8_SCHED; PG8_LDA(At, 0, 0); PG8_STAGE(PG8_SA(1, 1), a1 + hstep, voffA);
            PG8_WAIT_V(8); PG8_WAIT_L(0); PG8_BAR; PG8_MMA(0, 0, At, B0); PG8_MMA(0, 1, At, B1); PG8_BAR; PG8_SCHED;
            PG8_LDA(At, 0, 1); PG8_STAGE(PG8_SB(0, 0), b2, voffB); PG8_STAGE(PG8_SB(0, 1), b2 + hstep, voffB); PG8_STAGE(PG8_SA(0, 0), a2, voffA);
            PG8_WAIT_V(8); PG8_WAIT_L(0); PG8_BAR; PG8_MMA(1, 0, At, B0); PG8_MMA(1, 1, At, B1); PG8_BAR; PG8_SCHED;
            PG8_LDB(B0, 1, 0); PG8_LDB(B1, 1, 1); PG8_SCHED; PG8_LDA(At, 1, 0); PG8_STAGE(PG8_SA(0, 1), a2 + hstep, voffA);
            PG8_WAIT_V(8); PG8_WAIT_L(0); PG8_BAR; PG8_MMA(0, 0, At, B0); PG8_MMA(0, 1, At, B1); PG8_BAR; PG8_SCHED;
            PG8_LDA(At, 1, 1); PG8_STAGE(PG8_SB(1, 0), b3, voffB); PG8_STAGE(PG8_SB(1, 1), b3 + hstep, voffB); PG8_STAGE(PG8_SA(1, 0), a3, voffA);
            PG8_WAIT_V(8); PG8_WAIT_L(0); PG8_BAR; PG8_MMA(1, 0, At, B0); PG8_MMA(1, 1, At, B1); PG8_BAR; PG8_SCHED;
            } else {
            PG8_LDB(B0, 0, 0); PG8_SCHED; PG8_LDA(At, 0, 0); PG8_STAGE(PG8_SA(1, 1), a1 + hstep, voffA);
            PG8_WAIT_L(8); PG8_BAR; PG8_WAIT_L(0); PG8_MMA(0, 0, At, B0); PG8_BAR; PG8_SCHED;
            PG8_LDB(B1, 0, 1); PG8_STAGE(PG8_SB(0, 0), b2, voffB);
            PG8_BAR; PG8_WAIT_L(0); PG8_MMA(0, 1, At, B1); PG8_BAR;
            PG8_LDA(At, 0, 1); PG8_STAGE(PG8_SA(0, 0), a2, voffA);
            PG8_BAR; PG8_WAIT_L(0); PG8_MMA(1, 0, At, B0); PG8_BAR; PG8_SCHED;
            PG8_STAGE(PG8_SB(0, 1), b2 + hstep, voffB);
            PG8_WAIT_V(6); PG8_BAR; PG8_MMA(1, 1, At, B1); PG8_BAR;
            PG8_LDB(B0, 1, 0); PG8_SCHED; PG8_LDA(At, 1, 0); PG8_STAGE(PG8_SA(0, 1), a2 + hstep, voffA);
            PG8_WAIT_L(8); PG8_BAR; PG8_WAIT_L(0); PG8_MMA(0, 0, At, B0); PG8_BAR; PG8_SCHED;
            PG8_LDB(B1, 1, 1); PG8_STAGE(PG8_SB(1, 0), b3, voffB);
            PG8_BAR; PG8_WAIT_L(0); PG8_MMA(0, 1, At, B1); PG8_BAR;
            PG8_LDA(At, 1, 1); PG8_STAGE(PG8_SA(1, 0), a3, voffA);
            PG8_BAR; PG8_WAIT_L(0); PG8_MMA(1, 0, At, B0); PG8_BAR; PG8_SCHED;
            PG8_STAGE(PG8_SB(1, 1), b3 + hstep, voffB);
            PG8_WAIT_V(6); PG8_BAR; PG8_MMA(1, 1, At, B1); PG8_BAR;
            }
        }
        if constexpr (ALIGN_EPI) { if (wr == 0) PG8_BAR; }
        if constexpr (!Epi::AFTER_DRAIN) { E(acc, cur, wr, wc, fr, fq); S.done(cur); }
        if (!has_next) break;
#pragma unroll
        for (int a = 0; a < 2; ++a)
#pragma unroll
            for (int b = 0; b < 2; ++b)
#pragma unroll
                for (int m = 0; m < 4; ++m)
#pragma unroll
                    for (int n = 0; n < 2; ++n) acc[a][b][m][n] = (f32x4){0.f, 0.f, 0.f, 0.f};
        cur = nxt; cA = nA; cB = nB; ++ui;
        if constexpr (ALIGN_EPI) { if (wr == 1) PG8_BAR; }
    }
    PG8_WAIT_V(0);
    if constexpr (!ALIGN_EPI) { if (wr == 0) PG8_BAR; }
    PG8_BAR;
    if constexpr (Epi::AFTER_DRAIN) { E.fused(acc, cur, wr, wc, fr, fq, lds, wid, lane); S.done(cur); }
#undef PG8_SA
#undef PG8_SB
#undef PG8_STAGE
#undef PG8_LDA
#undef PG8_LDB
#undef PG8_MMA
#undef PG8_WAIT_V
#undef PG8_WAIT_L
#undef PG8_BAR
#undef PG8_SCHED
}
}

#define LAS __attribute__((address_space(3)))
typedef unsigned short bf16_t;
typedef short bf16x8 __attribute__((ext_vector_type(8)));
typedef float f32x4 __attribute__((ext_vector_type(4)));
typedef float f32x16 __attribute__((ext_vector_type(16)));
typedef unsigned u32x4 __attribute__((ext_vector_type(4)));
typedef unsigned u32x2 __attribute__((ext_vector_type(2)));
typedef short v4i16_t __attribute__((ext_vector_type(4)));

constexpr int NB = 2, SEQ = 8192, MTOK = NB * SEQ, DM = 1024, NZ = 3600, NZP = 3840, DEPTH = 2;
constexpr int C_QA = 0, C_KA = 256, C_VA = 512, C_GA = 768, C_QB = 1024, C_KB = 1280, C_VB = 1536, C_GB = 1792;
constexpr int C_CA = 2048, C_CG = 2304, C_GC = 2560, C_QD = 2816, C_KD = 2944, C_VD = 3072, C_LR = 3328, C_GD = 3344;
constexpr float EPS = 1e-6f, LOG2E = 1.4426950408889634f, QSCALE = 0.125f * LOG2E;
constexpr int NTHR = 512, NWAVES = 8;
constexpr int LDS_BYTES = 155648;

#ifndef REP_PHASE
#define REP_PHASE -1
#endif
#ifndef N_LAUNCH_MODE
#define N_LAUNCH_MODE 1
#endif

constexpr size_t MiB = 1u << 20;
constexpr size_t WS_CTL = 0, CTL_ZERO_BYTES = 32 * 1024;
constexpr size_t WS_SSQ0 = 256 * 1024, WS_SSQ1 = 384 * 1024;
constexpr size_t WS_KM = 512 * 1024;
constexpr size_t WS_WIN = 1 * MiB;
constexpr size_t WIN_L = (size_t)NZP * DM * 2;
constexpr size_t WS_WOUT = 16 * MiB;
constexpr size_t WOUT_L = (size_t)DM * DM * 2;
constexpr size_t WS_WPW = 20 * MiB;
constexpr size_t WPW_L = 256 * 256 * 2;
constexpr size_t WS_BL = 20 * MiB + 768 * 1024;
constexpr size_t WS_DST = 21 * MiB;
constexpr size_t WS_KV = 23 * MiB;
constexpr size_t WS_PO = 32 * MiB;
constexpr size_t WS_H = 64 * MiB;
constexpr size_t WS_CC = 96 * MiB;
constexpr size_t WS_Z = 128 * MiB;
constexpr size_t WS_LIST = 248 * MiB;
constexpr size_t WS_END = 256 * MiB;
constexpr int C_DO = C_CA;
constexpr int C_PS = NZ;

__device__ __forceinline__ float bf2f(unsigned v) { return __uint_as_float(v << 16); }
typedef float f32x2c_t __attribute__((ext_vector_type(2))); typedef __bf16 bf16x2c_t __attribute__((ext_vector_type(2)));
__device__ __forceinline__ unsigned cvtpk_(float lo, float hi) { f32x2c_t v = {lo, hi}; bf16x2c_t b = __builtin_convertvector(v, bf16x2c_t); return __builtin_bit_cast(unsigned, b); }
__device__ __forceinline__ unsigned pk2(float lo, float hi) { return cvtpk_(lo, hi); }
__device__ __forceinline__ unsigned f2bf(float f) { return cvtpk_(f, 0.f) & 0xffffu; }
__device__ __forceinline__ void unpack8(const u32x4 a, float (&x)[8]) {
#pragma unroll
    for (int k = 0; k < 4; ++k) { x[2 * k] = bf2f(a[k] & 0xffffu); x[2 * k + 1] = bf2f(a[k] >> 16); }
}
__device__ __forceinline__ float wave_sum(float v) {
    return wave64_sum(v);
}
__device__ __forceinline__ float sigmoidf_(float x) { return __builtin_amdgcn_rcpf(1.0f + __expf(-x)); }
__device__ __forceinline__ float siluf_(float x) { return x * __builtin_amdgcn_rcpf(1.0f + __expf(-x)); }
__device__ __forceinline__ float logsigmoidf_(float x) { return x < 0.f ? x - log1pf(__expf(x)) : -log1pf(__expf(-x)); }
__device__ __forceinline__ int crow(int r, int hi) { return (r & 3) + 8 * (r >> 2) + 4 * hi; }
__device__ __forceinline__ float ex2(float x) { return __builtin_amdgcn_exp2f(x); }


__device__ __forceinline__ bf16x8 frag_tr_perm(const LAS bf16_t* img, int pitch, int kb, int colbase, int lane) {
    const int hf = lane >> 5, i = lane & 15;
    const LAS bf16_t* a = img + (kb + 4 * hf + (i >> 2)) * pitch + colbase + 16 * ((lane >> 4) & 1) + 4 * (i & 3);
    const v4i16_t lo = __builtin_amdgcn_ds_read_tr16_b64_v4i16((LAS v4i16_t*)a);
    const v4i16_t hi = __builtin_amdgcn_ds_read_tr16_b64_v4i16((LAS v4i16_t*)(a + 8 * pitch));
    return (bf16x8){lo[0], lo[1], lo[2], lo[3], hi[0], hi[1], hi[2], hi[3]};
}
struct LayerP {
    const float *norm_g, *qga, *kga, *qgb, *kgb, *conv_w, *conv_b, *ln_g, *ln_b, *pw_b, *gate_w, *gate_b, *gla_g;
    const bf16_t *WinT, *WoutT, *WpwT;
    const float* xin; float* xout;
};
struct Frame {
    LAS unsigned char* lds;
    int tid, lane, wave, G, bid;
    unsigned* ctl;
    bf16_t *H, *Z, *CC, *DOp, *PO; float *KMP, *BL, *DST, *KV, *PS; unsigned* LIST;
};

__device__ __forceinline__ void transpose_item(const float* W, int K, int N, int NPb, bf16_t* WT, LAS float* scr, int item, int lane, const float* kscale = nullptr) {
    const int nblk = NPb, kb = item / nblk, nb = item % nblk, k0 = 64 * kb, n0 = 32 * nb;
    const int nn = n0 + (lane & 31);
    float wv[32];
#pragma unroll
    for (int i = 0; i < 32; ++i) { const int kk = 2 * i + (lane >> 5); wv[i] = (nn < N) ? __builtin_nontemporal_load(W + (size_t)(k0 + kk) * N + nn) : 0.f; }
    if (kscale) {
#pragma unroll
        for (int i = 0; i < 32; ++i) wv[i] *= kscale[k0 + 2 * i + (lane >> 5)]; }
#pragma unroll
    for (int i = 0; i < 32; ++i) scr[(2 * i + (lane >> 5)) * 33 + (lane & 31)] = wv[i];
    asm volatile("s_waitcnt lgkmcnt(0)" ::: "memory");
    const int c = lane & 7;
#pragma unroll
    for (int j = 0; j < 4; ++j) { const int n = (lane >> 3) + 8 * j; const LAS float* s = scr + (8 * c) * 33 + n;
        u32x4 o; o.x = pk2(s[0 * 33], s[1 * 33]); o.y = pk2(s[2 * 33], s[3 * 33]); o.z = pk2(s[4 * 33], s[5 * 33]); o.w = pk2(s[6 * 33], s[7 * 33]);
        *(u32x4*)(WT + (size_t)(n0 + n) * K + k0 + 8 * c) = o; }
    asm volatile("s_waitcnt lgkmcnt(0)" ::: "memory");
}
__device__ __forceinline__ void cvt_row(const float* xrow, bf16_t* orow, float* ssq_out, int lane) {
    const f32x4* xr = (const f32x4*)xrow + lane;
    f32x4 v[4]; float s = 0.f;
#pragma unroll
    for (int j = 0; j < 4; ++j) { v[j] = xr[64 * j]; s += (v[j].x * v[j].x + v[j].y * v[j].y) + (v[j].z * v[j].z + v[j].w * v[j].w); }
    unsigned long long* o8 = (unsigned long long*)orow + lane;
#pragma unroll
    for (int j = 0; j < 4; ++j) o8[64 * j] = (unsigned long long)pk2(v[j].x, v[j].y) | ((unsigned long long)pk2(v[j].z, v[j].w) << 32);
    s = wave_sum(s);
    if (lane == 0) *ssq_out = s;
}

__device__ __forceinline__ void cvt_row2(const float* xrow, bf16_t* orow, float* ssq_out, size_t rstride, int lane) {
    f32x4 v[2][4];
#pragma unroll
    for (int t = 0; t < 2; ++t)
#pragma unroll
        for (int j = 0; j < 4; ++j) v[t][j] = __builtin_nontemporal_load((const f32x4*)(xrow + t * rstride * DM) + lane + 64 * j);
#pragma unroll
    for (int t = 0; t < 2; ++t) { float s = 0.f;
        unsigned long long* o8 = (unsigned long long*)(orow + t * rstride * DM) + lane;
#pragma unroll
        for (int j = 0; j < 4; ++j) { s += (v[t][j].x * v[t][j].x + v[t][j].y * v[t][j].y) + (v[t][j].z * v[t][j].z + v[t][j].w * v[t][j].w);
            o8[64 * j] = (unsigned long long)pk2(v[t][j].x, v[t][j].y) | ((unsigned long long)pk2(v[t][j].z, v[t][j].w) << 32); }
        s = wave_sum(s);
        if (lane == 0) ssq_out[t * rstride] = s; }
}

__device__ __forceinline__ float logsigmoid_fast(float x) { return fminf(x, 0.f) - __logf(1.0f + __expf(-fabsf(x))); }
constexpr int GL_BC = 0;
constexpr int GL_V = 64 * 132;
constexpr int GL_KH = GL_V + 64 * 264 / 2;
constexpr int GL_LR = GL_KH + 64 * 136 / 2;
constexpr int GL_TOT = GL_LR + 64 * 20;
constexpr int GL_END = GL_TOT + 512;
static_assert(GL_END * 4 <= 140 * 1024, "GLA LDS");

__device__ __forceinline__ void gla_kv_item(const Frame& F, const LayerP& P, int it) {
    LAS float* S = (LAS float*)F.lds; LAS float* bcS = S + GL_BC; LAS bf16_t* vS = (LAS bf16_t*)(S + GL_V); LAS bf16_t* khS = (LAS bf16_t*)(S + GL_KH); LAS float* lrS = S + GL_LR; LAS float* totS = S + GL_TOT;
    const int m0 = it * 64, tid = F.tid, lane = F.lane;
    unsigned lrv; { const int idx = tid * 2, row = idx >> 4, c = idx & 15; lrv = *(const unsigned*)(F.Z + (size_t)(m0 + row) * NZP + C_LR + c); }
    const int cc = tid & 127, jg = tid >> 7;
    float wv[16];
#pragma unroll
    for (int r = 0; r < 16; ++r) wv[r] = P.gate_w[r * 128 + cc];
    const float bias = P.gate_b[cc];
    u32x4 qx[2], kx[2], vx[4];
#pragma unroll
    for (int i = 0; i < 2; ++i) { const int q = tid + 512 * i, j = q >> 4, c8 = q & 15; const bf16_t* zr = F.Z + (size_t)(m0 + j) * NZP + 8 * c8;
        qx[i] = *(const u32x4*)(zr + C_QD); kx[i] = *(const u32x4*)(zr + C_KD); }
#pragma unroll
    for (int i = 0; i < 4; ++i) { const int q = tid + 512 * i, j = q >> 5, c8 = q & 31; vx[i] = *(const u32x4*)(F.Z + (size_t)(m0 + j) * NZP + C_VD + 8 * c8); }
    __syncthreads();
    { const int idx = tid * 2, row = idx >> 4, c = idx & 15; lrS[row * 20 + c] = bf2f(lrv & 0xffffu); lrS[row * 20 + c + 1] = bf2f(lrv >> 16); }
#pragma unroll
    for (int i = 0; i < 4; ++i) { const int q = tid + 512 * i, j = q >> 5, c8 = q & 31; *(LAS u32x4*)(vS + j * 264 + 8 * c8) = vx[i]; }
    __syncthreads();
    float loc[16]; float run = 0.f;
#pragma unroll
    for (int i = 0; i < 16; ++i) { const int j = jg * 16 + i; float x = bias;
#pragma unroll
        for (int r4 = 0; r4 < 4; ++r4) { const f32x4 lv = *(const LAS f32x4*)(lrS + j * 20 + 4 * r4);
            x += lv.x * wv[4 * r4] + lv.y * wv[4 * r4 + 1] + lv.z * wv[4 * r4 + 2] + lv.w * wv[4 * r4 + 3]; }
        run += logsigmoid_fast(x) * (1.0f / 16.0f); loc[i] = run; }
    totS[jg * 128 + cc] = run;
    __syncthreads();
    float off = 0.f;
    for (int gg = 0; gg < jg; ++gg) off += totS[gg * 128 + cc];
#pragma unroll
    for (int i = 0; i < 16; ++i) bcS[(jg * 16 + i) * 132 + cc] = off + loc[i];
    __syncthreads();
    float eb[2][8];
#pragma unroll
    for (int i = 0; i < 2; ++i) { const int c8 = (tid + 512 * i) & 15;
#pragma unroll
        for (int e = 0; e < 8; ++e) eb[i][e] = __expf(bcS[63 * 132 + 8 * c8 + e]); }
    if (tid < 128) F.BL[(size_t)it * 128 + tid] = bcS[63 * 132 + tid];
    __syncthreads();
#pragma unroll
    for (int i = 0; i < 2; ++i) { const int q = tid + 512 * i, j = q >> 4, c8 = q & 15; float xq[8], xk[8], yq[8], yk[8]; unpack8(qx[i], xq); unpack8(kx[i], xk);
        const f32x4 b0 = *(const LAS f32x4*)(bcS + j * 132 + 8 * c8), b1 = *(const LAS f32x4*)(bcS + j * 132 + 8 * c8 + 4);
        const float bcv[8] = {b0.x, b0.y, b0.z, b0.w, b1.x, b1.y, b1.z, b1.w}; float kh[8];
#pragma unroll
        for (int e = 0; e < 8; ++e) { const float e1 = __expf(bcv[e]), e2 = __builtin_amdgcn_rcpf(e1);
            yq[e] = xq[e] * 0.17677669529663687f * e1; yk[e] = xk[e] * e2;
            kh[e] = xk[e] * (eb[i][e] * e2); }
        { u32x4 kw; kw.x = pk2(kh[0], kh[1]); kw.y = pk2(kh[2], kh[3]); kw.z = pk2(kh[4], kh[5]); kw.w = pk2(kh[6], kh[7]); *(LAS u32x4*)(khS + j * 136 + 8 * c8) = kw; }
        bf16_t* zr = F.Z + (size_t)(m0 + j) * NZP + 8 * c8;
        u32x4 o; o.x = pk2(yq[0], yq[1]); o.y = pk2(yq[2], yq[3]); o.z = pk2(yq[4], yq[5]); o.w = pk2(yq[6], yq[7]); *(u32x4*)(zr + C_QD) = o;
        o.x = pk2(yk[0], yk[1]); o.y = pk2(yk[2], yk[3]); o.z = pk2(yk[4], yk[5]); o.w = pk2(yk[6], yk[7]); *(u32x4*)(zr + C_KD) = o; }
    __syncthreads();
    const int h = F.wave >> 1, vh = F.wave & 1;
    f32x16 acc;
#pragma unroll
    for (int r = 0; r < 16; ++r) acc[r] = 0.f;
    { const int hf = lane >> 5, i15 = lane & 15, g1 = (lane >> 4) & 1;
      const LAS bf16_t* ka = khS + (8 * hf + (i15 >> 2)) * 136 + h * 32 + 16 * g1 + 4 * (i15 & 3);
      const LAS bf16_t* va = vS + (8 * hf + (i15 >> 2)) * 264 + h * 64 + 32 * vh + 16 * g1 + 4 * (i15 & 3);
#pragma unroll
      for (int s = 0; s < 4; ++s) {
          const v4i16_t a0 = __builtin_amdgcn_ds_read_tr16_b64_v4i16((LAS v4i16_t*)(ka + (16 * s) * 136)), a1 = __builtin_amdgcn_ds_read_tr16_b64_v4i16((LAS v4i16_t*)(ka + (16 * s + 4) * 136));
          const v4i16_t b0 = __builtin_amdgcn_ds_read_tr16_b64_v4i16((LAS v4i16_t*)(va + (16 * s) * 264)), b1 = __builtin_amdgcn_ds_read_tr16_b64_v4i16((LAS v4i16_t*)(va + (16 * s + 4) * 264));
          acc = __builtin_amdgcn_mfma_f32_32x32x16_bf16((bf16x8){a0[0], a0[1], a0[2], a0[3], a1[0], a1[1], a1[2], a1[3]}, (bf16x8){b0[0], b0[1], b0[2], b0[3], b1[0], b1[1], b1[2], b1[3]}, acc, 0, 0, 0); } }
    float* kvp = F.KV + ((size_t)it * 4 + h) * 2048;
#pragma unroll
    for (int r = 0; r < 16; ++r) { const int d = crow(r, lane >> 5); kvp[d * 64 + 32 * vh + (lane & 31)] = acc[r]; }
}

constexpr int GO_Q = 0;
constexpr int GO_K = 64 * 136 * 2;
constexpr int GO_VT = 2 * 64 * 136 * 2;
constexpr int GO_OUT = GO_VT + 256 * 72 * 2;
static_assert(GO_OUT + 64 * 260 * 4 <= 140 * 1024, "GLA out LDS");
__device__ __forceinline__ void gla_out_item(const Frame& F, const LayerP& P, int it) {
    LAS bf16_t* QtS = (LAS bf16_t*)(F.lds + GO_Q); LAS bf16_t* KtS = (LAS bf16_t*)(F.lds + GO_K); LAS bf16_t* VT = (LAS bf16_t*)(F.lds + GO_VT); LAS float* oS = (LAS float*)(F.lds + GO_OUT);
    const int m0 = it * 64, tid = F.tid, lane = F.lane, hf = lane >> 5, l31 = lane & 31;
    const int h = F.wave >> 1, ih = F.wave & 1;
    u32x4 qx[2], kx[2], vx[4], gx[4];
#pragma unroll
    for (int i = 0; i < 2; ++i) { const int q = tid + 512 * i, j = q >> 4, c8 = q & 15; const bf16_t* zr = F.Z + (size_t)(m0 + j) * NZP + 8 * c8;
        qx[i] = *(const u32x4*)(zr + C_QD); kx[i] = *(const u32x4*)(zr + C_KD); }
#pragma unroll
    for (int i = 0; i < 4; ++i) { const int q = tid + 512 * i, j = q >> 5, c8 = q & 31; vx[i] = *(const u32x4*)(F.Z + (size_t)(m0 + j) * NZP + C_VD + 8 * c8); }
#pragma unroll
    for (int i = 0; i < 4; ++i) { const int q = tid + 512 * i, j = q >> 5, c8 = q & 31; gx[i] = *(const u32x4*)(F.Z + (size_t)(m0 + j) * NZP + C_GD + 8 * c8); }
    float sta[2][2][8];
    { const float* st = F.KV + ((size_t)it * 4 + h) * 2048;
#pragma unroll
      for (int vt = 0; vt < 2; ++vt)
#pragma unroll
          for (int s = 0; s < 2; ++s)
#pragma unroll
              for (int jj = 0; jj < 8; ++jj) sta[vt][s][jj] = st[(16 * s + 8 * hf + jj) * 64 + 32 * vt + l31]; }
    float gn[2][16];
#pragma unroll
    for (int vt = 0; vt < 2; ++vt)
#pragma unroll
        for (int r = 0; r < 16; ++r) gn[vt][r] = P.gla_g[32 * vt + crow(r, hf)];
    __syncthreads();
#pragma unroll
    for (int i = 0; i < 2; ++i) { const int q = tid + 512 * i, j = q >> 4, c8 = q & 15;
        *(LAS u32x4*)(QtS + j * 136 + 8 * c8) = qx[i]; *(LAS u32x4*)(KtS + j * 136 + 8 * c8) = kx[i]; }
#pragma unroll
    for (int i = 0; i < 4; ++i) { const int q = tid + 512 * i, j = q >> 5, c8 = q & 31; *(LAS u32x4*)(VT + j * 264 + 8 * c8) = vx[i]; }
    __syncthreads();
    bf16x8 qB[2];
#pragma unroll
    for (int s = 0; s < 2; ++s) qB[s] = *(const LAS bf16x8*)(QtS + (32 * ih + l31) * 136 + h * 32 + 16 * s + 8 * hf);
    f32x16 aT[2];
#pragma unroll
    for (int jt = 0; jt < 2; ++jt) {
#pragma unroll
        for (int r = 0; r < 16; ++r) aT[jt][r] = 0.f;
        if (jt <= ih) {
#pragma unroll
            for (int s = 0; s < 2; ++s) { const bf16x8 a = *(const LAS bf16x8*)(KtS + (32 * jt + l31) * 136 + h * 32 + 16 * s + 8 * hf);
                aT[jt] = __builtin_amdgcn_mfma_f32_32x32x16_bf16(a, qB[s], aT[jt], 0, 0, 0); }
#pragma unroll
            for (int r = 0; r < 16; ++r) { const int j = 32 * jt + crow(r, hf), i = 32 * ih + l31; if (j > i) aT[jt][r] = 0.f; }
        }
    }
    f32x16 oT[2];
#pragma unroll
    for (int vt = 0; vt < 2; ++vt) {
#pragma unroll
        for (int r = 0; r < 16; ++r) oT[vt][r] = 0.f;
#pragma unroll
        for (int s = 0; s < 2; ++s) { u32x4 sw; sw.x = cvtpk_(sta[vt][s][0], sta[vt][s][1]); sw.y = cvtpk_(sta[vt][s][2], sta[vt][s][3]); sw.z = cvtpk_(sta[vt][s][4], sta[vt][s][5]); sw.w = cvtpk_(sta[vt][s][6], sta[vt][s][7]);
            oT[vt] = __builtin_amdgcn_mfma_f32_32x32x16_bf16(__builtin_bit_cast(bf16x8, sw), qB[s], oT[vt], 0, 0, 0); }
#pragma unroll
        for (int jt = 0; jt < 2; ++jt) {
            if (jt <= ih) {
#pragma unroll
                for (int s = 0; s < 2; ++s) {
                    u32x4 pw; pw.x = cvtpk_(aT[jt][8 * s + 0], aT[jt][8 * s + 1]); pw.y = cvtpk_(aT[jt][8 * s + 2], aT[jt][8 * s + 3]); pw.z = cvtpk_(aT[jt][8 * s + 4], aT[jt][8 * s + 5]); pw.w = cvtpk_(aT[jt][8 * s + 6], aT[jt][8 * s + 7]);
                    oT[vt] = __builtin_amdgcn_mfma_f32_32x32x16_bf16(frag_tr_perm(VT, 264, 32 * jt + 16 * s, h * 64 + 32 * vt, lane), __builtin_bit_cast(bf16x8, pw), oT[vt], 0, 0, 0); }
            }
        }
    }
    float ss = 0.f;
#pragma unroll
    for (int vt = 0; vt < 2; ++vt)
#pragma unroll
        for (int r = 0; r < 16; ++r) ss += oT[vt][r] * oT[vt][r];
    ss = xor32_sum(ss);
    const float rinv = __builtin_amdgcn_rsqf(ss * (1.0f / 64.0f) + EPS);
#pragma unroll
    for (int vt = 0; vt < 2; ++vt)
#pragma unroll
        for (int r = 0; r < 16; ++r) oS[(32 * ih + l31) * 260 + h * 64 + 32 * vt + crow(r, hf)] = (oT[vt][r] * rinv) * gn[vt][r];
    __syncthreads();
#pragma unroll
    for (int i = 0; i < 4; ++i) { const int q = tid + 512 * i, j = q >> 5, c8 = q & 31; float gg[8]; unpack8(gx[i], gg); float y[8];
        const f32x4 t0 = *(const LAS f32x4*)(oS + j * 260 + 8 * c8), t1 = *(const LAS f32x4*)(oS + j * 260 + 8 * c8 + 4); const float tv[8] = {t0.x, t0.y, t0.z, t0.w, t1.x, t1.y, t1.z, t1.w};
#pragma unroll
        for (int e = 0; e < 8; ++e) y[e] = tv[e] * siluf_(gg[e]);
        u32x4 o; o.x = pk2(y[0], y[1]); o.y = pk2(y[2], y[3]); o.z = pk2(y[4], y[5]); o.w = pk2(y[6], y[7]);
        *(u32x4*)(F.CC + (size_t)(m0 + j) * DM + 768 + 8 * c8) = o; }
}

constexpr int CV_U = 0;
constexpr int CV_A = 94 * 256 * 4;
static_assert(CV_A + 64 * 264 * 2 <= 140 * 1024, "conv LDS");
__device__ __forceinline__ void conv_item(const Frame& F, const LayerP& P, int it) {
    LAS float* uS = (LAS float*)F.lds; LAS bf16_t* aS = (LAS bf16_t*)(F.lds + CV_A);
    const int tid = F.tid, lane = F.lane, w = F.wave;
    const int b = it >> 7, t0 = (it & 127) * 64, m0 = it * 64;
    u32x4 ua[6], ug[6];
#pragma unroll
    for (int i = 0; i < 6; ++i) { const int q = tid + 512 * i, r = q >> 5, c8 = q & 31, tt = t0 - 30 + r;
        ua[i] = (u32x4){0u, 0u, 0u, 0u}; ug[i] = (u32x4){0u, 0u, 0u, 0u};
        if (q < 94 * 32 && tt >= 0) { const bf16_t* zr = F.Z + (size_t)(b * SEQ + tt) * NZP + 8 * c8; ua[i] = *(const u32x4*)(zr + C_CA); ug[i] = *(const u32x4*)(zr + C_CG); } }
    typedef float f32x2v __attribute__((ext_vector_type(2)));
    const int cp = tid & 127, tq = tid >> 7;

    __syncthreads();
#pragma unroll
    for (int i = 0; i < 6; ++i) { const int q = tid + 512 * i, r = q >> 5, c8 = q & 31;
        if (q < 94 * 32) { float xa[8], xg[8]; unpack8(ua[i], xa); unpack8(ug[i], xg);
#pragma unroll
            for (int e = 0; e < 8; ++e) xa[e] = xa[e] * sigmoidf_(xg[e]);
            *(LAS f32x4*)(uS + r * 256 + 8 * c8) = (f32x4){xa[0], xa[1], xa[2], xa[3]}; *(LAS f32x4*)(uS + r * 256 + 8 * c8 + 4) = (f32x4){xa[4], xa[5], xa[6], xa[7]}; } }
    __syncthreads();
    {
        f32x2v wk[31];
#pragma unroll
        for (int k = 0; k < 31; ++k) wk[k] = *(const f32x2v*)(P.conv_w + k * 256 + 2 * cp);
        const f32x2v cbias = *(const f32x2v*)(P.conv_b + 2 * cp);
#pragma nounroll
        for (int hh = 0; hh < 2; ++hh) { const int t0r = 16 * tq + 8 * hh;
            f32x2v u[38];
#pragma unroll
            for (int r = 0; r < 38; ++r) u[r] = *(const LAS f32x2v*)(uS + (t0r + r) * 256 + 2 * cp);
#pragma unroll
            for (int i = 0; i < 8; ++i) { f32x2v acc = wk[0] * u[i];
#pragma unroll
                for (int k = 1; k < 31; ++k) acc = __builtin_elementwise_fma(wk[k], u[i + k], acc);
                acc = acc + cbias;
                *(LAS unsigned*)(aS + (t0r + i) * 264 + 2 * cp) = pk2(acc.x, acc.y); } }
    }
    asm volatile("" ::: "memory"); __builtin_amdgcn_sched_barrier(0);
    const int n0 = 32 * w, fr = lane & 15, fq = lane >> 4;
    bf16x8 bfr[8][2];
#pragma unroll
    for (int ks = 0; ks < 8; ++ks)
#pragma unroll
        for (int nt = 0; nt < 2; ++nt) bfr[ks][nt] = *(const bf16x8*)(P.WpwT + (size_t)(n0 + 16 * nt + fr) * 256 + 32 * ks + 8 * fq);
    u32x4 gx[4];
#pragma unroll
    for (int i = 0; i < 4; ++i) { const int q = tid + 512 * i, j = q >> 5, c8 = q & 31; gx[i] = *(const u32x4*)(F.Z + (size_t)(m0 + j) * NZP + C_GC + 8 * c8); }
    float lg[4], lb[4];
#pragma unroll
    for (int j = 0; j < 4; ++j) { lg[j] = P.ln_g[lane + 64 * j]; lb[j] = P.ln_b[lane + 64 * j]; }
    __syncthreads();
#pragma unroll 2
    for (int i = 0; i < 8; ++i) { const int row = 8 * w + i;
        float x[4]; float s = 0.f;
#pragma unroll
        for (int j = 0; j < 4; ++j) { x[j] = bf2f(aS[row * 264 + lane + 64 * j]); s += x[j]; }
        const float mean = wave_sum(s) * (1.0f / 256.0f); float s2 = 0.f;
#pragma unroll
        for (int j = 0; j < 4; ++j) { x[j] -= mean; s2 += x[j] * x[j]; }
        const float rstd = __builtin_amdgcn_rsqf(wave_sum(s2) * (1.0f / 256.0f) + EPS);
#pragma unroll
        for (int j = 0; j < 4; ++j) { const float un = (x[j] * rstd) * lg[j] + lb[j];
            aS[row * 264 + lane + 64 * j] = (bf16_t)f2bf(siluf_(un)); } }
    __syncthreads();
    f32x4 acc[4][2];
#pragma unroll
    for (int m = 0; m < 4; ++m)
#pragma unroll
        for (int nt = 0; nt < 2; ++nt) acc[m][nt] = (f32x4){0.f, 0.f, 0.f, 0.f};
#pragma unroll
    for (int ks = 0; ks < 8; ++ks) {
#pragma unroll
        for (int m = 0; m < 4; ++m) { const bf16x8 af = *(const LAS bf16x8*)(aS + (16 * m + fr) * 264 + 32 * ks + 8 * fq);
#pragma unroll
            for (int nt = 0; nt < 2; ++nt) acc[m][nt] = __builtin_amdgcn_mfma_f32_16x16x32_bf16(af, bfr[ks][nt], acc[m][nt], 0, 0, 0); } }
#pragma unroll
    for (int m = 0; m < 4; ++m)
#pragma unroll
        for (int nt = 0; nt < 2; ++nt) { const int col = n0 + 16 * nt + fr; const float pb = P.pw_b[col];
#pragma unroll
            for (int r = 0; r < 4; ++r) uS[(16 * m + 4 * fq + r) * 260 + col] = acc[m][nt][r] + pb; }
    __syncthreads();
#pragma unroll
    for (int i = 0; i < 4; ++i) { const int q = tid + 512 * i, j = q >> 5, c8 = q & 31; float gg[8]; unpack8(gx[i], gg); float y[8];
        const f32x4 t0 = *(const LAS f32x4*)(uS + j * 260 + 8 * c8), t1 = *(const LAS f32x4*)(uS + j * 260 + 8 * c8 + 4); const float tv[8] = {t0.x, t0.y, t0.z, t0.w, t1.x, t1.y, t1.z, t1.w};
#pragma unroll
        for (int e = 0; e < 8; ++e) y[e] = tv[e] * siluf_(gg[e]);
        u32x4 o; o.x = pk2(y[0], y[1]); o.y = pk2(y[2], y[3]); o.z = pk2(y[4], y[5]); o.w = pk2(y[6], y[7]);
        *(u32x4*)(F.CC + (size_t)(m0 + j) * DM + 512 + 8 * c8) = o; }
}

typedef float f32x2_t __attribute__((ext_vector_type(2))); typedef __bf16 bf16x2_t __attribute__((ext_vector_type(2)));
__device__ __forceinline__ unsigned cvtpk(float lo, float hi) { f32x2_t v = {lo, hi}; bf16x2_t b = __builtin_convertvector(v, bf16x2_t); return __builtin_bit_cast(unsigned, b); }

struct AttnState { float m, l; f32x16 oT[2]; };
__device__ __forceinline__ void attn_init(AttnState& st) {
    st.m = -INFINITY; st.l = 0.f;
#pragma unroll
    for (int d0 = 0; d0 < 2; ++d0)
#pragma unroll
        for (int r = 0; r < 16; ++r) st.oT[d0][r] = 0.f;
}
__device__ __forceinline__ bf16x8 v_frag_tr(const LAS bf16_t* Vs, int kb, int d0, int lane) {
    const int hf = lane >> 5, i = lane & 15;
    const LAS bf16_t* a = Vs + (kb + 4 * hf + (i >> 2)) * 72 + 32 * d0 + 16 * ((lane >> 4) & 1) + 4 * (i & 3);
    const v4i16_t lo = __builtin_amdgcn_ds_read_tr16_b64_v4i16((LAS v4i16_t*)a);
    const v4i16_t hi = __builtin_amdgcn_ds_read_tr16_b64_v4i16((LAS v4i16_t*)(a + 8 * 72));
    return (bf16x8){lo[0], lo[1], lo[2], lo[3], hi[0], hi[1], hi[2], hi[3]};
}
__device__ __forceinline__ f32x16 attn_qk(const LAS bf16_t* Ks, int krow0, const bf16x8 (&qf)[4], const f32x16& cb, int l31, int hf) {
    f32x16 p = cb;
    bf16x8 a[4];
#pragma unroll
    for (int d0 = 0; d0 < 4; ++d0) a[d0] = *(const LAS bf16x8*)(Ks + (krow0 + l31) * 72 + 16 * d0 + 8 * hf);
    __builtin_amdgcn_s_setprio(1);
#pragma unroll
    for (int d0 = 0; d0 < 4; ++d0) p = __builtin_amdgcn_mfma_f32_32x32x16_bf16(a[d0], qf[d0], p, 0, 0, 0);
    __builtin_amdgcn_s_setprio(0);
    return p;
}
__device__ __forceinline__ float xhalf_max(float v) { const auto rr = __builtin_amdgcn_permlane32_swap(__float_as_uint(v), __float_as_uint(v), false, false); return fmaxf(__uint_as_float(rr[0]), __uint_as_float(rr[1])); }
__device__ __forceinline__ float xhalf_sum(float v) { const auto rr = __builtin_amdgcn_permlane32_swap(__float_as_uint(v), __float_as_uint(v), false, false); return __uint_as_float(rr[0]) + __uint_as_float(rr[1]); }
__device__ __forceinline__ void attn_softmax_pv(AttnState& st, f32x16 p, const LAS bf16_t* Vt, int vpitch, int kcol0, float coff, bool MASKED, int lo, int hi, int l31, int hf) {
    if (MASKED) {
#pragma unroll
        for (int r = 0; r < 16; ++r) { const int c = crow(r, hf); if (c < lo || c > hi) p[r] = -INFINITY; }
    }
    float mx = fmaxf(fmaxf(p[0], p[1]), p[2]);
#pragma unroll
    for (int r = 3; r < 15; r += 2) mx = fmaxf(fmaxf(mx, p[r]), p[r + 1]);
    mx = fmaxf(mx, p[15]);
    mx += coff;
    mx = xhalf_max(mx);
    if (__any(mx > st.m)) {
        const float mnew = fmaxf(st.m, mx);
        const float alpha = ex2(st.m - mnew);
        st.l *= alpha; st.m = mnew;
#pragma unroll
        for (int d0 = 0; d0 < 2; ++d0)
#pragma unroll
            for (int r = 0; r < 16; ++r) st.oT[d0][r] *= alpha;
    }
    const float c = coff - st.m;
    float ls = 0.f;
#pragma unroll
    for (int r = 0; r < 16; ++r) { p[r] = ex2(p[r] + c); ls += p[r]; }
    st.l += ls;
#pragma unroll
    for (int s = 0; s < 2; ++s) {
        u32x4 pw; pw.x = cvtpk(p[8 * s + 0], p[8 * s + 1]); pw.y = cvtpk(p[8 * s + 2], p[8 * s + 3]); pw.z = cvtpk(p[8 * s + 4], p[8 * s + 5]); pw.w = cvtpk(p[8 * s + 6], p[8 * s + 7]);
        const bf16x8 pb = __builtin_bit_cast(bf16x8, pw);
#pragma unroll
        for (int d0 = 0; d0 < 2; ++d0) {
            st.oT[d0] = __builtin_amdgcn_mfma_f32_32x32x16_bf16(v_frag_tr(Vt, kcol0 + 16 * s, d0, 32 * hf + l31), pb, st.oT[d0], 0, 0, 0); }
    }
}
struct TileP { int kk0; float coff; bool masked; int lo, hi; };
__device__ __forceinline__ void attn_pair(AttnState& st, const LAS bf16_t* Ks, const LAS bf16_t* Vt, int vpitch, const bf16x8 (&qf)[4], const f32x16& cb, const TileP A, const TileP B, int l31, int hf) {
    f32x16 pA = attn_qk(Ks, A.kk0, qf, cb, l31, hf);
    f32x16 pB = attn_qk(Ks, B.kk0, qf, cb, l31, hf);
    if (A.masked) {
#pragma unroll
        for (int r = 0; r < 16; ++r) { const int c = crow(r, hf); if (c < A.lo || c > A.hi) pA[r] = -INFINITY; }
    }
    if (B.masked) {
#pragma unroll
        for (int r = 0; r < 16; ++r) { const int c = crow(r, hf); if (c < B.lo || c > B.hi) pB[r] = -INFINITY; }
    }
    float ma = fmaxf(fmaxf(pA[0], pA[1]), pA[2]), mb = fmaxf(fmaxf(pB[0], pB[1]), pB[2]);
#pragma unroll
    for (int r = 3; r < 15; r += 2) { ma = fmaxf(fmaxf(ma, pA[r]), pA[r + 1]); mb = fmaxf(fmaxf(mb, pB[r]), pB[r + 1]); }
    ma = fmaxf(ma, pA[15]) + A.coff; mb = fmaxf(mb, pB[15]) + B.coff;
    const float mx = xhalf_max(fmaxf(ma, mb));
    if (__any(mx > st.m)) {
        const float mnew = fmaxf(st.m, mx);
        const float alpha = ex2(st.m - mnew);
        st.l *= alpha; st.m = mnew;
#pragma unroll
        for (int d0 = 0; d0 < 2; ++d0)
#pragma unroll
            for (int r = 0; r < 16; ++r) st.oT[d0][r] *= alpha;
    }
    const float ca = A.coff - st.m, cbb = B.coff - st.m;
    float ls = 0.f;
#pragma unroll
    for (int r = 0; r < 16; ++r) { pA[r] = ex2(pA[r] + ca); ls += pA[r]; }
#pragma unroll
    for (int s = 0; s < 2; ++s) {
        u32x4 pw; pw.x = cvtpk(pA[8 * s + 0], pA[8 * s + 1]); pw.y = cvtpk(pA[8 * s + 2], pA[8 * s + 3]); pw.z = cvtpk(pA[8 * s + 4], pA[8 * s + 5]); pw.w = cvtpk(pA[8 * s + 6], pA[8 * s + 7]);
        const bf16x8 pb = __builtin_bit_cast(bf16x8, pw);
#pragma unroll
        for (int d0 = 0; d0 < 2; ++d0) {
            st.oT[d0] = __builtin_amdgcn_mfma_f32_32x32x16_bf16(v_frag_tr(Vt, A.kk0 + 16 * s, d0, 32 * hf + l31), pb, st.oT[d0], 0, 0, 0); }
    }
#pragma unroll
    for (int r = 0; r < 16; ++r) { pB[r] = ex2(pB[r] + cbb); ls += pB[r]; }
    st.l += ls;
#pragma unroll
    for (int s = 0; s < 2; ++s) {
        u32x4 pw; pw.x = cvtpk(pB[8 * s + 0], pB[8 * s + 1]); pw.y = cvtpk(pB[8 * s + 2], pB[8 * s + 3]); pw.z = cvtpk(pB[8 * s + 4], pB[8 * s + 5]); pw.w = cvtpk(pB[8 * s + 6], pB[8 * s + 7]);
        const bf16x8 pb = __builtin_bit_cast(bf16x8, pw);
#pragma unroll
        for (int d0 = 0; d0 < 2; ++d0) {
            st.oT[d0] = __builtin_amdgcn_mfma_f32_32x32x16_bf16(v_frag_tr(Vt, B.kk0 + 16 * s, d0, 32 * hf + l31), pb, st.oT[d0], 0, 0, 0); }
    }
}
__device__ __forceinline__ void attn_store_row(const AttnState& st, float scale, bf16_t* dst, int hf) {
#pragma unroll
    for (int d0 = 0; d0 < 2; ++d0)
#pragma unroll
        for (int g = 0; g < 4; ++g) { u32x2 w; w.x = pk2(st.oT[d0][4 * g] * scale, st.oT[d0][4 * g + 1] * scale); w.y = pk2(st.oT[d0][4 * g + 2] * scale, st.oT[d0][4 * g + 3] * scale);
            *(u32x2*)(dst + 32 * d0 + 8 * g + 4 * hf) = w; }
}

constexpr int MB_KS = 0;
constexpr int MB_VT = 256 * 72 * 2;
constexpr int MB_KM = MB_VT + 64 * 260 * 2;
constexpr int MB_VP = 260;
constexpr int DL_KS = 0;
constexpr int DL_VT = 384 * 72 * 2;
constexpr int DL_VP = 388;
constexpr int AT_PREF = 120 * 1024;
static_assert(DL_VT + 64 * 388 * 2 <= AT_PREF && MB_KM + 32 * 64 * 4 <= AT_PREF, "attention LDS");
constexpr int LIST_CAP = 8192;

__device__ __forceinline__ void moba_topk_unit(const Frame& F, const LayerP& P, int b, int h, int qb, unsigned* cnt  , unsigned* list  ) {
    LAS float* kmS = (LAS float*)(F.lds + MB_KM);
    const int tid = F.tid, lane = F.lane, w = F.wave, l31 = lane & 31, hf = lane >> 5, bh = b * 4 + h;
    __syncthreads();
    for (int q = tid; q < qb * 64; q += 512) { const int n = q >> 6, d = q & 63;
        kmS[q] = __hip_atomic_load(F.KMP + ((size_t)(b * 32 + n)) * 256 + h * 64 + d, __ATOMIC_RELAXED, __HIP_MEMORY_SCOPE_AGENT) * (1.0f / 256.0f); }
    const int qpos = qb * 256 + 32 * w + l31;
    const size_t grow = (size_t)b * SEQ + qpos;
    float qv[32];
#pragma unroll
    for (int d0 = 0; d0 < 4; ++d0) { const u32x4 a = *(const u32x4*)(F.Z + grow * NZP + C_QA + h * 64 + 16 * d0 + 8 * hf);
#pragma unroll
        for (int k = 0; k < 4; ++k) { qv[d0 * 8 + 2 * k] = bf2f(a[k] & 0xffffu); qv[d0 * 8 + 2 * k + 1] = bf2f(a[k] >> 16); } }
    __syncthreads();
    float v0 = -INFINITY, v1 = -INFINITY, v2 = -INFINITY; int i0 = -1, i1 = -1, i2 = -1;
    for (int n = 0; n < qb; ++n) { float g = 0.f;
#pragma unroll
        for (int d0 = 0; d0 < 4; ++d0) { const f32x4 k0 = *(const LAS f32x4*)(kmS + n * 64 + 16 * d0 + 8 * hf), k1 = *(const LAS f32x4*)(kmS + n * 64 + 16 * d0 + 8 * hf + 4);
            g += qv[d0 * 8 + 0] * k0.x + qv[d0 * 8 + 1] * k0.y + qv[d0 * 8 + 2] * k0.z + qv[d0 * 8 + 3] * k0.w + qv[d0 * 8 + 4] * k1.x + qv[d0 * 8 + 5] * k1.y + qv[d0 * 8 + 6] * k1.z + qv[d0 * 8 + 7] * k1.w; }
        g = xor32_sum(g);
        if (g > v0) { v2 = v1; i2 = i1; v1 = v0; i1 = i0; v0 = g; i0 = n; }
        else if (g > v1) { v2 = v1; i2 = i1; v1 = g; i1 = n; }
        else if (g > v2) { v2 = g; i2 = n; } }
    float gq = fabsf(P.qga[lane]), gk = fabsf(P.kga[lane]);
    gq = wave64_max(gq); gk = wave64_max(gk);
    const float B2 = 2.04f * 64.0f * gq * gk * QSCALE, slope2 = exp2f(-(float)(2 * h + 1)) * LOG2E;
    const bool z0 = i0 >= 0 && (B2 - slope2 * (float)(qpos - 256 * i0 - 255)) < -152.0f;
    const bool z1 = i1 >= 0 && (B2 - slope2 * (float)(qpos - 256 * i1 - 255)) < -152.0f;
    const bool z2 = i2 >= 0 && (B2 - slope2 * (float)(qpos - 256 * i2 - 255)) < -152.0f;
    if (z0) i0 = -1;
    if (z1) i1 = -1;
    if (z2) i2 = -1;
    unsigned mymask = 0u;
    for (int n = 0; n < qb; ++n) {
        const unsigned long long mask = __ballot(hf == 0 && (n == i0 || n == i1 || n == i2));
        if (lane == n) mymask = (unsigned)mask;
    }
    unsigned mybase = 0u;
    if (mymask != 0u) mybase = atomicAdd(cnt + bh * 32 + lane, (unsigned)__popc(mymask));
    {
        const unsigned below = (1u << l31) - 1u;
        const int sel[3] = {i0, i1, i2};
#pragma unroll
        for (int k = 0; k < 3; ++k) {
            const int n = sel[k] < 0 ? 0 : sel[k];
            const unsigned mk = (unsigned)__shfl((int)mymask, n), bs = (unsigned)__shfl((int)mybase, n);
            if (hf == 0 && sel[k] >= 0) { const int pos = (int)bs + __popc(mk & below);
                if (pos < LIST_CAP) list[((size_t)bh * 32 + n) * LIST_CAP + pos] = ((unsigned)qpos << 2) | (unsigned)k; }
        }
    }
    if (hf == 0) { float* ps = F.PS + grow * (NZP / 2) + h * 8;
        float ninf = -1e30f, zer = 0.f; asm volatile("" : "+v"(ninf), "+v"(zer));
        if (i0 < 0) { ps[0] = ninf; ps[1] = zer; }
        if (i1 < 0) { ps[2] = ninf; ps[3] = zer; }
        if (i2 < 0) { ps[4] = ninf; ps[5] = zer; } }
}

constexpr int AT_KS = 0, AT_VT = 384 * 72 * 2, AT_VP = 72;
struct AttDesc {
    int kind;
    int b, h, n, tile, cnt, pr;
    int pat, dil, g, u;
    int nrows, first_valid; long long row0, rstride;
    int kcol, vcol;
};
__device__ __forceinline__ AttDesc att_decode(int j, int total, const LAS int* pref, const unsigned* cnt) {
    AttDesc D; D.kind = 0; D.b = 0; D.h = 0; D.n = 0; D.tile = 0; D.cnt = 0; D.pr = 0; D.pat = 0; D.dil = 1; D.g = 0; D.u = 0;
    if (j < total + 256) {
        int pr, tile;
        if (j < total) { int lo = 0, hi = 255;
            while (lo < hi) { const int mid = (lo + hi + 1) >> 1; if (pref[mid] <= j) lo = mid; else hi = mid - 1; }
            pr = lo; tile = j - pref[pr] + 1; D.kind = 0;
        } else { const int u = j - total; pr = (u & 7) * 32 + (u >> 3); tile = 0; D.kind = 1; }
        D.cnt = pref[272 + pr];
        D.pr = pr; D.tile = tile; D.b = pr >> 7; D.h = (pr >> 5) & 3; D.n = pr & 31;
        D.nrows = 256; D.first_valid = 0; D.row0 = (long long)D.b * SEQ + D.n * 256; D.rstride = 1; D.kcol = C_KA + D.h * 64; D.vcol = C_VA + D.h * 64;
    } else {
        const int q = j - total - 256; D.kind = 2; D.pat = q >> 8; const int r = q & 255; D.b = (r >> 2) & 1; D.h = r & 3; const int uidx = r >> 3;
        D.dil = (D.pat == 0) ? 1 : (D.pat == 1 ? 4 : 16);
        const int upg = 32 / D.dil; D.g = uidx / upg; D.u = uidx % upg;
        const int i0 = 256 * D.u - 128;
        D.nrows = 384; D.first_valid = (i0 < 0) ? 128 : 0; D.row0 = (long long)D.b * SEQ + (long long)i0 * D.dil + D.g; D.rstride = D.dil; D.kcol = C_KB + D.h * 64; D.vcol = C_VB + D.h * 64;
    }
    return D;
}
struct StageRegs { u32x4 kx[2][2], vx[2][2]; };
__device__ __forceinline__ void att_stage_issue(StageRegs& R, int tid, const bf16_t* Z, const AttDesc& D) {
#pragma unroll
    for (int i = 0; i < 2; ++i) { const int q = tid + 512 * i, r = (q >> 3) * 2, c8 = q & 7;
#pragma unroll
        for (int e = 0; e < 2; ++e) { R.kx[i][e] = (u32x4){0u, 0u, 0u, 0u}; R.vx[i][e] = (u32x4){0u, 0u, 0u, 0u};
            if (r + e >= D.first_valid) { const bf16_t* zr = Z + (size_t)(D.row0 + (long long)(r + e) * D.rstride) * NZP + 8 * c8;
                R.kx[i][e] = *(const u32x4*)(zr + D.kcol); R.vx[i][e] = *(const u32x4*)(zr + D.vcol); } } }
}
__device__ __forceinline__ void att_stage_put(const u32x4 (&kx)[2], const u32x4 (&vx)[2], int r, int c8, LAS bf16_t* Ks, LAS bf16_t* Vt) {
    *(LAS u32x4*)(Ks + r * 72 + 8 * c8) = kx[0]; *(LAS u32x4*)(Ks + (r + 1) * 72 + 8 * c8) = kx[1];
    *(LAS u32x4*)(Vt + r * 72 + 8 * c8) = vx[0]; *(LAS u32x4*)(Vt + (r + 1) * 72 + 8 * c8) = vx[1];
}
struct StageTail { u32x4 k3[2], v3[2]; };
__device__ __forceinline__ void att_stage_tail_issue(StageTail& T3, int tid, const bf16_t* Z, const AttDesc& D) {
    const int q3 = tid + 1024, r3 = (q3 >> 3) * 2, c83 = q3 & 7;
#pragma unroll
    for (int e = 0; e < 2; ++e) { T3.k3[e] = (u32x4){0u, 0u, 0u, 0u}; T3.v3[e] = (u32x4){0u, 0u, 0u, 0u};
        if (D.nrows > 256) { const bf16_t* zr = Z + (size_t)(D.row0 + (long long)(r3 + e) * D.rstride) * NZP + 8 * c83; T3.k3[e] = *(const u32x4*)(zr + D.kcol); T3.v3[e] = *(const u32x4*)(zr + D.vcol); } }
}
__device__ __forceinline__ void att_stage_write(const StageRegs& R, const StageTail& T3, int tid, const AttDesc& D, LAS bf16_t* Ks, LAS bf16_t* Vt) {
#pragma unroll
    for (int i = 0; i < 2; ++i) { const int q = tid + 512 * i, r = (q >> 3) * 2, c8 = q & 7; att_stage_put(R.kx[i], R.vx[i], r, c8, Ks, Vt); }
    if (D.nrows > 256) { const int q3 = tid + 1024, r3 = (q3 >> 3) * 2, c83 = q3 & 7; att_stage_put(T3.k3, T3.v3, r3, c83, Ks, Vt); }
}
__device__ __forceinline__ unsigned att_entry_issue(const AttDesc& D, const unsigned* LIST, int w, int l31) {
    if (D.kind == 2) return 0u;
    const int idx0 = D.tile * 256 + 32 * w;
    if (idx0 >= D.cnt) return 0u;
    const int idx = idx0 + l31;
    return LIST[(size_t)D.pr * LIST_CAP + (idx < D.cnt ? idx : idx0)];
}
__device__ __forceinline__ void att_compute(const Frame& F, const AttDesc& D, const int mode  , unsigned entry, const bf16x8 (&qf)[4], size_t grow, int qpos) {
    const LAS bf16_t* Ks = (const LAS bf16_t*)(F.lds + AT_KS); const LAS bf16_t* Vt = (const LAS bf16_t*)(F.lds + AT_VT);
    const int lane = F.lane, w = F.wave, l31 = lane & 31, hf = lane >> 5;
    const bool dilk = mode == 2, own = mode == 1;
    const int idx0 = D.tile * 256 + 32 * w;
    if (mode == 0 && idx0 >= D.cnt) return;
    const float slope2 = dilk ? exp2f(-(float)(2 * D.h + 2)) * LOG2E * (float)D.dil : exp2f(-(float)(2 * D.h + 1)) * LOG2E;
    f32x16 cb;
#pragma unroll
    for (int r = 0; r < 16; ++r) cb[r] = slope2 * (float)crow(r, hf);
    const int i0 = 256 * D.u - 128;
    AttnState st; attn_init(st);
    int jmin = 0; if (dilk) { jmin = (-i0 - 32 * w + 31) >> 5; jmin = jmin < 0 ? 0 : jmin; }
    const int ntile = dilk ? (5 - jmin) : (own ? (w + 1) : 8);
    auto tile_params = [&](int s) -> TileP { TileP T;
        if (dilk) { const int j = 4 - s; T.kk0 = 32 * w + 32 * j; T.coff = -slope2 * (float)(l31 + 128 - 32 * j); T.masked = (j == 4 || j == 0); T.lo = l31 - 32 * j; T.hi = l31 + 128 - 32 * j; }
        else { T.kk0 = 32 * s; T.coff = slope2 * (float)(D.n * 256 + 32 * s - qpos); T.masked = own && (s == w); T.lo = -1; T.hi = l31; }
        return T; };
    int s = 0;
#pragma nounroll
    for (; s + 1 < ntile; s += 2) attn_pair(st, Ks, Vt, AT_VP, qf, cb, tile_params(s), tile_params(s + 1), l31, hf);
    if (s < ntile) { const TileP T = tile_params(s);
        const f32x16 pc = attn_qk(Ks, T.kk0, qf, cb, l31, hf);
        attn_softmax_pv(st, pc, Vt, AT_VP, T.kk0, T.coff, T.masked, T.lo, T.hi, l31, hf); }
    const float ltot = xhalf_sum(st.l);
    if (dilk) {
        attn_store_row(st, __builtin_amdgcn_rcpf(ltot), F.DOp + grow * NZP + D.pat * 256 + D.h * 64, hf);
        if (hf == 0) { float* sp = F.DST + (((size_t)D.pat * MTOK + grow) * 4 + D.h) * 2; sp[0] = st.m; sp[1] = ltot; }
    } else {
        const bool valid = own || (idx0 + l31 < D.cnt);
        const int slot = own ? 3 : (int)(entry & 3u);
        if (valid) {
            attn_store_row(st, __builtin_amdgcn_rcpf(ltot), F.PO + (((size_t)slot * MTOK + grow) * 4 + D.h) * 64, hf);
            if (hf == 0) { float* ps = F.PS + grow * (NZP / 2) + D.h * 8 + slot * 2; ps[0] = st.m; ps[1] = ltot; } }
    }
}
__device__ __forceinline__ void att_phase(const Frame& F, const unsigned* cnt, unsigned* dctr  ) {
    LAS int* pref = (LAS int*)(F.lds + AT_PREF);
    LAS bf16_t* Ks = (LAS bf16_t*)(F.lds + AT_KS); LAS bf16_t* Vt = (LAS bf16_t*)(F.lds + AT_VT);
    const int lane = F.lane, w = F.wave, l31 = lane & 31, hf = lane >> 5;
    LAS int* dq = pref + 530;
    __syncthreads();
    if (F.tid == 0) dq[0] = (int)atomicAdd(dctr, 1u);
    {
        int T = 0;
        if (F.tid < 256) { int c = (int)__hip_atomic_load(cnt + F.tid, __ATOMIC_RELAXED, __HIP_MEMORY_SCOPE_AGENT); c = c > LIST_CAP ? LIST_CAP : c; pref[272 + F.tid] = c; T = ((c + 255) >> 8) - 1; T = T < 0 ? 0 : T; }
        int x = T;
#pragma unroll
        for (int o = 1; o < 64; o <<= 1) { const int y = __shfl_up(x, o); if (lane >= o) x += y; }
        if (lane == 63) pref[264 + w] = x;
        __syncthreads();
        int off = 0;
        for (int ww = 0; ww < w; ++ww) off += pref[264 + ww];
        if (F.tid < 256) pref[F.tid] = x + off - T;
        if (F.tid == 255) pref[256] = x + off;
        __syncthreads();
    }
    const int total = pref[256], NS = total + 256;
    const int vcu = (F.G % 8 == 0) ? (F.bid % 8) * (F.G / 8) + F.bid / 8 : F.bid;
    int j = vcu, nd = 0; bool isdyn = false;
    if (j >= NS) { const int d = dq[0]; nd = 1; isdyn = true; if (d >= 768) return; j = NS + d; if (F.tid == 0) dq[1] = (int)atomicAdd(dctr, 1u); }
    AttDesc D = att_decode(j, total, pref, cnt);
    StageRegs R; att_stage_issue(R, F.tid, F.Z, D);
    unsigned entry = att_entry_issue(D, F.LIST, w, l31);
    for (;;) {
        int qpos; size_t grow; int qcol;
        if (D.kind == 2) { const int iq = 256 * D.u + 32 * w + l31; qpos = iq; grow = (size_t)D.b * SEQ + (size_t)iq * D.dil + D.g; qcol = C_QB + D.h * 64; }
        else { qpos = (D.kind == 1) ? (D.n * 256 + 32 * w + l31) : (int)(entry >> 2); grow = (size_t)D.b * SEQ + qpos; qcol = C_QA + D.h * 64; }
        bf16x8 qf[4];
#pragma unroll
        for (int d0 = 0; d0 < 4; ++d0) qf[d0] = *(const bf16x8*)(F.Z + grow * NZP + qcol + 16 * d0 + 8 * hf);
        const bool two = (D.kind == 1) && (D.cnt > 0);
        const int qpos2 = (int)(entry >> 2); const size_t grow2 = (size_t)D.b * SEQ + qpos2;
        StageTail T3; att_stage_tail_issue(T3, F.tid, F.Z, D);
        __syncthreads();
        att_stage_write(R, T3, F.tid, D, Ks, Vt);
        __syncthreads();
        int jn; bool have_n; int fd = 0; bool fetched = false;
        if (!isdyn && j + F.G < NS) { jn = j + F.G; have_n = true; }
        else { const int d = dq[nd & 1]; ++nd; isdyn = true; have_n = d < 768; jn = NS + d;
            if (have_n) { fetched = true; if (F.tid == 0) fd = (int)atomicAdd(dctr, 1u); } }
        AttDesc Dn = D; unsigned entry_n = 0u;
        if (have_n) { Dn = att_decode(jn, total, pref, cnt); att_stage_issue(R, F.tid, F.Z, Dn); entry_n = att_entry_issue(Dn, F.LIST, w, l31); }
        const int npass = two ? 2 : 1;
#pragma nounroll
        for (int pass = 0; pass < npass; ++pass) {
            const int mode = (pass == 1) ? 0 : D.kind;
            att_compute(F, D, mode, entry, qf, pass ? grow2 : grow, pass ? qpos2 : qpos);
            if (pass + 1 < npass) {
#pragma unroll
                for (int d0 = 0; d0 < 4; ++d0) qf[d0] = *(const bf16x8*)(F.Z + grow2 * NZP + qcol + 16 * d0 + 8 * hf); }
        }
        if (fetched && F.tid == 0) dq[nd & 1] = fd;
        if (!have_n) break;
        D = Dn; entry = entry_n; j = jn;
    }
    __syncthreads();
}

template <int NP, int NB>
__device__ __forceinline__ void combine_items(const Frame& F, int item0, int istride, int nitems, const bf16_t* PO, size_t o_row, size_t o_head, size_t o_part, const float* PS, size_t s_row, size_t s_head, size_t s_part, int zgate_col, int cc_col) {
    float m[NB][NP], l[NB][NP]; u32x4 ox[NB][NP], gz[NB];
#pragma unroll
    for (int k = 0; k < NB; ++k) { const int item = item0 + k * istride; const int idx = (item < nitems ? item : item0) * 512 + F.tid; const size_t row = (size_t)(idx >> 5); const int h = (idx >> 3) & 3, c8 = idx & 7;
#pragma unroll
        for (int pp = 0; pp < NP; ++pp) { const float* sp = PS + row * s_row + h * s_head + pp * s_part; m[k][pp] = sp[0]; l[k][pp] = sp[1]; }
        gz[k] = *(const u32x4*)(F.Z + row * NZP + zgate_col + h * 64 + 8 * c8); }
#pragma unroll
    for (int k = 0; k < NB; ++k) { const int item = item0 + k * istride; const int idx = (item < nitems ? item : item0) * 512 + F.tid; const size_t row = (size_t)(idx >> 5); const int h = (idx >> 3) & 3, c8 = idx & 7;
#pragma unroll
        for (int pp = 0; pp < NP; ++pp) { ox[k][pp] = (u32x4){0u, 0u, 0u, 0u};
            if (l[k][pp] > 0.f) ox[k][pp] = __builtin_nontemporal_load((const u32x4*)(PO + row * o_row + h * o_head + pp * o_part + 8 * c8)); } }
#pragma unroll
    for (int k = 0; k < NB; ++k) { const int item = item0 + k * istride; if (item >= nitems) continue;
        const int idx = item * 512 + F.tid; const size_t row = (size_t)(idx >> 5); const int h = (idx >> 3) & 3, c8 = idx & 7;
        float mm = m[k][0];
#pragma unroll
        for (int pp = 1; pp < NP; ++pp) mm = fmaxf(mm, m[k][pp]);
        float wsum = 0.f; float o[8];
#pragma unroll
        for (int e = 0; e < 8; ++e) o[e] = 0.f;
#pragma unroll
        for (int pp = 0; pp < NP; ++pp) { const float wgt = (l[k][pp] > 0.f) ? l[k][pp] * ex2(m[k][pp] - mm) : 0.f; wsum += wgt;
            float x[8]; unpack8(ox[k][pp], x);
#pragma unroll
            for (int e = 0; e < 8; ++e) o[e] += wgt * x[e]; }
        const float rw = __builtin_amdgcn_rcpf(wsum);
        float gx[8]; unpack8(gz[k], gx);
        float y[8];
#pragma unroll
        for (int e = 0; e < 8; ++e) y[e] = o[e] * rw * siluf_(gx[e]);
        u32x4 ov; ov.x = pk2(y[0], y[1]); ov.y = pk2(y[2], y[3]); ov.z = pk2(y[4], y[5]); ov.w = pk2(y[6], y[7]);
        *(u32x4*)(F.CC + row * DM + cc_col + h * 64 + 8 * c8) = ov; }
}

__device__ __forceinline__ void gla_scan_item2(const Frame& F, int sc, const int rep = 0) {
    LAS float* S = (LAS float*)F.lds;
    const int lane = F.lane, w = F.wave;
    const int gidx = sc * 64 + lane, b = gidx >> 13, rem = gidx & 8191, hd = rem >> 6;
    float* kv = F.KV + ((size_t)b * 128 + 16 * w) * 8192 + rem; const float* bl = F.BL + ((size_t)b * 128 + 16 * w) * 128 + hd;
    float kvv[16], dec[16];
#pragma unroll
    for (int u = 0; u < 16; ++u) { kvv[u] = kv[(size_t)u * 8192]; dec[u] = bl[u * 128]; }
    float A = 1.f, Sx = 0.f;
#pragma unroll
    for (int u = 0; u < 16; ++u) { dec[u] = __expf(dec[u]); Sx = dec[u] * Sx + kvv[u]; A *= dec[u]; }
    __syncthreads();
    S[(w * 2 + 0) * 64 + lane] = A; S[(w * 2 + 1) * 64 + lane] = Sx;
    __syncthreads();
    float X = 0.f;
    for (int ww = 0; ww < w; ++ww) X = S[(ww * 2) * 64 + lane] * X + S[(ww * 2 + 1) * 64 + lane];
#pragma unroll
    for (int u = 0; u < 16; ++u) { if (!rep) kv[(size_t)u * 8192] = X; X = dec[u] * X + kvv[u]; }
    if (rep) asm volatile("" :: "v"(X));
    __syncthreads();
}

#define XB_TMO      128
#define XB_XCNT(j)  (256  + 64 * (j))
#define XB_XSUB(j)  (1280 + 64 * (j))
#define XB_XGEN(j)  (2304 + 64 * (j))
#define XB_TOP      3328
#define XB_TOPGEN   3392
#define XCD_BAR_WORDS 3456
#define XB_SPIN_CAP (1u << 18)

__device__ __forceinline__ unsigned xb_ld(unsigned* p)              { return __hip_atomic_load(p, __ATOMIC_RELAXED, __HIP_MEMORY_SCOPE_AGENT); }
__device__ __forceinline__ unsigned xb_add(unsigned* p, unsigned v) { return __hip_atomic_fetch_add(p, v, __ATOMIC_RELAXED, __HIP_MEMORY_SCOPE_AGENT); }
__device__ __forceinline__ unsigned xb_xcc_id() { return (unsigned)__builtin_amdgcn_s_getreg((3 << 11) | 20) & 0xFu; }
#define XB_SPIN(cond, bar) do { unsigned _sp = 0; while (cond) { __builtin_amdgcn_s_sleep(1); \
    if ((++_sp & 255u) == 0u) { if (xb_ld(&(bar)[XB_TMO])) break; if (_sp > XB_SPIN_CAP) { atomicAdd(&(bar)[XB_TMO], 1u); break; } } } } while (0)

struct XcdBarrier {
    unsigned* bar; unsigned x;
    volatile LAS unsigned* st;
};

__device__ __forceinline__ XcdBarrier xcd_barrier_post(unsigned* bar, volatile LAS unsigned* st) {
    XcdBarrier b; b.bar = bar; b.x = xb_xcc_id(); b.st = st;
    if (threadIdx.x == 0) (void)xb_add(&bar[XB_XCNT(b.x)], 1u);
    return b;
}
__device__ __forceinline__ void xcd_barrier_complete(unsigned* bar, unsigned x, unsigned& nloc, unsigned& nx) {
    const unsigned G = gridDim.x * gridDim.y * gridDim.z;
    unsigned sum, cnt, mine, sp = 0u;
    for (;;) {
        sum = 0u; cnt = 0u; mine = 0u;
#pragma unroll
        for (unsigned j = 0; j < 16; ++j) { const unsigned c = xb_ld(&bar[XB_XCNT(j)]); sum += c; cnt += (c > 0u) ? 1u : 0u; mine = (j == x) ? c : mine; }
        if (sum == G) break;
        __builtin_amdgcn_s_sleep(1);
        if ((++sp & 255u) == 0u) { if (xb_ld(&bar[XB_TMO])) break; if (sp > XB_SPIN_CAP) { atomicAdd(&bar[XB_TMO], 1u); break; } }
    }
    nloc = mine > 0u ? mine : 1u; nx = cnt > 0u ? cnt : 1u;
}

__device__ __forceinline__ void xcd_barrier(const XcdBarrier& b) {
    asm volatile("s_waitcnt vmcnt(0)" ::: "memory");
    __syncthreads();
    if (threadIdx.x == 0) {
        unsigned* bar = b.bar;
        __builtin_amdgcn_s_waitcnt(0);
        unsigned nloc = b.st[0], nx = b.st[1];
        if (nloc == 0u) { xcd_barrier_complete(bar, b.x, nloc, nx); b.st[0] = nloc; b.st[1] = nx; }
        const unsigned old = xb_add(&bar[XB_XSUB(b.x)], 1u);
        const unsigned gen = old / nloc;
        if (old + 1u == (gen + 1u) * nloc) {
            __builtin_amdgcn_fence(__ATOMIC_RELEASE, "agent");
            asm volatile("s_waitcnt vmcnt(0)" ::: "memory");
            const unsigned og = xb_add(&bar[XB_TOP], 1u);
            const unsigned tg = og / nx;
            if (og + 1u == (tg + 1u) * nx) xb_add(&bar[XB_TOPGEN], 1u);
            else XB_SPIN(xb_ld(&bar[XB_TOPGEN]) == tg, bar);
            __builtin_amdgcn_fence(__ATOMIC_ACQUIRE, "agent");
            xb_add(&bar[XB_XGEN(b.x)], 1u);
            asm volatile("s_waitcnt vmcnt(0)" ::: "memory");
        } else {
            XB_SPIN(xb_ld(&bar[XB_XGEN(b.x)]) == gen, bar);
            __builtin_amdgcn_fence(__ATOMIC_ACQUIRE, "agent");
            asm volatile("s_waitcnt vmcnt(0)" ::: "memory");
        }
    }
    __syncthreads();
}

struct Args { const float* in[17]; float* out; unsigned char* ws; int ph_lo, ph_hi, coop, pad; };

constexpr int W_I_IN = 16 * (NZP / 32), W_I_OUT = 16 * 32, W_I_PW = 4 * 8, W_ITEMS_L = W_I_IN + W_I_OUT + W_I_PW;
__device__ __forceinline__ void weight_copy_item(const float* w_in, const float* w_out, const float* w_pw, const float* norm_g, unsigned char* ws, int ll, int r, LAS float* scr, int lane) {
    if (r < W_I_IN) { transpose_item(w_in + (size_t)ll * DM * NZ, DM, NZ, NZP / 32, (bf16_t*)(ws + WS_WIN + ll * WIN_L), scr, r, lane, norm_g + ll * DM); return; } r -= W_I_IN;
    if (r < W_I_OUT) { transpose_item(w_out + (size_t)ll * DM * DM, DM, DM, 32, (bf16_t*)(ws + WS_WOUT + ll * WOUT_L), scr, r, lane); return; } r -= W_I_OUT;
    transpose_item(w_pw + (size_t)ll * 65536, 256, 256, 8, (bf16_t*)(ws + WS_WPW + ll * WPW_L), scr, r, lane);
}
template <int K> __device__ __forceinline__ void run_phase(const int l, LAS unsigned char* lds_base, LAS int* s_item, const int rep = 0) {
        typedef const __attribute__((address_space(4))) Args* ArgP;
        ArgP ap = (ArgP)__builtin_amdgcn_kernarg_segment_ptr(); asm volatile("" : "+s"(ap));
        Frame F;
        F.lds = lds_base;
        { int t_ = threadIdx.x; asm volatile("" : "+v"(t_)); F.tid = t_; F.lane = t_ & 63; F.wave = __builtin_amdgcn_readfirstlane(t_ >> 6); }
        { int g_ = gridDim.x, b_ = blockIdx.x; asm volatile("" : "+s"(g_), "+s"(b_)); F.G = g_; F.bid = b_; }
        unsigned char* ws = ap->ws;
        F.ctl = (unsigned*)(ws + WS_CTL);
        F.H = (bf16_t*)(ws + WS_H); F.Z = (bf16_t*)(ws + WS_Z); F.CC = (bf16_t*)(ws + WS_CC); F.DOp = F.Z + C_DO;
        F.KMP = (float*)(ws + WS_KM + (size_t)l * 65536); F.BL = (float*)(ws + WS_BL); F.DST = (float*)(ws + WS_DST); F.KV = (float*)(ws + WS_KV);
        F.PO = (bf16_t*)(ws + WS_PO); F.PS = (float*)(F.Z + C_PS); F.LIST = (unsigned*)(ws + WS_LIST);
        LayerP P;
        P.norm_g = ap->in[1] + l * DM;
        P.qga = ap->in[3] + l * 64; P.kga = ap->in[4] + l * 64; P.qgb = ap->in[5] + l * 64; P.kgb = ap->in[6] + l * 64;
        P.conv_w = ap->in[7] + l * 31 * 256; P.conv_b = ap->in[8] + l * 256; P.ln_g = ap->in[9] + l * 256; P.ln_b = ap->in[10] + l * 256;
        P.pw_b = ap->in[12] + l * 256; P.gate_w = ap->in[13] + l * 16 * 128; P.gate_b = ap->in[14] + l * 128; P.gla_g = ap->in[15] + l * 64;
        P.WinT = (const bf16_t*)(ws + WS_WIN + l * WIN_L); P.WoutT = (const bf16_t*)(ws + WS_WOUT + l * WOUT_L); P.WpwT = (const bf16_t*)(ws + WS_WPW + l * WPW_L);
        P.xin = (l == 0) ? ap->in[0] : ap->out; P.xout = ap->out;

        if constexpr (K == 0) {
            const int gw = F.bid * NWAVES + F.wave, NGW = F.G * NWAVES;
            if (l == 0) {
                float* z1 = (float*)(ws + WS_SSQ1); float* z2 = (float*)(ws + WS_KM);
                for (int i = F.bid * NTHR + F.tid; i < MTOK + 2 * 16384; i += F.G * NTHR) { if (i < MTOK) z1[i] = 0.f; else z2[i - MTOK] = 0.f; }
            }
            if (l == 0) {
                LAS float* scr = (LAS float*)(F.lds + F.wave * 16384);
                for (int it = gw; it < W_I_IN; it += NGW) weight_copy_item(ap->in[2], ap->in[16], ap->in[11], ap->in[1], ws, 0, it, scr, F.lane);
            }
            if (l == 0) for (int m = gw; m < MTOK; m += 2 * NGW) cvt_row2(P.xin + (size_t)m * DM, F.H + (size_t)m * DM, (float*)(ws + WS_SSQ0) + m, (size_t)NGW, F.lane);
        } else if constexpr (K == 1) {
            pg8::Gemm g{F.H, P.WinT, MTOK, NZP, DM}; pg8::StaticOrder S; S.init(MTOK, NZP, F.G, F.bid);
            pg8::EpiZ E{F.Z, NZP, (const float*)(ws + (l == 0 ? WS_SSQ0 : WS_SSQ1)), 1.0f / DM, EPS, (LAS float*)(F.lds + 135168), P.qga, P.kga, P.qgb, P.kgb, (float*)(ws + WS_KM + (size_t)l * 65536), QSCALE, NZ};
            pg8::gemm_phase<pg8::EpiZ, pg8::StaticOrder, true, true>(F.lds, g, S, E);
            if (l == 0) {
                const int nu = (MTOK / 256) * (NZP / 256), base_u = nu / F.G, rem_u = nu % F.G;
                const int nfree = (rem_u == 0) ? F.G : (F.G - rem_u), fidx = (rem_u == 0) ? F.bid : (F.bid - rem_u);
                if (fidx >= 0) { LAS float* scr = (LAS float*)(F.lds + F.wave * 16384);
                    const int nw_ = nfree * NWAVES, w0_ = fidx * NWAVES + F.wave;
                    for (int it = W_I_IN + w0_; it < W_ITEMS_L; it += nw_) weight_copy_item(ap->in[2], ap->in[16], ap->in[11], ap->in[1], ws, 0, it, scr, F.lane);
                    for (int it = w0_; it < W_ITEMS_L; it += nw_) weight_copy_item(ap->in[2], ap->in[16], ap->in[11], ap->in[1], ws, 1, it, scr, F.lane); }
                (void)base_u;
            }
        } else if constexpr (K == 2) {
            if (!rep) for (int it = F.bid; it < 256; it += F.G) gla_kv_item(F, P, it);
            if (!rep) { unsigned* cnt = F.ctl + 1024 + l * 256;
                for (int it = F.bid; it < 256; it += F.G) moba_topk_unit(F, P, (it >> 2) & 1, it & 3, 31 - (it >> 3), cnt, F.LIST); }
            { const int nr_ = (REP_PHASE == -8) ? 5 : 1; for (int it = F.bid; it < 256 * nr_; it += F.G) conv_item(F, P, it & 255); }
        } else if constexpr (K == 4) {
            if (!rep) for (int it = F.bid; it < 256; it += F.G) gla_scan_item2(F, it);
            att_phase(F, F.ctl + 1024 + l * 256, F.ctl + 2048 + l * 64);
        } else if constexpr (K == 5) {
            { const int nrep_ = (REP_PHASE == -2) ? 4 : 1; for (int it = F.bid; it < 256 * nrep_; it += F.G) gla_out_item(F, P, it & 255); }
            for (int it = F.bid; it < 1024; it += 4 * F.G) combine_items<4, 4>(F, it, F.G, 1024, F.PO, 256, 64, (size_t)MTOK * 256, F.PS, NZP / 2, 8, 2, C_GA, 0);
            for (int it = F.bid; it < 1024; it += 4 * F.G) combine_items<3, 4>(F, it, F.G, 1024, F.DOp, NZP, 64, 256, F.DST, 8, 2, (size_t)MTOK * 8, C_GB, 256);
        } else {
            pg8::Gemm g{F.CC, P.WoutT, MTOK, DM, DM}; pg8::StaticOrder S; S.init(MTOK, DM, F.G, F.bid);
            if (l == 0) { pg8::EpiResX E{F.H, (float*)(ws + WS_SSQ1), DM};
                pg8::gemm_phase<pg8::EpiResX, pg8::StaticOrder, true, true>(F.lds, g, S, E); }
            else { pg8::EpiRes E{F.H, P.xout, DM};
                pg8::gemm_phase<pg8::EpiRes, pg8::StaticOrder, true, true>(F.lds, g, S, E); }
        }
}

__global__ void __launch_bounds__(NTHR, 2) hybrid_fwd(Args args) {
    extern __shared__ __attribute__((aligned(16))) unsigned char lds_raw[];
    cg::grid_group grid = cg::this_grid();
    LAS unsigned char* lds_base = (LAS unsigned char*)lds_raw;
    LAS int* s_item = (LAS int*)(lds_base + LDS_BYTES - 64);
    const int ph_lo = args.ph_lo, ph_hi = args.ph_hi, coop = args.coop;
    volatile LAS unsigned* bst = (volatile LAS unsigned*)(lds_base + LDS_BYTES - 32);
    if (threadIdx.x == 0) { bst[0] = 0u; bst[1] = 0u; }
    __syncthreads();
    XcdBarrier bar; bar.bar = (unsigned*)(args.ws + WS_CTL) + 4096; bar.x = 0; bar.st = bst;
    if (coop) bar = xcd_barrier_post((unsigned*)(args.ws + WS_CTL) + 4096, bst);
#define GRID_BAR() do { if (coop == 2) grid.sync(); else if (coop == 1) xcd_barrier(bar); } while (0)
    if (REP_PHASE == -3 && coop) { for (int zz = 0; zz < 20; ++zz) GRID_BAR(); }
#ifndef ONLY_K
#define ONLY_K -1
#endif
#define RUN(PH) if ((ONLY_K < 0 || ((PH) % 7) == ONLY_K) && ph_lo <= (PH) && (PH) < ph_hi) { run_phase<(PH) % 7>((PH) / 7, lds_base, s_item); \
        if ((PH) == REP_PHASE) { GRID_BAR(); run_phase<(PH) % 7>((PH) / 7, lds_base, s_item, 1); } \
        if ((PH) + 1 < ph_hi) GRID_BAR(); }
#ifdef LAYER_LOOP
    RUN(0)
#define RUNL(KK) { const int ph_ = 7 * lyr + (KK); if ((ONLY_K < 0 || (KK) == ONLY_K) && ph_lo <= ph_ && ph_ < ph_hi) { run_phase<(KK)>(lyr, lds_base, s_item); \
        if (ph_ == REP_PHASE) { GRID_BAR(); run_phase<(KK)>(lyr, lds_base, s_item, 1); } \
        if (ph_ + 1 < ph_hi) GRID_BAR(); } }
#pragma nounroll
    for (int lyr_ = 0; lyr_ < 2; ++lyr_) { int lyr = lyr_; asm volatile("" : "+s"(lyr)); RUNL(1) RUNL(2) RUNL(4) RUNL(5) RUNL(6) }
#undef RUNL
#else
    RUN(0) RUN(1) RUN(2) RUN(4) RUN(5) RUN(6) RUN(8) RUN(9) RUN(11) RUN(12) RUN(13)
#endif
#undef RUN
#undef GRID_BAR
}

extern "C" void kernel_launch(void* const* d_in, const int* in_sizes, int n_in, void* d_out, int out_size, void* d_ws, size_t ws_size, hipStream_t stream) {
    static int grid = 0;
    if (grid == 0) {
        if (n_in != 17 || out_size != MTOK * DM || ws_size < WS_END) { fprintf(stderr, "kernel_launch: unexpected shapes (n_in %d out %d ws %zu)\n", n_in, out_size, ws_size); grid = -1; return; }
        int dev = 0, cus = 0, per_cu = 0;
        hipGetDevice(&dev); hipDeviceGetAttribute(&cus, hipDeviceAttributeMultiprocessorCount, dev);
        if (hipFuncSetAttribute((const void*)hybrid_fwd, hipFuncAttributeMaxDynamicSharedMemorySize, LDS_BYTES) != hipSuccess) { fprintf(stderr, "kernel_launch: hipFuncSetAttribute failed\n"); grid = -1; return; }
        if (hipOccupancyMaxActiveBlocksPerMultiprocessor(&per_cu, (const void*)hybrid_fwd, NTHR, LDS_BYTES) != hipSuccess || per_cu < 1) { fprintf(stderr, "kernel_launch: occupancy query gives %d\n", per_cu); per_cu = 1; }
        (void)hipGetLastError();
        if (per_cu > 1) per_cu = 1;
        grid = cus * per_cu;
    }
    if (grid < 0) return;
    hipMemsetAsync((char*)d_ws + WS_CTL, 0, CTL_ZERO_BYTES, stream);
    Args a{};
    for (int i = 0; i < 17; ++i) a.in[i] = (const float*)d_in[i];
    a.out = (float*)d_out; a.ws = (unsigned char*)d_ws;
#if N_LAUNCH_MODE == 1
    a.ph_lo = 0; a.ph_hi = 14; a.coop = 1;
    void* kargs[] = {&a};
    hipError_t e = hipLaunchCooperativeKernel((const void*)hybrid_fwd, dim3(grid), dim3(NTHR), kargs, LDS_BYTES, stream);
    if (e != hipSuccess) fprintf(stderr, "cooperative launch failed: %s (grid %d)\n", hipGetErrorString(e), grid);
#else
    for (int ph = 0; ph < 14; ++ph) { a.ph_lo = ph; a.ph_hi = ph + 1; a.coop = 0;
        hipLaunchKernelGGL(hybrid_fwd, dim3(grid), dim3(NTHR), LDS_BYTES, stream, a); }
#endif
}
```

```cpp
#include <hip/hip_runtime.h>
#include <hip/hip_cooperative_groups.h>
#include <cstdio>
#include <cstdint>
namespace cg = cooperative_groups;
template <int CTRL> __device__ __forceinline__ float xl_dpp(float v) { return __int_as_float(__builtin_amdgcn_update_dpp(0, __float_as_int(v), CTRL, 0xF, 0xF, true)); }
__device__ __forceinline__ float row16_sum(float v) { v += xl_dpp<0xB1>(v); v += xl_dpp<0x4E>(v); v += xl_dpp<0x141>(v); v += xl_dpp<0x140>(v); return v; }
__device__ __forceinline__ float row16_max(float v) { v = fmaxf(v, xl_dpp<0xB1>(v)); v = fmaxf(v, xl_dpp<0x4E>(v)); v = fmaxf(v, xl_dpp<0x141>(v)); v = fmaxf(v, xl_dpp<0x140>(v)); return v; }
__device__ __forceinline__ float xor16_sum(float v) { const auto r = __builtin_amdgcn_permlane16_swap(__float_as_uint(v), __float_as_uint(v), false, false); return __uint_as_float(r[0]) + __uint_as_float(r[1]); }
__device__ __forceinline__ float xor32_sum(float v) { const auto r = __builtin_amdgcn_permlane32_swap(__float_as_uint(v), __float_as_uint(v), false, false); return __uint_as_float(r[0]) + __uint_as_float(r[1]); }
__device__ __forceinline__ float wave64_sum(float v) { v = row16_sum(v);
    return (__int_as_float(__builtin_amdgcn_readlane(__float_as_int(v), 0)) + __int_as_float(__builtin_amdgcn_readlane(__float_as_int(v), 16))) + (__int_as_float(__builtin_amdgcn_readlane(__float_as_int(v), 32)) + __int_as_float(__builtin_amdgcn_readlane(__float_as_int(v), 48))); }
__device__ __forceinline__ float wave64_max(float v) { v = row16_max(v);
    return fmaxf(fmaxf(__int_as_float(__builtin_amdgcn_readlane(__float_as_int(v), 0)), __int_as_float(__builtin_amdgcn_readlane(__float_as_int(v), 16))), fmaxf(__int_as_float(__builtin_amdgcn_readlane(__float_as_int(v), 32)), __int_as_float(__builtin_amdgcn_readlane(__float_as_int(v), 48)))); }
namespace pg8 {
#define PG8_LAS __attribute__((address_space(3)))
typedef unsigned short bf16_t;
typedef short bf16x8 __attribute__((ext_vector_type(8)));
typedef float f32x4 __attribute__((ext_vector_type(4)));
typedef unsigned u32x4 __attribute__((ext_vector_type(4)));
constexpr int BM = 256, BK = 64, HALF = 128, HTB = HALF * BK * 2  , STAGE_BYTES = 8 * HTB, NXCD = 8, WGM = 8;

__host__ __device__ __forceinline__ int lds_byte(int r, int c) { const int st = (r >> 4) * 2 + (c >> 5), rr = r & 15, cc = c & 31, ob = rr * 64 + cc * 2; return st * 1024 + (ob ^ (((ob >> 9) & 1) << 5)); }
__host__ __device__ __forceinline__ void stage_rc(int b, int& R, int& C) { const int st = b / 1024, sb = b % 1024, swz = sb ^ (((sb >> 9) & 1) << 5); R = (st >> 1) * 16 + swz / 64; C = (st & 1) * 32 + (swz % 64) / 2; }
__host__ __device__ __forceinline__ int perm32(int rho) { const int n = rho >> 4, i = rho & 15; return 8 * (i >> 2) + 4 * n + (i & 3); }

struct Unit { int pm, pn; };
struct Gemm { const bf16_t* A; const bf16_t* Bt; int M, N, K; };

struct StaticOrder {
    int nM, nN, nwg, G, c;
    __host__ __device__ void init(int M, int N, int G_, int c_) { nM = M / BM; nN = N / BM; nwg = nM * nN; G = G_; c = c_; }
    __host__ __device__ bool next(int i, Unit& u) const {
        const long L = (long)i * G + c; if (L >= nwg) return false;
        int wgid = (int)L; { const int q = nwg / NXCD, r = nwg % NXCD, xcd = wgid % NXCD, off = wgid / NXCD; wgid = (xcd < r ? xcd * (q + 1) : r * (q + 1) + (xcd - r) * q) + off; }
        const int nig = WGM * nN, gid = wgid / nig, fm = gid * WGM, gsz = (nM - fm) < WGM ? (nM - fm) : WGM;
        u.pm = fm + ((wgid % nig) % gsz); u.pn = (wgid % nig) / gsz; return true;
    }
    __device__ __forceinline__ void a_ready(const Unit&) const {}
    __device__ __forceinline__ void done(const Unit&) const {}
};

__device__ __forceinline__ unsigned cvt_pk_bf16(float lo, float hi) { unsigned r; asm volatile("v_cvt_pk_bf16_f32 %0, %1, %2" : "=v"(r) : "v"(lo), "v"(hi)); return r; }
struct EpiZ {
    static constexpr bool PERM = true, AFTER_DRAIN = false;
    bf16_t* O; int ldc; const float* ssq; float inv_k, eps;
    PG8_LAS float* xch; const float *qga, *kga, *qgb, *kgb; float* km; float qscale; int ncols;
    __device__ __forceinline__ void operator()(const f32x4 (&acc)[2][2][4][2], const Unit& u, int wr, int wc, int fr, int fq) const {
        const int row0 = u.pm * BM + wr * 64 + fr; const int col0 = u.pn * BM + wc * 32 + 8 * fq;
        const int kind = (u.pn == 0) ? 1 : (u.pn == 1) ? 2 : (u.pn == 4) ? 3 : (u.pn == 5) ? 4 : 0;
        float sc[2][4];
#pragma unroll
        for (int ai = 0; ai < 2; ++ai)
#pragma unroll
            for (int m = 0; m < 4; ++m) sc[ai][m] = __builtin_amdgcn_rsqf(__hip_atomic_load(ssq + row0 + ai * HALF + m * 16, __ATOMIC_RELAXED, __HIP_MEMORY_SCOPE_AGENT) * inv_k + eps);
        const int wave = wr * 4 + wc;
        const float* gp = (kind == 1) ? qga : (kind == 2) ? kga : (kind == 3) ? qgb : kgb;
        const float gs = (kind & 1) ? qscale : 1.0f;
        float g[8];
#pragma unroll
        for (int e2 = 0; e2 < 8; ++e2) g[e2] = gp[32 * (wc & 1) + 8 * fq + e2] * gs;
        if (kind != 0) {
#pragma unroll
            for (int ai = 0; ai < 2; ++ai)
#pragma unroll
                for (int m = 0; m < 4; ++m)
#pragma unroll
                    for (int bj = 0; bj < 2; ++bj) { const f32x4 v0 = acc[ai][bj][m][0] * sc[ai][m], v1 = acc[ai][bj][m][1] * sc[ai][m];
                        float s = (v0[0] * v0[0] + v0[1] * v0[1]) + (v0[2] * v0[2] + v0[3] * v0[3]) + (v1[0] * v1[0] + v1[1] * v1[1]) + (v1[2] * v1[2] + v1[3] * v1[3]);
                        s = xor16_sum(s); s = xor32_sum(s);
                        if (fq == 0) xch[((wave * 2 + ai) * 4 + m) * 32 + bj * 16 + fr] = s; }
        }
        asm volatile("s_waitcnt lgkmcnt(0)" ::: "memory"); __builtin_amdgcn_s_barrier(); asm volatile("" ::: "memory");
        if (kind == 0) {
#pragma unroll
            for (int ai = 0; ai < 2; ++ai)
#pragma unroll
                for (int m = 0; m < 4; ++m) { bf16_t* rowp = O + (size_t)(row0 + ai * HALF + m * 16) * ldc + col0;
#pragma unroll
                    for (int bj = 0; bj < 2; ++bj) { const f32x4 v0 = acc[ai][bj][m][0] * sc[ai][m], v1 = acc[ai][bj][m][1] * sc[ai][m];
                        u32x4 w; w.x = cvt_pk_bf16(v0[0], v0[1]); w.y = cvt_pk_bf16(v0[2], v0[3]); w.z = cvt_pk_bf16(v1[0], v1[1]); w.w = cvt_pk_bf16(v1[2], v1[3]);
                        if (col0 + bj * HALF < ncols) *(u32x4*)(rowp + bj * HALF) = w; } }
            return;
        }
        float kacc[2][8];
#pragma unroll
        for (int bj = 0; bj < 2; ++bj)
#pragma unroll
            for (int e2 = 0; e2 < 8; ++e2) kacc[bj][e2] = 0.f;
        const int we = wave & ~1;
#pragma unroll
        for (int ai = 0; ai < 2; ++ai)
#pragma unroll
            for (int m = 0; m < 4; ++m) { bf16_t* rowp = O + (size_t)(row0 + ai * HALF + m * 16) * ldc + col0;
#pragma unroll
                for (int bj = 0; bj < 2; ++bj) {
                    const float tot = xch[((we * 2 + ai) * 4 + m) * 32 + bj * 16 + fr] + xch[(((we + 1) * 2 + ai) * 4 + m) * 32 + bj * 16 + fr];
                    const float rh = sc[ai][m] * __builtin_amdgcn_rsqf(tot * (1.0f / 64.0f) + eps);
                    f32x4 v0 = acc[ai][bj][m][0] * rh, v1 = acc[ai][bj][m][1] * rh;
                    v0[0] *= g[0]; v0[1] *= g[1]; v0[2] *= g[2]; v0[3] *= g[3]; v1[0] *= g[4]; v1[1] *= g[5]; v1[2] *= g[6]; v1[3] *= g[7];
                    if (kind == 2) { kacc[bj][0] += v0[0]; kacc[bj][1] += v0[1]; kacc[bj][2] += v0[2]; kacc[bj][3] += v0[3]; kacc[bj][4] += v1[0]; kacc[bj][5] += v1[1]; kacc[bj][6] += v1[2]; kacc[bj][7] += v1[3]; }
                    u32x4 w; w.x = cvt_pk_bf16(v0[0], v0[1]); w.y = cvt_pk_bf16(v0[2], v0[3]); w.z = cvt_pk_bf16(v1[0], v1[1]); w.w = cvt_pk_bf16(v1[2], v1[3]);
                    *(u32x4*)(rowp + bj * HALF) = w; } }
        if (kind == 2) {
#pragma unroll
            for (int bj = 0; bj < 2; ++bj)
#pragma unroll
                for (int e2 = 0; e2 < 8; ++e2) { float s = kacc[bj][e2];
                    s = row16_sum(s);
                    if (fr == 0) atomicAdd(km + (size_t)u.pm * 256 + bj * HALF + wc * 32 + 8 * fq + e2, s); }
        }
    }
};
struct EpiResX {
    static constexpr bool PERM = false, AFTER_DRAIN = false;
    bf16_t* xb; float* ssq; int ldc;
    __device__ __forceinline__ void operator()(const f32x4 (&acc)[2][2][4][2], const Unit& u, int wr, int wc, int fr, int fq) const {
        const int col0 = u.pn * BM + wc * 32 + 4 * fq;
#pragma unroll
        for (int ai = 0; ai < 2; ++ai) {
            unsigned long long bs[4][2][2];
#pragma unroll
            for (int m = 0; m < 4; ++m) { const size_t off = (size_t)(u.pm * BM + ai * HALF + wr * 64 + m * 16 + fr) * ldc + col0;
#pragma unroll
                for (int bj = 0; bj < 2; ++bj)
#pragma unroll
                    for (int n = 0; n < 2; ++n) bs[m][bj][n] = *(const unsigned long long*)(xb + off + bj * HALF + n * 16); }
            asm volatile("" ::: "memory");
#pragma unroll
            for (int m = 0; m < 4; ++m) { const int row = u.pm * BM + ai * HALF + wr * 64 + m * 16 + fr; const size_t off = (size_t)row * ldc + col0;
                float s = 0.f;
#pragma unroll
                for (int bj = 0; bj < 2; ++bj)
#pragma unroll
                    for (int n = 0; n < 2; ++n) { const unsigned long long wv = bs[m][bj][n]; const unsigned lo = (unsigned)wv, hi = (unsigned)(wv >> 32);
                        f32x4 r; r[0] = __uint_as_float(lo << 16); r[1] = __uint_as_float(lo & 0xffff0000u); r[2] = __uint_as_float(hi << 16); r[3] = __uint_as_float(hi & 0xffff0000u);
                        const f32x4 x1 = r + acc[ai][bj][m][n];
                        unsigned long long w = (unsigned long long)cvt_pk_bf16(x1[0], x1[1]) | ((unsigned long long)cvt_pk_bf16(x1[2], x1[3]) << 32);
                        *(unsigned long long*)(xb + off + bj * HALF + n * 16) = w;
                        s += (x1[0] * x1[0] + x1[1] * x1[1]) + (x1[2] * x1[2] + x1[3] * x1[3]); }
                s = xor16_sum(s); s = xor32_sum(s);
                if (fq == 0) atomicAdd(ssq + row, s); }
            asm volatile("" ::: "memory");
        }
    }
};
struct EpiRes {
    static constexpr bool PERM = false, AFTER_DRAIN = false;
    const bf16_t* xb; float* out; int ldc;
    __device__ __forceinline__ void operator()(const f32x4 (&acc)[2][2][4][2], const Unit& u, int wr, int wc, int fr, int fq) const {
        const int col0 = u.pn * BM + wc * 32 + 4 * fq;
        unsigned long long bs[2][4][2][2];
#pragma unroll
        for (int ai = 0; ai < 2; ++ai)
#pragma unroll
            for (int m = 0; m < 4; ++m) { const size_t off = (size_t)(u.pm * BM + ai * HALF + wr * 64 + m * 16 + fr) * ldc + col0;
#pragma unroll
                for (int bj = 0; bj < 2; ++bj)
#pragma unroll
                    for (int n = 0; n < 2; ++n) bs[ai][m][bj][n] = *(const unsigned long long*)(xb + off + bj * HALF + n * 16); }
        asm volatile("" ::: "memory");
#pragma unroll
        for (int ai = 0; ai < 2; ++ai)
#pragma unroll
            for (int m = 0; m < 4; ++m) { const size_t off = (size_t)(u.pm * BM + ai * HALF + wr * 64 + m * 16 + fr) * ldc + col0;
#pragma unroll
                for (int bj = 0; bj < 2; ++bj)
#pragma unroll
                    for (int n = 0; n < 2; ++n) { const unsigned long long w = bs[ai][m][bj][n]; const unsigned lo = (unsigned)w, hi = (unsigned)(w >> 32);
                        f32x4 r; r[0] = __uint_as_float(lo << 16); r[1] = __uint_as_float(lo & 0xffff0000u); r[2] = __uint_as_float(hi << 16); r[3] = __uint_as_float(hi & 0xffff0000u);
                        *(f32x4*)(out + off + bj * HALF + n * 16) = r + acc[ai][bj][m][n]; } }
    }
};
template <class Epi, class Sched, bool ALIGN_EPI = false, bool SP2 = false>
__device__ __forceinline__ void gemm_phase(PG8_LAS unsigned char* lds, const Gemm g, const Sched& S, const Epi& E) {
    int tid_l = threadIdx.x; asm volatile("" : "+v"(tid_l));
    const int tid = tid_l, wid = __builtin_amdgcn_readfirstlane(tid >> 6), lane = tid & 63, wr = wid >> 2, wc = wid & 3, fr = lane & 15, fq = lane >> 4;
    const int K = g.K, nt = K / BK;
    unsigned voffA[2], voffB[2];
#pragma unroll
    for (int i = 0; i < 2; ++i) { int R, C; stage_rc(tid * 16 + i * 8192, R, C); const int Rb = Epi::PERM ? ((R & ~31) + perm32(R & 31)) : R;
        voffA[i] = (unsigned)(R * K + C) * 2u; voffB[i] = (unsigned)(Rb * K + C) * 2u; }
    const size_t kstep = (size_t)(BK * 2);
    const size_t hstep = (size_t)HALF * K * 2;
    const size_t tstep = 2 * hstep;
    const unsigned ldsw = (unsigned)wid * 1024u;
    const int aoff = lds_byte(wr * 64 + fr, fq * 8), boff = lds_byte(wc * 32 + fr, fq * 8);
#define PG8_SA(b, h) (((b) * 2 + (h)) * HTB)
#define PG8_SB(b, h) ((4 + (b) * 2 + (h)) * HTB)
#define PG8_STAGE(bufoff, gbase, voff) do { _Pragma("unroll") for (int _i = 0; _i < 2; ++_i) \
        __builtin_amdgcn_global_load_lds((const unsigned*)((const char*)(gbase) + (voff)[_i]), (PG8_LAS unsigned*)(lds + (bufoff) + ldsw + _i * 8192), 16, 0, 0); } while (0)
#define PG8_LDA(dst, b, h) do { _Pragma("unroll") for (int m = 0; m < 4; ++m) _Pragma("unroll") for (int k = 0; k < 2; ++k) dst[m][k] = *(const PG8_LAS bf16x8*)(lds + PG8_SA(b, h) + aoff + m * 2048 + k * 1024); } while (0)
#define PG8_LDB(dst, b, h) do { _Pragma("unroll") for (int n = 0; n < 2; ++n) _Pragma("unroll") for (int k = 0; k < 2; ++k) dst[n][k] = *(const PG8_LAS bf16x8*)(lds + PG8_SB(b, h) + boff + n * 2048 + k * 1024); } while (0)
#define PG8_MMA(ai, bj, At, Bt) do { __builtin_amdgcn_s_setprio(1); _Pragma("unroll") for (int m = 0; m < 4; ++m) _Pragma("unroll") for (int n = 0; n < 2; ++n) _Pragma("unroll") for (int k = 0; k < 2; ++k) \
        acc[ai][bj][m][n] = __builtin_amdgcn_mfma_f32_16x16x32_bf16(Bt[n][k], At[m][k], acc[ai][bj][m][n], 0, 0, 0); __builtin_amdgcn_s_setprio(0); } while (0)
#define PG8_WAIT_V(n) asm volatile("s_waitcnt vmcnt(" #n ")" ::: "memory")
#define PG8_WAIT_L(n) asm volatile("s_waitcnt lgkmcnt(" #n ")" ::: "memory")
#define PG8_BAR __builtin_amdgcn_s_barrier()
#define PG8_SCHED __builtin_amdgcn_sched_barrier(0)
    Unit cur, nxt; int ui = 0;
    if (!S.next(0, cur)) return;
    f32x4 acc[2][2][4][2];
#pragma unroll
    for (int a = 0; a < 2; ++a)
#pragma unroll
        for (int b = 0; b < 2; ++b)
#pragma unroll
            for (int m = 0; m < 4; ++m)
#pragma unroll
                for (int n = 0; n < 2; ++n) acc[a][b][m][n] = (f32x4){0.f, 0.f, 0.f, 0.f};
    bf16x8 At[4][2], B0[2][2], B1[2][2];
    const char* cA = (const char*)g.A + (size_t)cur.pm * tstep; const char* cB = (const char*)g.Bt + (size_t)cur.pn * tstep;
    S.a_ready(cur);
    if constexpr (SP2) {
        PG8_STAGE(PG8_SB(0, 0), cB, voffB); PG8_STAGE(PG8_SB(0, 1), cB + hstep, voffB); PG8_STAGE(PG8_SA(0, 0), cA, voffA); PG8_STAGE(PG8_SA(0, 1), cA + hstep, voffA);
        if (wr == 1) PG8_BAR;
        PG8_WAIT_V(2); PG8_BAR;
        PG8_STAGE(PG8_SB(1, 0), cB + kstep, voffB); PG8_STAGE(PG8_SA(1, 0), cA + kstep, voffA); PG8_STAGE(PG8_SB(1, 1), cB + hstep + kstep, voffB);
        PG8_WAIT_V(6); PG8_BAR;
    } else {
        PG8_STAGE(PG8_SB(0, 0), cB, voffB); PG8_STAGE(PG8_SA(0, 0), cA, voffA); PG8_STAGE(PG8_SB(0, 1), cB + hstep, voffB); PG8_STAGE(PG8_SA(0, 1), cA + hstep, voffA);
        if (wr == 1) PG8_BAR;
        PG8_WAIT_V(4); PG8_BAR;
        PG8_STAGE(PG8_SB(1, 0), cB + kstep, voffB); PG8_STAGE(PG8_SA(1, 0), cA + kstep, voffA); PG8_STAGE(PG8_SB(1, 1), cB + hstep + kstep, voffB);
        PG8_WAIT_V(6); PG8_BAR;
    }
    for (;;) {
        const bool has_next = S.next(ui + 1, nxt);
        const char* nA = has_next ? (const char*)g.A + (size_t)nxt.pm * tstep : cA; const char* nB = has_next ? (const char*)g.Bt + (size_t)nxt.pn * tstep : cB;
        for (int t = 0; t < nt; t += 2) {
            const bool last = (t == nt - 2);
            const char* a1 = cA + (size_t)(t + 1) * kstep;
            const char* a2 = last ? nA : cA + (size_t)(t + 2) * kstep; const char* b2 = last ? nB : cB + (size_t)(t + 2) * kstep;
            const char* a3 = a2 + kstep; const char* b3 = b2 + kstep;
            if (last && has_next) S.a_ready(nxt);
            if constexpr (SP2) {
            PG8_LDB(B0, 0, 0); PG8_LDB(B1, 0, 1); PG8_SCHED; PG8_LDA(At, 0, 0); PG8_STAGE(PG8_SA(1, 1), a1 + hstep, voffA);
            PG8_WAIT_V(8); PG8_WAIT_L(0); PG8_BAR; PG8_MMA(0, 0, At, B0); PG8_MMA(0, 1, At, B1); PG8_BAR; PG8_SCHED;
            PG8_LDA(At, 0, 1); PG8_STAGE(PG8_SB(0, 0), b2, voffB); PG8_STAGE(PG8_SB(0, 1), b2 + hstep, voffB); PG8_STAGE(PG8_SA(0, 0), a2, voffA);
            PG8_WAIT_V(8); PG8_WAIT_L(0); PG8_BAR; PG8_MMA(1, 0, At, B0); PG8_MMA(1, 1, At, B1); PG8_BAR; PG8_SCHED;
            PG8_LDB(B0, 1, 0); PG8_LDB(B1, 1, 1); PG8_SCHED; PG8_LDA(At, 1, 0); PG8_STAGE(PG8_SA(0, 1), a2 + hstep, voffA);
            PG8_WAIT_V(8); PG8_WAIT_L(0); PG8_BAR; PG8_MMA(0, 0, At, B0); PG8_MMA(0, 1, At, B1); PG8_BAR; PG8_SCHED;
            PG8_LDA(At, 1, 1); PG8_STAGE(PG8_SB(1, 0), b3, voffB); PG8_STAGE(PG8_SB(1, 1), b3 + hstep, voffB); PG8_STAGE(PG8_SA(1, 0), a3, voffA);
            PG8_WAIT_V(8); PG8_WAIT_L(0); PG8_BAR; PG8_MMA(1, 0, At, B0); PG8_MMA(1, 1, At, B1); PG8_BAR; PG8_SCHED;
            } else {
            PG8_LDB(B0, 0, 0); PG8_SCHED; PG8_LDA(At, 0, 0); PG8_STAGE(PG8_SA(1, 1), a1 + hstep, voffA);
            PG8_WAIT_L(8); PG8_BAR; PG8_WAIT_L(0); PG8_MMA(0, 0, At, B0); PG8_BAR; PG8_SCHED;
            PG8_LDB(B1, 0, 1); PG8_STAGE(PG8_SB(0, 0), b2, voffB);
            PG8_BAR; PG8_WAIT_L(0); PG8_MMA(0, 1, At, B1); PG8_BAR;
            PG8_LDA(At, 0, 1); PG8_STAGE(PG8_SA(0, 0), a2, voffA);
            PG8_BAR; PG8_WAIT_L(0); PG8_MMA(1, 0, At, B0); PG8_BAR; PG8_SCHED;
            PG8_STAGE(PG8_SB(0, 1), b2 + hstep, voffB);
            PG8_WAIT_V(6); PG8_BAR; PG8_MMA(1, 1, At, B1); PG8_BAR;
            PG8_LDB(B0, 1, 0); PG8_SCHED; PG8_LDA(At, 1, 0); PG8_STAGE(PG8_SA(0, 1), a2 + hstep, voffA);
            PG8_WAIT_L(8); PG8_BAR; PG8_WAIT_L(0); PG8_MMA(0, 0, At, B0); PG8_BAR; PG8_SCHED;
            PG8_LDB(B1, 1, 1); PG8_STAGE(PG8_SB(1, 0), b3, voffB);
            PG8_BAR; PG8_WAIT_L(0); PG8_MMA(0, 1, At, B1); PG8_BAR;
            PG8_LDA(At, 1, 1); PG8_STAGE(PG8_SA(1, 0), a3, voffA);
            PG8_BAR; PG8_WAIT_L(0); PG8_MMA(1, 0, At, B0); PG8_BAR; PG8_SCHED;
            PG8_STAGE(PG8_SB(1, 1), b3 + hstep, voffB);
            PG8_WAIT_V(6); PG8_BAR; PG8_MMA(1, 1, At, B1); PG8_BAR;
            }
        }
        if constexpr (ALIGN_EPI) { if (wr == 0) PG8_BAR; }
        if constexpr (!Epi::AFTER_DRAIN) { E(acc, cur, wr, wc, fr, fq); S.done(cur); }
        if (!has_next) break;
#pragma unroll
        for (int a = 0; a < 2; ++a)
#pragma unroll
            for (int b = 0; b < 2; ++b)
#pragma unroll
                for (int m = 0; m < 4; ++m)
#pragma unroll
                    for (int n = 0; n < 2; ++n) acc[a][b][m][n] = (f32x4){0.f, 0.f, 0.f, 0.f};
        cur = nxt; cA = nA; cB = nB; ++ui;
        if constexpr (ALIGN_EPI) { if (wr == 1) PG8_BAR; }
    }
    PG8_WAIT_V(0);
    if constexpr (!ALIGN_EPI) { if (wr == 0) PG8_BAR; }
    PG8_BAR;
    if constexpr (Epi::AFTER_DRAIN) { E.fused(acc, cur, wr, wc, fr, fq, lds, wid, lane); S.done(cur); }
#undef PG8_SA
#undef PG8_SB
#undef PG8_STAGE
#undef PG8_LDA
#undef PG8_LDB
#undef PG8_MMA
#undef PG8_WAIT_V
#undef PG8_WAIT_L
#undef PG8_BAR
#undef PG8_SCHED
}
}

#define LAS __attribute__((address_space(3)))
typedef unsigned short bf16_t;
typedef short bf16x8 __attribute__((ext_vector_type(8)));
typedef float f32x4 __attribute__((ext_vector_type(4)));
typedef float f32x16 __attribute__((ext_vector_type(16)));
typedef unsigned u32x4 __attribute__((ext_vector_type(4)));
typedef unsigned u32x2 __attribute__((ext_vector_type(2)));
typedef short v4i16_t __attribute__((ext_vector_type(4)));

constexpr int NB = 2, SEQ = 8192, MTOK = NB * SEQ, DM = 1024, NZ = 3600, NZP = 3840, DEPTH = 2;
constexpr int C_QA = 0, C_KA = 256, C_VA = 512, C_GA = 768, C_QB = 1024, C_KB = 1280, C_VB = 1536, C_GB = 1792;
constexpr int C_CA = 2048, C_CG = 2304, C_GC = 2560, C_QD = 2816, C_KD = 2944, C_VD = 3072, C_LR = 3328, C_GD = 3344;
constexpr float EPS = 1e-6f, LOG2E = 1.4426950408889634f, QSCALE = 0.125f * LOG2E;
constexpr int NTHR = 512, NWAVES = 8;
constexpr int LDS_BYTES = 155648;

#ifndef REP_PHASE
#define REP_PHASE -1
#endif
#ifndef N_LAUNCH_MODE
#define N_LAUNCH_MODE 1
#endif

constexpr size_t MiB = 1u << 20;
constexpr size_t WS_CTL = 0, CTL_ZERO_BYTES = 32 * 1024;
constexpr size_t WS_SSQ0 = 256 * 1024, WS_SSQ1 = 384 * 1024;
constexpr size_t WS_KM = 512 * 1024;
constexpr size_t WS_WIN = 1 * MiB;
constexpr size_t WIN_L = (size_t)NZP * DM * 2;
constexpr size_t WS_WOUT = 16 * MiB;
constexpr size_t WOUT_L = (size_t)DM * DM * 2;
constexpr size_t WS_WPW = 20 * MiB;
constexpr size_t WPW_L = 256 * 256 * 2;
constexpr size_t WS_BL = 20 * MiB + 768 * 1024;
constexpr size_t WS_DST = 21 * MiB;
constexpr size_t WS_KV = 23 * MiB;
constexpr size_t WS_PO = 32 * MiB;
constexpr size_t WS_H = 64 * MiB;
constexpr size_t WS_CC = 96 * MiB;
constexpr size_t WS_Z = 128 * MiB;
constexpr size_t WS_LIST = 248 * MiB;
constexpr size_t WS_END = 256 * MiB;
constexpr int C_DO = C_CA;
constexpr int C_PS = NZ;

__device__ __forceinline__ float bf2f(unsigned v) { return __uint_as_float(v << 16); }
typedef float f32x2c_t __attribute__((ext_vector_type(2))); typedef __bf16 bf16x2c_t __attribute__((ext_vector_type(2)));
__device__ __forceinline__ unsigned cvtpk_(float lo, float hi) { f32x2c_t v = {lo, hi}; bf16x2c_t b = __builtin_convertvector(v, bf16x2c_t); return __builtin_bit_cast(unsigned, b); }
__device__ __forceinline__ unsigned pk2(float lo, float hi) { return cvtpk_(lo, hi); }
__device__ __forceinline__ unsigned f2bf(float f) { return cvtpk_(f, 0.f) & 0xffffu; }
__device__ __forceinline__ void unpack8(const u32x4 a, float (&x)[8]) {
#pragma unroll
    for (int k = 0; k < 4; ++k) { x[2 * k] = bf2f(a[k] & 0xffffu); x[2 * k + 1] = bf2f(a[k] >> 16); }
}
__device__ __forceinline__ float wave_sum(float v) {
    return wave64_sum(v);
}
__device__ __forceinline__ float sigmoidf_(float x) { return __builtin_amdgcn_rcpf(1.0f + __expf(-x)); }
__device__ __forceinline__ float siluf_(float x) { return x * __builtin_amdgcn_rcpf(1.0f + __expf(-x)); }
__device__ __forceinline__ float logsigmoidf_(float x) { return x < 0.f ? x - log1pf(__expf(x)) : -log1pf(__expf(-x)); }
__device__ __forceinline__ int crow(int r, int hi) { return (r & 3) + 8 * (r >> 2) + 4 * hi; }
__device__ __forceinline__ float ex2(float x) { return __builtin_amdgcn_exp2f(x); }


__device__ __forceinline__ bf16x8 frag_tr_perm(const LAS bf16_t* img, int pitch, int kb, int colbase, int lane) {
    const int hf = lane >> 5, i = lane & 15;
    const LAS bf16_t* a = img + (kb + 4 * hf + (i >> 2)) * pitch + colbase + 16 * ((lane >> 4) & 1) + 4 * (i & 3);
    const v4i16_t lo = __builtin_amdgcn_ds_read_tr16_b64_v4i16((LAS v4i16_t*)a);
    const v4i16_t hi = __builtin_amdgcn_ds_read_tr16_b64_v4i16((LAS v4i16_t*)(a + 8 * pitch));
    return (bf16x8){lo[0], lo[1], lo[2], lo[3], hi[0], hi[1], hi[2], hi[3]};
}
struct LayerP {
    const float *norm_g, *qga, *kga, *qgb, *kgb, *conv_w, *conv_b, *ln_g, *ln_b, *pw_b, *gate_w, *gate_b, *gla_g;
    const bf16_t *WinT, *WoutT, *WpwT;
    const float* xin; float* xout;
};
struct Frame {
    LAS unsigned char* lds;
    int tid, lane, wave, G, bid;
    unsigned* ctl;
    bf16_t *H, *Z, *CC, *DOp, *PO; float *KMP, *BL, *DST, *KV, *PS; unsigned* LIST;
};

__device__ __forceinline__ void transpose_item(const float* W, int K, int N, int NPb, bf16_t* WT, LAS float* scr, int item, int lane, const float* kscale = nullptr) {
    const int nblk = NPb, kb = item / nblk, nb = item % nblk, k0 = 64 * kb, n0 = 32 * nb;
    const int nn = n0 + (lane & 31);
    float wv[32];
#pragma unroll
    for (int i = 0; i < 32; ++i) { const int kk = 2 * i + (lane >> 5); wv[i] = (nn < N) ? __builtin_nontemporal_load(W + (size_t)(k0 + kk) * N + nn) : 0.f; }
    if (kscale) {
#pragma unroll
        for (int i = 0; i < 32; ++i) wv[i] *= kscale[k0 + 2 * i + (lane >> 5)]; }
#pragma unroll
    for (int i = 0; i < 32; ++i) scr[(2 * i + (lane >> 5)) * 33 + (lane & 31)] = wv[i];
    asm volatile("s_waitcnt lgkmcnt(0)" ::: "memory");
    const int c = lane & 7;
#pragma unroll
    for (int j = 0; j < 4; ++j) { const int n = (lane >> 3) + 8 * j; const LAS float* s = scr + (8 * c) * 33 + n;
        u32x4 o; o.x = pk2(s[0 * 33], s[1 * 33]); o.y = pk2(s[2 * 33], s[3 * 33]); o.z = pk2(s[4 * 33], s[5 * 33]); o.w = pk2(s[6 * 33], s[7 * 33]);
        *(u32x4*)(WT + (size_t)(n0 + n) * K + k0 + 8 * c) = o; }
    asm volatile("s_waitcnt lgkmcnt(0)" ::: "memory");
}
__device__ __forceinline__ void cvt_row(const float* xrow, bf16_t* orow, float* ssq_out, int lane) {
    const f32x4* xr = (const f32x4*)xrow + lane;
    f32x4 v[4]; float s = 0.f;
#pragma unroll
    for (int j = 0; j < 4; ++j) { v[j] = xr[64 * j]; s += (v[j].x * v[j].x + v[j].y * v[j].y) + (v[j].z * v[j].z + v[j].w * v[j].w); }
    unsigned long long* o8 = (unsigned long long*)orow + lane;
#pragma unroll
    for (int j = 0; j < 4; ++j) o8[64 * j] = (unsigned long long)pk2(v[j].x, v[j].y) | ((unsigned long long)pk2(v[j].z, v[j].w) << 32);
    s = wave_sum(s);
    if (lane == 0) *ssq_out = s;
}

__device__ __forceinline__ void cvt_row2(const float* xrow, bf16_t* orow, float* ssq_out, size_t rstride, int lane) {
    f32x4 v[2][4];
#pragma unroll
    for (int t = 0; t < 2; ++t)
#pragma unroll
        for (int j = 0; j < 4; ++j) v[t][j] = __builtin_nontemporal_load((const f32x4*)(xrow + t * rstride * DM) + lane + 64 * j);
#pragma unroll
    for (int t = 0; t < 2; ++t) { float s = 0.f;
        unsigned long long* o8 = (unsigned long long*)(orow + t * rstride * DM) + lane;
#pragma unroll
        for (int j = 0; j < 4; ++j) { s += (v[t][j].x * v[t][j].x + v[t][j].y * v[t][j].y) + (v[t][j].z * v[t][j].z + v[t][j].w * v[t][j].w);
            o8[64 * j] = (unsigned long long)pk2(v[t][j].x, v[t][j].y) | ((unsigned long long)pk2(v[t][j].z, v[t][j].w) << 32); }
        s = wave_sum(s);
        if (lane == 0) ssq_out[t * rstride] = s; }
}

__device__ __forceinline__ float logsigmoid_fast(float x) { return fminf(x, 0.f) - __logf(1.0f + __expf(-fabsf(x))); }
constexpr int GL_BC = 0;
constexpr int GL_V = 64 * 132;
constexpr int GL_KH = GL_V + 64 * 264 / 2;
constexpr int GL_LR = GL_KH + 64 * 136 / 2;
constexpr int GL_TOT = GL_LR + 64 * 20;
constexpr int GL_END = GL_TOT + 512;
static_assert(GL_END * 4 <= 140 * 1024, "GLA LDS");

__device__ __forceinline__ void gla_kv_item(const Frame& F, const LayerP& P, int it) {
    LAS float* S = (LAS float*)F.lds; LAS float* bcS = S + GL_BC; LAS bf16_t* vS = (LAS bf16_t*)(S + GL_V); LAS bf16_t* khS = (LAS bf16_t*)(S + GL_KH); LAS float* lrS = S + GL_LR; LAS float* totS = S + GL_TOT;
    const int m0 = it * 64, tid = F.tid, lane = F.lane;
    unsigned lrv; { const int idx = tid * 2, row = idx >> 4, c = idx & 15; lrv = *(const unsigned*)(F.Z + (size_t)(m0 + row) * NZP + C_LR + c); }
    const int cc = tid & 127, jg = tid >> 7;
    float wv[16];
#pragma unroll
    for (int r = 0; r < 16; ++r) wv[r] = P.gate_w[r * 128 + cc];
    const float bias = P.gate_b[cc];
    u32x4 qx[2], kx[2], vx[4];
#pragma unroll
    for (int i = 0; i < 2; ++i) { const int q = tid + 512 * i, j = q >> 4, c8 = q & 15; const bf16_t* zr = F.Z + (size_t)(m0 + j) * NZP + 8 * c8;
        qx[i] = *(const u32x4*)(zr + C_QD); kx[i] = *(const u32x4*)(zr + C_KD); }
#pragma unroll
    for (int i = 0; i < 4; ++i) { const int q = tid + 512 * i, j = q >> 5, c8 = q & 31; vx[i] = *(const u32x4*)(F.Z + (size_t)(m0 + j) * NZP + C_VD + 8 * c8); }
    __syncthreads();
    { const int idx = tid * 2, row = idx >> 4, c = idx & 15; lrS[row * 20 + c] = bf2f(lrv & 0xffffu); lrS[row * 20 + c + 1] = bf2f(lrv >> 16); }
#pragma unroll
    for (int i = 0; i < 4; ++i) { const int q = tid + 512 * i, j = q >> 5, c8 = q & 31; *(LAS u32x4*)(vS + j * 264 + 8 * c8) = vx[i]; }
    __syncthreads();
    float loc[16]; float run = 0.f;
#pragma unroll
    for (int i = 0; i < 16; ++i) { const int j = jg * 16 + i; float x = bias;
#pragma unroll
        for (int r4 = 0; r4 < 4; ++r4) { const f32x4 lv = *(const LAS f32x4*)(lrS + j * 20 + 4 * r4);
            x += lv.x * wv[4 * r4] + lv.y * wv[4 * r4 + 1] + lv.z * wv[4 * r4 + 2] + lv.w * wv[4 * r4 + 3]; }
        run += logsigmoid_fast(x) * (1.0f / 16.0f); loc[i] = run; }
    totS[jg * 128 + cc] = run;
    __syncthreads();
    float off = 0.f;
    for (int gg = 0; gg < jg; ++gg) off += totS[gg * 128 + cc];
#pragma unroll
    for (int i = 0; i < 16; ++i) bcS[(jg * 16 + i) * 132 + cc] = off + loc[i];
    __syncthreads();
    float eb[2][8];
#pragma unroll
    for (int i = 0; i < 2; ++i) { const int c8 = (tid + 512 * i) & 15;
#pragma unroll
        for (int e = 0; e < 8; ++e) eb[i][e] = __expf(bcS[63 * 132 + 8 * c8 + e]); }
    if (tid < 128) F.BL[(size_t)it * 128 + tid] = bcS[63 * 132 + tid];
    __syncthreads();
#pragma unroll
    for (int i = 0; i < 2; ++i) { const int q = tid + 512 * i, j = q >> 4, c8 = q & 15; float xq[8], xk[8], yq[8], yk[8]; unpack8(qx[i], xq); unpack8(kx[i], xk);
        const f32x4 b0 = *(const LAS f32x4*)(bcS + j * 132 + 8 * c8), b1 = *(const LAS f32x4*)(bcS + j * 132 + 8 * c8 + 4);
        const float bcv[8] = {b0.x, b0.y, b0.z, b0.w, b1.x, b1.y, b1.z, b1.w}; float kh[8];
#pragma unroll
        for (int e = 0; e < 8; ++e) { const float e1 = __expf(bcv[e]), e2 = __builtin_amdgcn_rcpf(e1);
            yq[e] = xq[e] * 0.17677669529663687f * e1; yk[e] = xk[e] * e2;
            kh[e] = xk[e] * (eb[i][e] * e2); }
        { u32x4 kw; kw.x = pk2(kh[0], kh[1]); kw.y = pk2(kh[2], kh[3]); kw.z = pk2(kh[4], kh[5]); kw.w = pk2(kh[6], kh[7]); *(LAS u32x4*)(khS + j * 136 + 8 * c8) = kw; }
        bf16_t* zr = F.Z + (size_t)(m0 + j) * NZP + 8 * c8;
        u32x4 o; o.x = pk2(yq[0], yq[1]); o.y = pk2(yq[2], yq[3]); o.z = pk2(yq[4], yq[5]); o.w = pk2(yq[6], yq[7]); *(u32x4*)(zr + C_QD) = o;
        o.x = pk2(yk[0], yk[1]); o.y = pk2(yk[2], yk[3]); o.z = pk2(yk[4], yk[5]); o.w = pk2(yk[6], yk[7]); *(u32x4*)(zr + C_KD) = o; }
    __syncthreads();
    const int h = F.wave >> 1, vh = F.wave & 1;
    f32x16 acc;
#pragma unroll
    for (int r = 0; r < 16; ++r) acc[r] = 0.f;
    { const int hf = lane >> 5, i15 = lane & 15, g1 = (lane >> 4) & 1;
      const LAS bf16_t* ka = khS + (8 * hf + (i15 >> 2)) * 136 + h * 32 + 16 * g1 + 4 * (i15 & 3);
      const LAS bf16_t* va = vS + (8 * hf + (i15 >> 2)) * 264 + h * 64 + 32 * vh + 16 * g1 + 4 * (i15 & 3);
#pragma unroll
      for (int s = 0; s < 4; ++s) {
          const v4i16_t a0 = __builtin_amdgcn_ds_read_tr16_b64_v4i16((LAS v4i16_t*)(ka + (16 * s) * 136)), a1 = __builtin_amdgcn_ds_read_tr16_b64_v4i16((LAS v4i16_t*)(ka + (16 * s + 4) * 136));
          const v4i16_t b0 = __builtin_amdgcn_ds_read_tr16_b64_v4i16((LAS v4i16_t*)(va + (16 * s) * 264)), b1 = __builtin_amdgcn_ds_read_tr16_b64_v4i16((LAS v4i16_t*)(va + (16 * s + 4) * 264));
          acc = __builtin_amdgcn_mfma_f32_32x32x16_bf16((bf16x8){a0[0], a0[1], a0[2], a0[3], a1[0], a1[1], a1[2], a1[3]}, (bf16x8){b0[0], b0[1], b0[2], b0[3], b1[0], b1[1], b1[2], b1[3]}, acc, 0, 0, 0); } }
    float* kvp = F.KV + ((size_t)it * 4 + h) * 2048;
#pragma unroll
    for (int r = 0; r < 16; ++r) { const int d = crow(r, lane >> 5); kvp[d * 64 + 32 * vh + (lane & 31)] = acc[r]; }
}

constexpr int GO_Q = 0;
constexpr int GO_K = 64 * 136 * 2;
constexpr int GO_VT = 2 * 64 * 136 * 2;
constexpr int GO_OUT = GO_VT + 256 * 72 * 2;
static_assert(GO_OUT + 64 * 260 * 4 <= 140 * 1024, "GLA out LDS");
__device__ __forceinline__ void gla_out_item(const Frame& F, const LayerP& P, int it) {
    LAS bf16_t* QtS = (LAS bf16_t*)(F.lds + GO_Q); LAS bf16_t* KtS = (LAS bf16_t*)(F.lds + GO_K); LAS bf16_t* VT = (LAS bf16_t*)(F.lds + GO_VT); LAS float* oS = (LAS float*)(F.lds + GO_OUT);
    const int m0 = it * 64, tid = F.tid, lane = F.lane, hf = lane >> 5, l31 = lane & 31;
    const int h = F.wave >> 1, ih = F.wave & 1;
    u32x4 qx[2], kx[2], vx[4], gx[4];
#pragma unroll
    for (int i = 0; i < 2; ++i) { const int q = tid + 512 * i, j = q >> 4, c8 = q & 15; const bf16_t* zr = F.Z + (size_t)(m0 + j) * NZP + 8 * c8;
        qx[i] = *(const u32x4*)(zr + C_QD); kx[i] = *(const u32x4*)(zr + C_KD); }
#pragma unroll
    for (int i = 0; i < 4; ++i) { const int q = tid + 512 * i, j = q >> 5, c8 = q & 31; vx[i] = *(const u32x4*)(F.Z + (size_t)(m0 + j) * NZP + C_VD + 8 * c8); }
#pragma unroll
    for (int i = 0; i < 4; ++i) { const int q = tid + 512 * i, j = q >> 5, c8 = q & 31; gx[i] = *(const u32x4*)(F.Z + (size_t)(m0 + j) * NZP + C_GD + 8 * c8); }
    float sta[2][2][8];
    { const float* st = F.KV + ((size_t)it * 4 + h) * 2048;
#pragma unroll
      for (int vt = 0; vt < 2; ++vt)
#pragma unroll
          for (int s = 0; s < 2; ++s)
#pragma unroll
              for (int jj = 0; jj < 8; ++jj) sta[vt][s][jj] = st[(16 * s + 8 * hf + jj) * 64 + 32 * vt + l31]; }
    float gn[2][16];
#pragma unroll
    for (int vt = 0; vt < 2; ++vt)
#pragma unroll
        for (int r = 0; r < 16; ++r) gn[vt][r] = P.gla_g[32 * vt + crow(r, hf)];
    __syncthreads();
#pragma unroll
    for (int i = 0; i < 2; ++i) { const int q = tid + 512 * i, j = q >> 4, c8 = q & 15;
        *(LAS u32x4*)(QtS + j * 136 + 8 * c8) = qx[i]; *(LAS u32x4*)(KtS + j * 136 + 8 * c8) = kx[i]; }
#pragma unroll
    for (int i = 0; i < 4; ++i) { const int q = tid + 512 * i, j = q >> 5, c8 = q & 31; *(LAS u32x4*)(VT + j * 264 + 8 * c8) = vx[i]; }
    __syncthreads();
    bf16x8 qB[2];
#pragma unroll
    for (int s = 0; s < 2; ++s) qB[s] = *(const LAS bf16x8*)(QtS + (32 * ih + l31) * 136 + h * 32 + 16 * s + 8 * hf);
    f32x16 aT[2];
#pragma unroll
    for (int jt = 0; jt < 2; ++jt) {
#pragma unroll
        for (int r = 0; r < 16; ++r) aT[jt][r] = 0.f;
        if (jt <= ih) {
#pragma unroll
            for (int s = 0; s < 2; ++s) { const bf16x8 a = *(const LAS bf16x8*)(KtS + (32 * jt + l31) * 136 + h * 32 + 16 * s + 8 * hf);
                aT[jt] = __builtin_amdgcn_mfma_f32_32x32x16_bf16(a, qB[s], aT[jt], 0, 0, 0); }
#pragma unroll
            for (int r = 0; r < 16; ++r) { const int j = 32 * jt + crow(r, hf), i = 32 * ih + l31; if (j > i) aT[jt][r] = 0.f; }
        }
    }
    f32x16 oT[2];
#pragma unroll
    for (int vt = 0; vt < 2; ++vt) {
#pragma unroll
        for (int r = 0; r < 16; ++r) oT[vt][r] = 0.f;
#pragma unroll
        for (int s = 0; s < 2; ++s) { u32x4 sw; sw.x = cvtpk_(sta[vt][s][0], sta[vt][s][1]); sw.y = cvtpk_(sta[vt][s][2], sta[vt][s][3]); sw.z = cvtpk_(sta[vt][s][4], sta[vt][s][5]); sw.w = cvtpk_(sta[vt][s][6], sta[vt][s][7]);
            oT[vt] = __builtin_amdgcn_mfma_f32_32x32x16_bf16(__builtin_bit_cast(bf16x8, sw), qB[s], oT[vt], 0, 0, 0); }
#pragma unroll
        for (int jt = 0; jt < 2; ++jt) {
            if (jt <= ih) {
#pragma unroll
                for (int s = 0; s < 2; ++s) {
                    u32x4 pw; pw.x = cvtpk_(aT[jt][8 * s + 0], aT[jt][8 * s + 1]); pw.y = cvtpk_(aT[jt][8 * s + 2], aT[jt][8 * s + 3]); pw.z = cvtpk_(aT[jt][8 * s + 4], aT[jt][8 * s + 5]); pw.w = cvtpk_(aT[jt][8 * s + 6], aT[jt][8 * s + 7]);
                    oT[vt] = __builtin_amdgcn_mfma_f32_32x32x16_bf16(frag_tr_perm(VT, 264, 32 * jt + 16 * s, h * 64 + 32 * vt, lane), __builtin_bit_cast(bf16x8, pw), oT[vt], 0, 0, 0); }
            }
        }
    }
    float ss = 0.f;
#pragma unroll
    for (int vt = 0; vt < 2; ++vt)
#pragma unroll
        for (int r = 0; r < 16; ++r) ss += oT[vt][r] * oT[vt][r];
    ss = xor32_sum(ss);
    const float rinv = __builtin_amdgcn_rsqf(ss * (1.0f / 64.0f) + EPS);
#pragma unroll
    for (int vt = 0; vt < 2; ++vt)
#pragma unroll
        for (int r = 0; r < 16; ++r) oS[(32 * ih + l31) * 260 + h * 64 + 32 * vt + crow(r, hf)] = (oT[vt][r] * rinv) * gn[vt][r];
    __syncthreads();
#pragma unroll
    for (int i = 0; i < 4; ++i) { const int q = tid + 512 * i, j = q >> 5, c8 = q & 31; float gg[8]; unpack8(gx[i], gg); float y[8];
        const f32x4 t0 = *(const LAS f32x4*)(oS + j * 260 + 8 * c8), t1 = *(const LAS f32x4*)(oS + j * 260 + 8 * c8 + 4); const float tv[8] = {t0.x, t0.y, t0.z, t0.w, t1.x, t1.y, t1.z, t1.w};
#pragma unroll
        for (int e = 0; e < 8; ++e) y[e] = tv[e] * siluf_(gg[e]);
        u32x4 o; o.x = pk2(y[0], y[1]); o.y = pk2(y[2], y[3]); o.z = pk2(y[4], y[5]); o.w = pk2(y[6], y[7]);
        *(u32x4*)(F.CC + (size_t)(m0 + j) * DM + 768 + 8 * c8) = o; }
}

constexpr int CV_U = 0;
constexpr int CV_A = 94 * 256 * 4;
static_assert(CV_A + 64 * 264 * 2 <= 140 * 1024, "conv LDS");
__device__ __forceinline__ void conv_item(const Frame& F, const LayerP& P, int it) {
    LAS float* uS = (LAS float*)F.lds; LAS bf16_t* aS = (LAS bf16_t*)(F.lds + CV_A);
    const int tid = F.tid, lane = F.lane, w = F.wave;
    const int b = it >> 7, t0 = (it & 127) * 64, m0 = it * 64;
    u32x4 ua[6], ug[6];
#pragma unroll
    for (int i = 0; i < 6; ++i) { const int q = tid + 512 * i, r = q >> 5, c8 = q & 31, tt = t0 - 30 + r;
        ua[i] = (u32x4){0u, 0u, 0u, 0u}; ug[i] = (u32x4){0u, 0u, 0u, 0u};
        if (q < 94 * 32 && tt >= 0) { const bf16_t* zr = F.Z + (size_t)(b * SEQ + tt) * NZP + 8 * c8; ua[i] = *(const u32x4*)(zr + C_CA); ug[i] = *(const u32x4*)(zr + C_CG); } }
    typedef float f32x2v __attribute__((ext_vector_type(2)));
    const int cp = tid & 127, tq = tid >> 7;

    __syncthreads();
#pragma unroll
    for (int i = 0; i < 6; ++i) { const int q = tid + 512 * i, r = q >> 5, c8 = q & 31;
        if (q < 94 * 32) { float xa[8], xg[8]; unpack8(ua[i], xa); unpack8(ug[i], xg);
#pragma unroll
            for (int e = 0; e < 8; ++e) xa[e] = xa[e] * sigmoidf_(xg[e]);
            *(LAS f32x4*)(uS + r * 256 + 8 * c8) = (f32x4){xa[0], xa[1], xa[2], xa[3]}; *(LAS f32x4*)(uS + r * 256 + 8 * c8 + 4) = (f32x4){xa[4], xa[5], xa[6], xa[7]}; } }
    __syncthreads();
    {
        f32x2v wk[31];
#pragma unroll
        for (int k = 0; k < 31; ++k) wk[k] = *(const f32x2v*)(P.conv_w + k * 256 + 2 * cp);
        const f32x2v cbias = *(const f32x2v*)(P.conv_b + 2 * cp);
#pragma nounroll
        for (int hh = 0; hh < 2; ++hh) { const int t0r = 16 * tq + 8 * hh;
            f32x2v u[38];
#pragma unroll
            for (int r = 0; r < 38; ++r) u[r] = *(const LAS f32x2v*)(uS + (t0r + r) * 256 + 2 * cp);
#pragma unroll
            for (int i = 0; i < 8; ++i) { f32x2v acc = wk[0] * u[i];
#pragma unroll
                for (int k = 1; k < 31; ++k) acc = __builtin_elementwise_fma(wk[k], u[i + k], acc);
                acc = acc + cbias;
                *(LAS unsigned*)(aS + (t0r + i) * 264 + 2 * cp) = pk2(acc.x, acc.y); } }
    }
    asm volatile("" ::: "memory"); __builtin_amdgcn_sched_barrier(0);
    const int n0 = 32 * w, fr = lane & 15, fq = lane >> 4;
    bf16x8 bfr[8][2];
#pragma unroll
    for (int ks = 0; ks < 8; ++ks)
#pragma unroll
        for (int nt = 0; nt < 2; ++nt) bfr[ks][nt] = *(const bf16x8*)(P.WpwT + (size_t)(n0 + 16 * nt + fr) * 256 + 32 * ks + 8 * fq);
    u32x4 gx[4];
#pragma unroll
    for (int i = 0; i < 4; ++i) { const int q = tid + 512 * i, j = q >> 5, c8 = q & 31; gx[i] = *(const u32x4*)(F.Z + (size_t)(m0 + j) * NZP + C_GC + 8 * c8); }
    float lg[4], lb[4];
#pragma unroll
    for (int j = 0; j < 4; ++j) { lg[j] = P.ln_g[lane + 64 * j]; lb[j] = P.ln_b[lane + 64 * j]; }
    __syncthreads();
#pragma unroll 2
    for (int i = 0; i < 8; ++i) { const int row = 8 * w + i;
        float x[4]; float s = 0.f;
#pragma unroll
        for (int j = 0; j < 4; ++j) { x[j] = bf2f(aS[row * 264 + lane + 64 * j]); s += x[j]; }
        const float mean = wave_sum(s) * (1.0f / 256.0f); float s2 = 0.f;
#pragma unroll
        for (int j = 0; j < 4; ++j) { x[j] -= mean; s2 += x[j] * x[j]; }
        const float rstd = __builtin_amdgcn_rsqf(wave_sum(s2) * (1.0f / 256.0f) + EPS);
#pragma unroll
        for (int j = 0; j < 4; ++j) { const float un = (x[j] * rstd) * lg[j] + lb[j];
            aS[row * 264 + lane + 64 * j] = (bf16_t)f2bf(siluf_(un)); } }
    __syncthreads();
    f32x4 acc[4][2];
#pragma unroll
    for (int m = 0; m < 4; ++m)
#pragma unroll
        for (int nt = 0; nt < 2; ++nt) acc[m][nt] = (f32x4){0.f, 0.f, 0.f, 0.f};
#pragma unroll
    for (int ks = 0; ks < 8; ++ks) {
#pragma unroll
        for (int m = 0; m < 4; ++m) { const bf16x8 af = *(const LAS bf16x8*)(aS + (16 * m + fr) * 264 + 32 * ks + 8 * fq);
#pragma unroll
            for (int nt = 0; nt < 2; ++nt) acc[m][nt] = __builtin_amdgcn_mfma_f32_16x16x32_bf16(af, bfr[ks][nt], acc[m][nt], 0, 0, 0); } }
#pragma unroll
    for (int m = 0; m < 4; ++m)
#pragma unroll
        for (int nt = 0; nt < 2; ++nt) { const int col = n0 + 16 * nt + fr; const float pb = P.pw_b[col];
#pragma unroll
            for (int r = 0; r < 4; ++r) uS[(16 * m + 4 * fq + r) * 260 + col] = acc[m][nt][r] + pb; }
    __syncthreads();
#pragma unroll
    for (int i = 0; i < 4; ++i) { const int q = tid + 512 * i, j = q >> 5, c8 = q & 31; float gg[8]; unpack8(gx[i], gg); float y[8];
        const f32x4 t0 = *(const LAS f32x4*)(uS + j * 260 + 8 * c8), t1 = *(const LAS f32x4*)(uS + j * 260 + 8 * c8 + 4); const float tv[8] = {t0.x, t0.y, t0.z, t0.w, t1.x, t1.y, t1.z, t1.w};
#pragma unroll
        for (int e = 0; e < 8; ++e) y[e] = tv[e] * siluf_(gg[e]);
        u32x4 o; o.x = pk2(y[0], y[1]); o.y = pk2(y[2], y[3]); o.z = pk2(y[4], y[5]); o.w = pk2(y[6], y[7]);
        *(u32x4*)(F.CC + (size_t)(m0 + j) * DM + 512 + 8 * c8) = o; }
}

typedef float f32x2_t __attribute__((ext_vector_type(2))); typedef __bf16 bf16x2_t __attribute__((ext_vector_type(2)));
__device__ __forceinline__ unsigned cvtpk(float lo, float hi) { f32x2_t v = {lo, hi}; bf16x2_t b = __builtin_convertvector(v, bf16x2_t); return __builtin_bit_cast(unsigned, b); }

struct AttnState { float m, l; f32x16 oT[2]; };
__device__ __forceinline__ void attn_init(AttnState& st, float ref) {
    st.m = ref; st.l = 0.f;
#pragma unroll
    for (int d0 = 0; d0 < 2; ++d0)
#pragma unroll
        for (int r = 0; r < 16; ++r) st.oT[d0][r] = 0.f;
}
__device__ __forceinline__ bf16x8 v_frag_tr(const LAS bf16_t* Vs, int kb, int d0, int lane) {
    const int hf = lane >> 5, i = lane & 15;
    const LAS bf16_t* a = Vs + (kb + 4 * hf + (i >> 2)) * 72 + 32 * d0 + 16 * ((lane >> 4) & 1) + 4 * (i & 3);
    const v4i16_t lo = __builtin_amdgcn_ds_read_tr16_b64_v4i16((LAS v4i16_t*)a);
    const v4i16_t hi = __builtin_amdgcn_ds_read_tr16_b64_v4i16((LAS v4i16_t*)(a + 8 * 72));
    return (bf16x8){lo[0], lo[1], lo[2], lo[3], hi[0], hi[1], hi[2], hi[3]};
}
__device__ __forceinline__ f32x16 attn_qk(const LAS bf16_t* Ks, int krow0, const bf16x8 (&qf)[4], const f32x16& cb, int l31, int hf) {
    f32x16 p = cb;
    bf16x8 a[4];
#pragma unroll
    for (int d0 = 0; d0 < 4; ++d0) a[d0] = *(const LAS bf16x8*)(Ks + (krow0 + l31) * 72 + 16 * d0 + 8 * hf);
    __builtin_amdgcn_s_setprio(1);
#pragma unroll
    for (int d0 = 0; d0 < 4; ++d0) p = __builtin_amdgcn_mfma_f32_32x32x16_bf16(a[d0], qf[d0], p, 0, 0, 0);
    __builtin_amdgcn_s_setprio(0);
    return p;
}
__device__ __forceinline__ float xhalf_sum(float v) { const auto rr = __builtin_amdgcn_permlane32_swap(__float_as_uint(v), __float_as_uint(v), false, false); return __uint_as_float(rr[0]) + __uint_as_float(rr[1]); }
template <bool MASKED>
__device__ __forceinline__ void attn_exp_pv(AttnState& st, f32x16& p, const bf16x8 (&vf)[2][2], float coff, int sgn, int dxs, float& ls) {
    const float c = coff - st.m;
#pragma unroll
    for (int r = 0; r < 16; ++r) p[r] = ex2(p[r] + c);
    if (MASKED) {
#pragma unroll
        for (int r = 0; r < 16; ++r) { const int thr = -sgn * ((r & 3) + 8 * (r >> 2)); p[r] = (dxs > thr) ? 0.f : p[r]; }
    }
#pragma unroll
    for (int r = 0; r < 16; ++r) ls += p[r];
#pragma unroll
    for (int s = 0; s < 2; ++s) {
        u32x4 pw; pw.x = cvtpk(p[8 * s + 0], p[8 * s + 1]); pw.y = cvtpk(p[8 * s + 2], p[8 * s + 3]); pw.z = cvtpk(p[8 * s + 4], p[8 * s + 5]); pw.w = cvtpk(p[8 * s + 6], p[8 * s + 7]);
        const bf16x8 pb = __builtin_bit_cast(bf16x8, pw);
#pragma unroll
        for (int d0 = 0; d0 < 2; ++d0) st.oT[d0] = __builtin_amdgcn_mfma_f32_32x32x16_bf16(vf[s][d0], pb, st.oT[d0], 0, 0, 0);
    }
}
__device__ __forceinline__ void attn_vfrags(bf16x8 (&vf)[2][2], const LAS bf16_t* Vt, int kk0, int lane) {
#pragma unroll
    for (int s = 0; s < 2; ++s)
#pragma unroll
        for (int d0 = 0; d0 < 2; ++d0) vf[s][d0] = v_frag_tr(Vt, kk0 + 16 * s, d0, lane);
}
struct TileP { int kk0; float coff; };
__device__ __forceinline__ void attn_pair(AttnState& st, const LAS bf16_t* Ks, const LAS bf16_t* Vt, const bf16x8 (&qf)[4], const f32x16& cb, const TileP A, const TileP B, int l31, int hf) {
    bf16x8 ka[4], kb[4], va[2][2], vb[2][2];
#pragma unroll
    for (int d0 = 0; d0 < 4; ++d0) { ka[d0] = *(const LAS bf16x8*)(Ks + (A.kk0 + l31) * 72 + 16 * d0 + 8 * hf); kb[d0] = *(const LAS bf16x8*)(Ks + (B.kk0 + l31) * 72 + 16 * d0 + 8 * hf); }
    attn_vfrags(va, Vt, A.kk0, 32 * hf + l31);
    __builtin_amdgcn_sched_barrier(0);
    f32x16 pA = cb, pB = cb;
    __builtin_amdgcn_s_setprio(1);
#pragma unroll
    for (int d0 = 0; d0 < 4; ++d0) { pA = __builtin_amdgcn_mfma_f32_32x32x16_bf16(ka[d0], qf[d0], pA, 0, 0, 0); pB = __builtin_amdgcn_mfma_f32_32x32x16_bf16(kb[d0], qf[d0], pB, 0, 0, 0); }
    __builtin_amdgcn_s_setprio(0);
    __builtin_amdgcn_sched_barrier(0);
    attn_vfrags(vb, Vt, B.kk0, 32 * hf + l31);
    __builtin_amdgcn_sched_barrier(0);
    float ls = 0.f;
    attn_exp_pv<false>(st, pA, va, A.coff, 0, 0, ls);
    attn_exp_pv<false>(st, pB, vb, B.coff, 0, 0, ls);
    st.l += ls;
}
template <bool MASKED>
__device__ __forceinline__ void attn_single(AttnState& st, const LAS bf16_t* Ks, const LAS bf16_t* Vt, const bf16x8 (&qf)[4], const f32x16& cb, const TileP T, int sgn, int dxs, int l31, int hf) {
    bf16x8 ka[4], va[2][2];
#pragma unroll
    for (int d0 = 0; d0 < 4; ++d0) ka[d0] = *(const LAS bf16x8*)(Ks + (T.kk0 + l31) * 72 + 16 * d0 + 8 * hf);
    attn_vfrags(va, Vt, T.kk0, 32 * hf + l31);
    __builtin_amdgcn_sched_barrier(0);
    f32x16 pc = cb;
    __builtin_amdgcn_s_setprio(1);
#pragma unroll
    for (int d0 = 0; d0 < 4; ++d0) pc = __builtin_amdgcn_mfma_f32_32x32x16_bf16(ka[d0], qf[d0], pc, 0, 0, 0);
    __builtin_amdgcn_s_setprio(0);
    float ls = 0.f;
    attn_exp_pv<MASKED>(st, pc, va, T.coff, sgn, dxs, ls);
    st.l += ls;
}
__device__ __forceinline__ void attn_store_row(const AttnState& st, float scale, bf16_t* dst, int hf) {
#pragma unroll
    for (int d0 = 0; d0 < 2; ++d0)
#pragma unroll
        for (int g = 0; g < 4; ++g) { u32x2 w; w.x = pk2(st.oT[d0][4 * g] * scale, st.oT[d0][4 * g + 1] * scale); w.y = pk2(st.oT[d0][4 * g + 2] * scale, st.oT[d0][4 * g + 3] * scale);
            *(u32x2*)(dst + 32 * d0 + 8 * g + 4 * hf) = w; }
}

constexpr int MB_KS = 0;
constexpr int MB_VT = 256 * 72 * 2;
constexpr int MB_KM = MB_VT + 64 * 260 * 2;
constexpr int MB_VP = 260;
constexpr int DL_KS = 0;
constexpr int DL_VT = 384 * 72 * 2;
constexpr int DL_VP = 388;
constexpr int AT_PREF = 120 * 1024;
static_assert(DL_VT + 64 * 388 * 2 <= AT_PREF && MB_KM + 32 * 64 * 4 <= AT_PREF, "attention LDS");
constexpr int LIST_CAP = 8192;

__device__ __forceinline__ void moba_topk_unit(const Frame& F, const LayerP& P, int b, int h, int qb, unsigned* cnt  , unsigned* list  ) {
    LAS float* kmS = (LAS float*)(F.lds + MB_KM);
    const int tid = F.tid, lane = F.lane, w = F.wave, l31 = lane & 31, hf = lane >> 5, bh = b * 4 + h;
    __syncthreads();
    for (int q = tid; q < qb * 64; q += 512) { const int n = q >> 6, d = q & 63;
        kmS[q] = __hip_atomic_load(F.KMP + ((size_t)(b * 32 + n)) * 256 + h * 64 + d, __ATOMIC_RELAXED, __HIP_MEMORY_SCOPE_AGENT) * (1.0f / 256.0f); }
    const int qpos = qb * 256 + 32 * w + l31;
    const size_t grow = (size_t)b * SEQ + qpos;
    float qv[32];
#pragma unroll
    for (int d0 = 0; d0 < 4; ++d0) { const u32x4 a = *(const u32x4*)(F.Z + grow * NZP + C_QA + h * 64 + 16 * d0 + 8 * hf);
#pragma unroll
        for (int k = 0; k < 4; ++k) { qv[d0 * 8 + 2 * k] = bf2f(a[k] & 0xffffu); qv[d0 * 8 + 2 * k + 1] = bf2f(a[k] >> 16); } }
    __syncthreads();
    float v0 = -INFINITY, v1 = -INFINITY, v2 = -INFINITY; int i0 = -1, i1 = -1, i2 = -1;
    for (int n = 0; n < qb; ++n) { float g = 0.f;
#pragma unroll
        for (int d0 = 0; d0 < 4; ++d0) { const f32x4 k0 = *(const LAS f32x4*)(kmS + n * 64 + 16 * d0 + 8 * hf), k1 = *(const LAS f32x4*)(kmS + n * 64 + 16 * d0 + 8 * hf + 4);
            g += qv[d0 * 8 + 0] * k0.x + qv[d0 * 8 + 1] * k0.y + qv[d0 * 8 + 2] * k0.z + qv[d0 * 8 + 3] * k0.w + qv[d0 * 8 + 4] * k1.x + qv[d0 * 8 + 5] * k1.y + qv[d0 * 8 + 6] * k1.z + qv[d0 * 8 + 7] * k1.w; }
        g = xor32_sum(g);
        if (g > v0) { v2 = v1; i2 = i1; v1 = v0; i1 = i0; v0 = g; i0 = n; }
        else if (g > v1) { v2 = v1; i2 = i1; v1 = g; i1 = n; }
        else if (g > v2) { v2 = g; i2 = n; } }
    float gq = fabsf(P.qga[lane]), gk = fabsf(P.kga[lane]);
    gq = wave64_max(gq); gk = wave64_max(gk);
    const float B2 = 2.04f * 64.0f * gq * gk * QSCALE, slope2 = exp2f(-(float)(2 * h + 1)) * LOG2E;
    const bool z0 = i0 >= 0 && (B2 - slope2 * (float)(qpos - 256 * i0 - 255)) < -152.0f;
    const bool z1 = i1 >= 0 && (B2 - slope2 * (float)(qpos - 256 * i1 - 255)) < -152.0f;
    const bool z2 = i2 >= 0 && (B2 - slope2 * (float)(qpos - 256 * i2 - 255)) < -152.0f;
    if (z0) i0 = -1;
    if (z1) i1 = -1;
    if (z2) i2 = -1;
    unsigned mymask = 0u;
    for (int n = 0; n < qb; ++n) {
        const unsigned long long mask = __ballot(hf == 0 && (n == i0 || n == i1 || n == i2));
        if (lane == n) mymask = (unsigned)mask;
    }
    unsigned mybase = 0u;
    if (mymask != 0u) mybase = atomicAdd(cnt + bh * 32 + lane, (unsigned)__popc(mymask));
    {
        const unsigned below = (1u << l31) - 1u;
        const int sel[3] = {i0, i1, i2};
#pragma unroll
        for (int k = 0; k < 3; ++k) {
            const int n = sel[k] < 0 ? 0 : sel[k];
            const unsigned mk = (unsigned)__shfl((int)mymask, n), bs = (unsigned)__shfl((int)mybase, n);
            if (hf == 0 && sel[k] >= 0) { const int pos = (int)bs + __popc(mk & below);
                if (pos < LIST_CAP) list[((size_t)bh * 32 + n) * LIST_CAP + pos] = ((unsigned)qpos << 2) | (unsigned)k; }
        }
    }
    if (hf == 0) { float* ps = F.PS + grow * (NZP / 2) + h * 8;
        float ninf = -1e30f, zer = 0.f; asm volatile("" : "+v"(ninf), "+v"(zer));
        if (i0 < 0) { ps[0] = ninf; ps[1] = zer; }
        if (i1 < 0) { ps[2] = ninf; ps[3] = zer; }
        if (i2 < 0) { ps[4] = ninf; ps[5] = zer; } }
}

constexpr int AT_KS = 0, AT_VT = 384 * 72 * 2, AT_VP = 72;
struct AttDesc {
    int kind;
    int b, h, n, tile, cnt, pr;
    int pat, dil, g, u;
    int nrows, first_valid; long long row0, rstride;
    int kcol, vcol;
};
__device__ __forceinline__ AttDesc att_decode(int j, int total, const LAS int* pref, const unsigned* cnt) {
    AttDesc D; D.kind = 0; D.b = 0; D.h = 0; D.n = 0; D.tile = 0; D.cnt = 0; D.pr = 0; D.pat = 0; D.dil = 1; D.g = 0; D.u = 0;
    if (j < total + 256) {
        int pr, tile;
        if (j < total) { int lo = 0, hi = 255;
            while (lo < hi) { const int mid = (lo + hi + 1) >> 1; if (pref[mid] <= j) lo = mid; else hi = mid - 1; }
            pr = lo; tile = j - pref[pr] + 1; D.kind = 0;
        } else { const int u = j - total; pr = (u & 7) * 32 + (u >> 3); tile = 0; D.kind = 1; }
        D.cnt = pref[272 + pr];
        D.pr = pr; D.tile = tile; D.b = pr >> 7; D.h = (pr >> 5) & 3; D.n = pr & 31;
        D.nrows = 256; D.first_valid = 0; D.row0 = (long long)D.b * SEQ + D.n * 256; D.rstride = 1; D.kcol = C_KA + D.h * 64; D.vcol = C_VA + D.h * 64;
    } else {
        const int q = j - total - 256; D.kind = 2; D.pat = q >> 8; const int r = q & 255; D.b = (r >> 2) & 1; D.h = r & 3; const int uidx = r >> 3;
        D.dil = (D.pat == 0) ? 1 : (D.pat == 1 ? 4 : 16);
        const int upg = 32 / D.dil; D.g = uidx / upg; D.u = uidx % upg;
        const int i0 = 256 * D.u - 128;
        D.nrows = 384; D.first_valid = (i0 < 0) ? 128 : 0; D.row0 = (long long)D.b * SEQ + (long long)i0 * D.dil + D.g; D.rstride = D.dil; D.kcol = C_KB + D.h * 64; D.vcol = C_VB + D.h * 64;
    }
    return D;
}
struct StageRegs { u32x4 kx[2][2], vx[2][2]; };
__device__ __forceinline__ void att_stage_issue(StageRegs& R, int tid, const bf16_t* Z, const AttDesc& D) {
#pragma unroll
    for (int i = 0; i < 2; ++i) { const int q = tid + 512 * i, r = (q >> 3) * 2, c8 = q & 7;
#pragma unroll
        for (int e = 0; e < 2; ++e) { R.kx[i][e] = (u32x4){0u, 0u, 0u, 0u}; R.vx[i][e] = (u32x4){0u, 0u, 0u, 0u};
            if (r + e >= D.first_valid) { const bf16_t* zr = Z + (size_t)(D.row0 + (long long)(r + e) * D.rstride) * NZP + 8 * c8;
                R.kx[i][e] = *(const u32x4*)(zr + D.kcol); R.vx[i][e] = *(const u32x4*)(zr + D.vcol); } } }
}
__device__ __forceinline__ void att_stage_put(const u32x4 (&kx)[2], const u32x4 (&vx)[2], int r, int c8, LAS bf16_t* Ks, LAS bf16_t* Vt) {
    *(LAS u32x4*)(Ks + r * 72 + 8 * c8) = kx[0]; *(LAS u32x4*)(Ks + (r + 1) * 72 + 8 * c8) = kx[1];
    *(LAS u32x4*)(Vt + r * 72 + 8 * c8) = vx[0]; *(LAS u32x4*)(Vt + (r + 1) * 72 + 8 * c8) = vx[1];
}
struct StageTail { u32x4 k3[2], v3[2]; };
__device__ __forceinline__ void att_stage_tail_issue(StageTail& T3, int tid, const bf16_t* Z, const AttDesc& D) {
    const int q3 = tid + 1024, r3 = (q3 >> 3) * 2, c83 = q3 & 7;
#pragma unroll
    for (int e = 0; e < 2; ++e) { T3.k3[e] = (u32x4){0u, 0u, 0u, 0u}; T3.v3[e] = (u32x4){0u, 0u, 0u, 0u};
        if (D.nrows > 256) { const bf16_t* zr = Z + (size_t)(D.row0 + (long long)(r3 + e) * D.rstride) * NZP + 8 * c83; T3.k3[e] = *(const u32x4*)(zr + D.kcol); T3.v3[e] = *(const u32x4*)(zr + D.vcol); } }
}
__device__ __forceinline__ void att_stage_write(const StageRegs& R, const StageTail& T3, int tid, const AttDesc& D, LAS bf16_t* Ks, LAS bf16_t* Vt) {
#pragma unroll
    for (int i = 0; i < 2; ++i) { const int q = tid + 512 * i, r = (q >> 3) * 2, c8 = q & 7; att_stage_put(R.kx[i], R.vx[i], r, c8, Ks, Vt); }
    if (D.nrows > 256) { const int q3 = tid + 1024, r3 = (q3 >> 3) * 2, c83 = q3 & 7; att_stage_put(T3.k3, T3.v3, r3, c83, Ks, Vt); }
}
__device__ __forceinline__ unsigned att_entry_issue(const AttDesc& D, const unsigned* LIST, int w, int l31) {
    if (D.kind == 2) return 0u;
    const int idx0 = D.tile * 256 + 32 * w;
    if (idx0 >= D.cnt) return 0u;
    const int idx = idx0 + l31;
    return LIST[(size_t)D.pr * LIST_CAP + (idx < D.cnt ? idx : idx0)];
}
__device__ __forceinline__ void att_compute(const Frame& F, const AttDesc& D, const int mode  , unsigned entry, const bf16x8 (&qf)[4], size_t grow, int qpos, float ref) {
    const LAS bf16_t* Ks = (const LAS bf16_t*)(F.lds + AT_KS); const LAS bf16_t* Vt = (const LAS bf16_t*)(F.lds + AT_VT);
    const int lane = F.lane, w = F.wave, l31 = lane & 31, hf = lane >> 5;
    const bool dilk = mode == 2, own = mode == 1;
    const int idx0 = D.tile * 256 + 32 * w;
    if (mode == 0 && idx0 >= D.cnt) return;
    const float slope2 = dilk ? exp2f(-(float)(2 * D.h + 2)) * LOG2E * (float)D.dil : exp2f(-(float)(2 * D.h + 1)) * LOG2E;
    f32x16 cb;
#pragma unroll
    for (int r = 0; r < 16; ++r) cb[r] = slope2 * (float)crow(r, hf);
    const int i0 = 256 * D.u - 128;
    AttnState st; attn_init(st, ref);
    int jmin = 0; if (dilk) { jmin = (-i0 - 32 * w + 31) >> 5; jmin = jmin < 0 ? 0 : jmin; }
    const int j1 = jmin > 1 ? jmin : 1;
    const int nun = dilk ? (4 - j1) : (own ? w : 8);
    auto tile_un = [&](int u) -> TileP { TileP T;
        if (dilk) { const int j = 3 - u; T.kk0 = 32 * w + 32 * j; T.coff = -slope2 * (float)(l31 + 128 - 32 * j); }
        else { T.kk0 = 32 * u; T.coff = slope2 * (float)(D.n * 256 + 32 * u - qpos); }
        return T; };
    int s = 0;
#pragma nounroll
    for (; s + 1 < nun; s += 2) attn_pair(st, Ks, Vt, qf, cb, tile_un(s), tile_un(s + 1), l31, hf);
    const int nmask = dilk ? (jmin == 0 ? 2 : 1) : (own ? 1 : 0);
    const int lfirst = (s < nun) ? 0 : 1;
#pragma nounroll
    for (int e = lfirst; e <= nmask; ++e) {
        TileP T; int sgn = 0;
        if (e == 0) T = tile_un(s);
        else if (dilk) { const int j = (e == 1) ? 4 : 0; T.kk0 = 32 * w + 32 * j; T.coff = -slope2 * (float)(l31 + 128 - 32 * j); sgn = (e == 1) ? 1 : -1; }
        else { T.kk0 = 32 * w; T.coff = slope2 * (float)(D.n * 256 + 32 * w - qpos); sgn = 1; }
        attn_single<true>(st, Ks, Vt, qf, cb, T, sgn, sgn == 0 ? -64 : sgn * (4 * hf - l31), l31, hf);
    }
    const float ltot = xhalf_sum(st.l);
    if (dilk) {
        attn_store_row(st, ltot > 0.f ? __builtin_amdgcn_rcpf(ltot) : 0.f, F.DOp + grow * NZP + D.pat * 256 + D.h * 64, hf);
        if (hf == 0) { float* sp = F.DST + (((size_t)D.pat * MTOK + grow) * 4 + D.h) * 2; sp[0] = st.m; sp[1] = ltot; }
    } else {
        const bool valid = own || (idx0 + l31 < D.cnt);
        const int slot = own ? 3 : (int)(entry & 3u);
        if (valid) {
            attn_store_row(st, ltot > 0.f ? __builtin_amdgcn_rcpf(ltot) : 0.f, F.PO + (((size_t)slot * MTOK + grow) * 4 + D.h) * 64, hf);
            if (hf == 0) { float* ps = F.PS + grow * (NZP / 2) + D.h * 8 + slot * 2; ps[0] = st.m; ps[1] = ltot; } }
    }
}
__device__ __forceinline__ void att_phase(const Frame& F, const LayerP& P, const unsigned* cnt, unsigned* dctr  ) {
    LAS int* pref = (LAS int*)(F.lds + AT_PREF);
    LAS bf16_t* Ks = (LAS bf16_t*)(F.lds + AT_KS); LAS bf16_t* Vt = (LAS bf16_t*)(F.lds + AT_VT);
    const int lane = F.lane, w = F.wave, l31 = lane & 31, hf = lane >> 5;
    LAS int* dq = pref + 530;
    float refa, refb;
    { float ga = wave64_max(fabsf(P.qga[lane])) * wave64_max(fabsf(P.kga[lane])), gb = wave64_max(fabsf(P.qgb[lane])) * wave64_max(fabsf(P.kgb[lane]));
      refa = 1.02f * 64.0f * QSCALE * ga; refb = 1.02f * 64.0f * QSCALE * gb; }
    __syncthreads();
    if (F.tid == 0) dq[0] = (int)atomicAdd(dctr, 1u);
    {
        int T = 0;
        if (F.tid < 256) { int c = (int)__hip_atomic_load(cnt + F.tid, __ATOMIC_RELAXED, __HIP_MEMORY_SCOPE_AGENT); c = c > LIST_CAP ? LIST_CAP : c; pref[272 + F.tid] = c; T = ((c + 255) >> 8) - 1; T = T < 0 ? 0 : T; }
        int x = T;
#pragma unroll
        for (int o = 1; o < 64; o <<= 1) { const int y = __shfl_up(x, o); if (lane >= o) x += y; }
        if (lane == 63) pref[264 + w] = x;
        __syncthreads();
        int off = 0;
        for (int ww = 0; ww < w; ++ww) off += pref[264 + ww];
        if (F.tid < 256) pref[F.tid] = x + off - T;
        if (F.tid == 255) pref[256] = x + off;
        __syncthreads();
    }
    const int total = pref[256], NS = total + 256;
    const int vcu = (F.G % 8 == 0) ? (F.bid % 8) * (F.G / 8) + F.bid / 8 : F.bid;
    int j = vcu, nd = 0; bool isdyn = false;
    if (j >= NS) { const int d = dq[0]; nd = 1; isdyn = true; if (d >= 768) return; j = NS + d; if (F.tid == 0) dq[1] = (int)atomicAdd(dctr, 1u); }
    AttDesc D = att_decode(j, total, pref, cnt);
    StageRegs R; att_stage_issue(R, F.tid, F.Z, D);
    unsigned entry = att_entry_issue(D, F.LIST, w, l31);
    for (;;) {
        int qpos; size_t grow; int qcol;
        if (D.kind == 2) { const int iq = 256 * D.u + 32 * w + l31; qpos = iq; grow = (size_t)D.b * SEQ + (size_t)iq * D.dil + D.g; qcol = C_QB + D.h * 64; }
        else { qpos = (D.kind == 1) ? (D.n * 256 + 32 * w + l31) : (int)(entry >> 2); grow = (size_t)D.b * SEQ + qpos; qcol = C_QA + D.h * 64; }
        bf16x8 qf[4];
#pragma unroll
        for (int d0 = 0; d0 < 4; ++d0) qf[d0] = *(const bf16x8*)(F.Z + grow * NZP + qcol + 16 * d0 + 8 * hf);
        const bool two = (D.kind == 1) && (D.cnt > 0);
        const int qpos2 = (int)(entry >> 2); const size_t grow2 = (size_t)D.b * SEQ + qpos2;
        StageTail T3; att_stage_tail_issue(T3, F.tid, F.Z, D);
        __syncthreads();
        att_stage_write(R, T3, F.tid, D, Ks, Vt);
        __syncthreads();
        asm volatile("" : "+v"(qf[0]), "+v"(qf[1]), "+v"(qf[2]), "+v"(qf[3]));
        int jn; bool have_n; int fd = 0; bool fetched = false;
        if (!isdyn && j + F.G < NS) { jn = j + F.G; have_n = true; }
        else { const int d = dq[nd & 1]; ++nd; isdyn = true; have_n = d < 768; jn = NS + d;
            if (have_n) { fetched = true; if (F.tid == 0) fd = (int)atomicAdd(dctr, 1u); } }
        AttDesc Dn = D; unsigned entry_n = 0u;
        if (have_n) { Dn = att_decode(jn, total, pref, cnt); att_stage_issue(R, F.tid, F.Z, Dn); entry_n = att_entry_issue(Dn, F.LIST, w, l31); }
        const int npass = two ? 2 : 1;
#pragma nounroll
        for (int pass = 0; pass < npass; ++pass) {
            const int mode = (pass == 1) ? 0 : D.kind;
            att_compute(F, D, mode, entry, qf, pass ? grow2 : grow, pass ? qpos2 : qpos, D.kind == 2 ? refb : refa);
            if (pass + 1 < npass) {
#pragma unroll
                for (int d0 = 0; d0 < 4; ++d0) qf[d0] = *(const bf16x8*)(F.Z + grow2 * NZP + qcol + 16 * d0 + 8 * hf);
                asm volatile("" : "+v"(qf[0]), "+v"(qf[1]), "+v"(qf[2]), "+v"(qf[3])); }
        }
        if (fetched && F.tid == 0) dq[nd & 1] = fd;
        if (!have_n) break;
        D = Dn; entry = entry_n; j = jn;
    }
    __syncthreads();
}

template <int NP, int NB>
__device__ __forceinline__ void combine_items(const Frame& F, int item0, int istride, int nitems, const bf16_t* PO, size_t o_row, size_t o_head, size_t o_part, const float* PS, size_t s_row, size_t s_head, size_t s_part, int zgate_col, int cc_col) {
    float m[NB][NP], l[NB][NP]; u32x4 ox[NB][NP], gz[NB];
#pragma unroll
    for (int k = 0; k < NB; ++k) { const int item = item0 + k * istride; const int idx = (item < nitems ? item : item0) * 512 + F.tid; const size_t row = (size_t)(idx >> 5); const int h = (idx >> 3) & 3, c8 = idx & 7;
#pragma unroll
        for (int pp = 0; pp < NP; ++pp) { const float* sp = PS + row * s_row + h * s_head + pp * s_part; m[k][pp] = sp[0]; l[k][pp] = sp[1]; }
        gz[k] = *(const u32x4*)(F.Z + row * NZP + zgate_col + h * 64 + 8 * c8); }
#pragma unroll
    for (int k = 0; k < NB; ++k) { const int item = item0 + k * istride; const int idx = (item < nitems ? item : item0) * 512 + F.tid; const size_t row = (size_t)(idx >> 5); const int h = (idx >> 3) & 3, c8 = idx & 7;
#pragma unroll
        for (int pp = 0; pp < NP; ++pp) { ox[k][pp] = (u32x4){0u, 0u, 0u, 0u};
            if (l[k][pp] > 0.f) ox[k][pp] = __builtin_nontemporal_load((const u32x4*)(PO + row * o_row + h * o_head + pp * o_part + 8 * c8)); } }
#pragma unroll
    for (int k = 0; k < NB; ++k) { const int item = item0 + k * istride; if (item >= nitems) continue;
        const int idx = item * 512 + F.tid; const size_t row = (size_t)(idx >> 5); const int h = (idx >> 3) & 3, c8 = idx & 7;
        float mm = m[k][0];
#pragma unroll
        for (int pp = 1; pp < NP; ++pp) mm = fmaxf(mm, m[k][pp]);
        float wsum = 0.f; float o[8];
#pragma unroll
        for (int e = 0; e < 8; ++e) o[e] = 0.f;
#pragma unroll
        for (int pp = 0; pp < NP; ++pp) { const float wgt = (l[k][pp] > 0.f) ? l[k][pp] * ex2(m[k][pp] - mm) : 0.f; wsum += wgt;
            float x[8]; unpack8(ox[k][pp], x);
#pragma unroll
            for (int e = 0; e < 8; ++e) o[e] += wgt * x[e]; }
        const float rw = __builtin_amdgcn_rcpf(wsum);
        float gx[8]; unpack8(gz[k], gx);
        float y[8];
#pragma unroll
        for (int e = 0; e < 8; ++e) y[e] = o[e] * rw * siluf_(gx[e]);
        u32x4 ov; ov.x = pk2(y[0], y[1]); ov.y = pk2(y[2], y[3]); ov.z = pk2(y[4], y[5]); ov.w = pk2(y[6], y[7]);
        *(u32x4*)(F.CC + row * DM + cc_col + h * 64 + 8 * c8) = ov; }
}

__device__ __forceinline__ void gla_scan_item2(const Frame& F, int sc, const int rep = 0) {
    LAS float* S = (LAS float*)F.lds;
    const int lane = F.lane, w = F.wave;
    const int gidx = sc * 64 + lane, b = gidx >> 13, rem = gidx & 8191, hd = rem >> 6;
    float* kv = F.KV + ((size_t)b * 128 + 16 * w) * 8192 + rem; const float* bl = F.BL + ((size_t)b * 128 + 16 * w) * 128 + hd;
    float kvv[16], dec[16];
#pragma unroll
    for (int u = 0; u < 16; ++u) { kvv[u] = kv[(size_t)u * 8192]; dec[u] = bl[u * 128]; }
    float A = 1.f, Sx = 0.f;
#pragma unroll
    for (int u = 0; u < 16; ++u) { dec[u] = __expf(dec[u]); Sx = dec[u] * Sx + kvv[u]; A *= dec[u]; }
    __syncthreads();
    S[(w * 2 + 0) * 64 + lane] = A; S[(w * 2 + 1) * 64 + lane] = Sx;
    __syncthreads();
    float X = 0.f;
    for (int ww = 0; ww < w; ++ww) X = S[(ww * 2) * 64 + lane] * X + S[(ww * 2 + 1) * 64 + lane];
#pragma unroll
    for (int u = 0; u < 16; ++u) { if (!rep) kv[(size_t)u * 8192] = X; X = dec[u] * X + kvv[u]; }
    if (rep) asm volatile("" :: "v"(X));
    __syncthreads();
}

#define XB_TMO      128
#define XB_XCNT(j)  (256  + 64 * (j))
#define XB_XSUB(j)  (1280 + 64 * (j))
#define XB_XGEN(j)  (2304 + 64 * (j))
#define XB_TOP      3328
#define XB_TOPGEN   3392
#define XCD_BAR_WORDS 3456
#define XB_SPIN_CAP (1u << 18)

__device__ __forceinline__ unsigned xb_ld(unsigned* p)              { return __hip_atomic_load(p, __ATOMIC_RELAXED, __HIP_MEMORY_SCOPE_AGENT); }
__device__ __forceinline__ unsigned xb_add(unsigned* p, unsigned v) { return __hip_atomic_fetch_add(p, v, __ATOMIC_RELAXED, __HIP_MEMORY_SCOPE_AGENT); }
__device__ __forceinline__ unsigned xb_xcc_id() { return (unsigned)__builtin_amdgcn_s_getreg((3 << 11) | 20) & 0xFu; }
#define XB_SPIN(cond, bar) do { unsigned _sp = 0; while (cond) { __builtin_amdgcn_s_sleep(1); \
    if ((++_sp & 255u) == 0u) { if (xb_ld(&(bar)[XB_TMO])) break; if (_sp > XB_SPIN_CAP) { atomicAdd(&(bar)[XB_TMO], 1u); break; } } } } while (0)

struct XcdBarrier {
    unsigned* bar; unsigned x;
    volatile LAS unsigned* st;
};

__device__ __forceinline__ XcdBarrier xcd_barrier_post(unsigned* bar, volatile LAS unsigned* st) {
    XcdBarrier b; b.bar = bar; b.x = xb_xcc_id(); b.st = st;
    if (threadIdx.x == 0) (void)xb_add(&bar[XB_XCNT(b.x)], 1u);
    return b;
}
__device__ __forceinline__ void xcd_barrier_complete(unsigned* bar, unsigned x, unsigned& nloc, unsigned& nx) {
    const unsigned G = gridDim.x * gridDim.y * gridDim.z;
    unsigned sum, cnt, mine, sp = 0u;
    for (;;) {
        sum = 0u; cnt = 0u; mine = 0u;
#pragma unroll
        for (unsigned j = 0; j < 16; ++j) { const unsigned c = xb_ld(&bar[XB_XCNT(j)]); sum += c; cnt += (c > 0u) ? 1u : 0u; mine = (j == x) ? c : mine; }
        if (sum == G) break;
        __builtin_amdgcn_s_sleep(1);
        if ((++sp & 255u) == 0u) { if (xb_ld(&bar[XB_TMO])) break; if (sp > XB_SPIN_CAP) { atomicAdd(&bar[XB_TMO], 1u); break; } }
    }
    nloc = mine > 0u ? mine : 1u; nx = cnt > 0u ? cnt : 1u;
}

__device__ __forceinline__ void xcd_barrier(const XcdBarrier& b) {
    asm volatile("s_waitcnt vmcnt(0)" ::: "memory");
    __syncthreads();
    if (threadIdx.x == 0) {
        unsigned* bar = b.bar;
        __builtin_amdgcn_s_waitcnt(0);
        unsigned nloc = b.st[0], nx = b.st[1];
        if (nloc == 0u) { xcd_barrier_complete(bar, b.x, nloc, nx); b.st[0] = nloc; b.st[1] = nx; }
        const unsigned old = xb_add(&bar[XB_XSUB(b.x)], 1u);
        const unsigned gen = old / nloc;
        if (old + 1u == (gen + 1u) * nloc) {
            __builtin_amdgcn_fence(__ATOMIC_RELEASE, "agent");
            asm volatile("s_waitcnt vmcnt(0)" ::: "memory");
            const unsigned og = xb_add(&bar[XB_TOP], 1u);
            const unsigned tg = og / nx;
            if (og + 1u == (tg + 1u) * nx) xb_add(&bar[XB_TOPGEN], 1u);
            else XB_SPIN(xb_ld(&bar[XB_TOPGEN]) == tg, bar);
            __builtin_amdgcn_fence(__ATOMIC_ACQUIRE, "agent");
            xb_add(&bar[XB_XGEN(b.x)], 1u);
            asm volatile("s_waitcnt vmcnt(0)" ::: "memory");
        } else {
            XB_SPIN(xb_ld(&bar[XB_XGEN(b.x)]) == gen, bar);
            __builtin_amdgcn_fence(__ATOMIC_ACQUIRE, "agent");
            asm volatile("s_waitcnt vmcnt(0)" ::: "memory");
        }
    }
    __syncthreads();
}

struct Args { const float* in[17]; float* out; unsigned char* ws; int ph_lo, ph_hi, coop, pad; };

constexpr int W_I_IN = 16 * (NZP / 32), W_I_OUT = 16 * 32, W_I_PW = 4 * 8, W_ITEMS_L = W_I_IN + W_I_OUT + W_I_PW;
__device__ __forceinline__ void weight_copy_item(const float* w_in, const float* w_out, const float* w_pw, const float* norm_g, unsigned char* ws, int ll, int r, LAS float* scr, int lane) {
    if (r < W_I_IN) { transpose_item(w_in + (size_t)ll * DM * NZ, DM, NZ, NZP / 32, (bf16_t*)(ws + WS_WIN + ll * WIN_L), scr, r, lane, norm_g + ll * DM); return; } r -= W_I_IN;
    if (r < W_I_OUT) { transpose_item(w_out + (size_t)ll * DM * DM, DM, DM, 32, (bf16_t*)(ws + WS_WOUT + ll * WOUT_L), scr, r, lane); return; } r -= W_I_OUT;
    transpose_item(w_pw + (size_t)ll * 65536, 256, 256, 8, (bf16_t*)(ws + WS_WPW + ll * WPW_L), scr, r, lane);
}
template <int K> __device__ __forceinline__ void run_phase(const int l, LAS unsigned char* lds_base, LAS int* s_item, const int rep = 0) {
        typedef const __attribute__((address_space(4))) Args* ArgP;
        ArgP ap = (ArgP)__builtin_amdgcn_kernarg_segment_ptr(); asm volatile("" : "+s"(ap));
        Frame F;
        F.lds = lds_base;
        { int t_ = threadIdx.x; asm volatile("" : "+v"(t_)); F.tid = t_; F.lane = t_ & 63; F.wave = __builtin_amdgcn_readfirstlane(t_ >> 6); }
        { int g_ = gridDim.x, b_ = blockIdx.x; asm volatile("" : "+s"(g_), "+s"(b_)); F.G = g_; F.bid = b_; }
        unsigned char* ws = ap->ws;
        F.ctl = (unsigned*)(ws + WS_CTL);
        F.H = (bf16_t*)(ws + WS_H); F.Z = (bf16_t*)(ws + WS_Z); F.CC = (bf16_t*)(ws + WS_CC); F.DOp = F.Z + C_DO;
        F.KMP = (float*)(ws + WS_KM + (size_t)l * 65536); F.BL = (float*)(ws + WS_BL); F.DST = (float*)(ws + WS_DST); F.KV = (float*)(ws + WS_KV);
        F.PO = (bf16_t*)(ws + WS_PO); F.PS = (float*)(F.Z + C_PS); F.LIST = (unsigned*)(ws + WS_LIST);
        LayerP P;
        P.norm_g = ap->in[1] + l * DM;
        P.qga = ap->in[3] + l * 64; P.kga = ap->in[4] + l * 64; P.qgb = ap->in[5] + l * 64; P.kgb = ap->in[6] + l * 64;
        P.conv_w = ap->in[7] + l * 31 * 256; P.conv_b = ap->in[8] + l * 256; P.ln_g = ap->in[9] + l * 256; P.ln_b = ap->in[10] + l * 256;
        P.pw_b = ap->in[12] + l * 256; P.gate_w = ap->in[13] + l * 16 * 128; P.gate_b = ap->in[14] + l * 128; P.gla_g = ap->in[15] + l * 64;
        P.WinT = (const bf16_t*)(ws + WS_WIN + l * WIN_L); P.WoutT = (const bf16_t*)(ws + WS_WOUT + l * WOUT_L); P.WpwT = (const bf16_t*)(ws + WS_WPW + l * WPW_L);
        P.xin = (l == 0) ? ap->in[0] : ap->out; P.xout = ap->out;

        if constexpr (K == 0) {
            const int gw = F.bid * NWAVES + F.wave, NGW = F.G * NWAVES;
            if (l == 0) {
                float* z1 = (float*)(ws + WS_SSQ1); float* z2 = (float*)(ws + WS_KM);
                for (int i = F.bid * NTHR + F.tid; i < MTOK + 2 * 16384; i += F.G * NTHR) { if (i < MTOK) z1[i] = 0.f; else z2[i - MTOK] = 0.f; }
            }
            if (l == 0) {
                LAS float* scr = (LAS float*)(F.lds + F.wave * 16384);
                for (int it = gw; it < W_I_IN; it += NGW) weight_copy_item(ap->in[2], ap->in[16], ap->in[11], ap->in[1], ws, 0, it, scr, F.lane);
            }
            if (l == 0) for (int m = gw; m < MTOK; m += 2 * NGW) cvt_row2(P.xin + (size_t)m * DM, F.H + (size_t)m * DM, (float*)(ws + WS_SSQ0) + m, (size_t)NGW, F.lane);
        } else if constexpr (K == 1) {
            pg8::Gemm g{F.H, P.WinT, MTOK, NZP, DM}; pg8::StaticOrder S; S.init(MTOK, NZP, F.G, F.bid);
            pg8::EpiZ E{F.Z, NZP, (const float*)(ws + (l == 0 ? WS_SSQ0 : WS_SSQ1)), 1.0f / DM, EPS, (LAS float*)(F.lds + 135168), P.qga, P.kga, P.qgb, P.kgb, (float*)(ws + WS_KM + (size_t)l * 65536), QSCALE, NZ};
            pg8::gemm_phase<pg8::EpiZ, pg8::StaticOrder, true, true>(F.lds, g, S, E);
            if (l == 0) {
                const int nu = (MTOK / 256) * (NZP / 256), base_u = nu / F.G, rem_u = nu % F.G;
                const int nfree = (rem_u == 0) ? F.G : (F.G - rem_u), fidx = (rem_u == 0) ? F.bid : (F.bid - rem_u);
                if (fidx >= 0) { LAS float* scr = (LAS float*)(F.lds + F.wave * 16384);
                    const int nw_ = nfree * NWAVES, w0_ = fidx * NWAVES + F.wave;
                    for (int it = W_I_IN + w0_; it < W_ITEMS_L; it += nw_) weight_copy_item(ap->in[2], ap->in[16], ap->in[11], ap->in[1], ws, 0, it, scr, F.lane);
                    for (int it = w0_; it < W_ITEMS_L; it += nw_) weight_copy_item(ap->in[2], ap->in[16], ap->in[11], ap->in[1], ws, 1, it, scr, F.lane); }
                (void)base_u;
            }
        } else if constexpr (K == 2) {
            if (!rep) for (int it = F.bid; it < 256; it += F.G) gla_kv_item(F, P, it);
            if (!rep) { unsigned* cnt = F.ctl + 1024 + l * 256;
                for (int it = F.bid; it < 256; it += F.G) moba_topk_unit(F, P, (it >> 2) & 1, it & 3, 31 - (it >> 3), cnt, F.LIST); }
            { const int nr_ = (REP_PHASE == -8) ? 5 : 1; for (int it = F.bid; it < 256 * nr_; it += F.G) conv_item(F, P, it & 255); }
        } else if constexpr (K == 4) {
            if (!rep) for (int it = F.bid; it < 256; it += F.G) gla_scan_item2(F, it);
            att_phase(F, P, F.ctl + 1024 + l * 256, F.ctl + 2048 + l * 64);
        } else if constexpr (K == 5) {
            { const int nrep_ = (REP_PHASE == -2) ? 4 : 1; for (int it = F.bid; it < 256 * nrep_; it += F.G) gla_out_item(F, P, it & 255); }
            for (int it = F.bid; it < 1024; it += 4 * F.G) combine_items<4, 4>(F, it, F.G, 1024, F.PO, 256, 64, (size_t)MTOK * 256, F.PS, NZP / 2, 8, 2, C_GA, 0);
            for (int it = F.bid; it < 1024; it += 4 * F.G) combine_items<3, 4>(F, it, F.G, 1024, F.DOp, NZP, 64, 256, F.DST, 8, 2, (size_t)MTOK * 8, C_GB, 256);
        } else {
            pg8::Gemm g{F.CC, P.WoutT, MTOK, DM, DM}; pg8::StaticOrder S; S.init(MTOK, DM, F.G, F.bid);
            if (l == 0) { pg8::EpiResX E{F.H, (float*)(ws + WS_SSQ1), DM};
                pg8::gemm_phase<pg8::EpiResX, pg8::StaticOrder, true, true>(F.lds, g, S, E); }
            else { pg8::EpiRes E{F.H, P.xout, DM};
                pg8::gemm_phase<pg8::EpiRes, pg8::StaticOrder, true, true>(F.lds, g, S, E); }
        }
}

__global__ void __launch_bounds__(NTHR, 2) hybrid_fwd(Args args) {
    extern __shared__ __attribute__((aligned(16))) unsigned char lds_raw[];
    cg::grid_group grid = cg::this_grid();
    LAS unsigned char* lds_base = (LAS unsigned char*)lds_raw;
    LAS int* s_item = (LAS int*)(lds_base + LDS_BYTES - 64);
    const int ph_lo = args.ph_lo, ph_hi = args.ph_hi, coop = args.coop;
    volatile LAS unsigned* bst = (volatile LAS unsigned*)(lds_base + LDS_BYTES - 32);
    if (threadIdx.x == 0) { bst[0] = 0u; bst[1] = 0u; }
    __syncthreads();
    XcdBarrier bar; bar.bar = (unsigned*)(args.ws + WS_CTL) + 4096; bar.x = 0; bar.st = bst;
    if (coop) bar = xcd_barrier_post((unsigned*)(args.ws + WS_CTL) + 4096, bst);
#define GRID_BAR() do { if (coop == 2) grid.sync(); else if (coop == 1) xcd_barrier(bar); } while (0)
    if (REP_PHASE == -3 && coop) { for (int zz = 0; zz < 20; ++zz) GRID_BAR(); }
#ifndef ONLY_K
#define ONLY_K -1
#endif
#define RUN(PH) if ((ONLY_K < 0 || ((PH) % 7) == ONLY_K) && ph_lo <= (PH) && (PH) < ph_hi) { run_phase<(PH) % 7>((PH) / 7, lds_base, s_item); \
        if ((PH) == REP_PHASE) { GRID_BAR(); run_phase<(PH) % 7>((PH) / 7, lds_base, s_item, 1); } \
        if ((PH) + 1 < ph_hi) GRID_BAR(); }
#ifdef LAYER_LOOP
    RUN(0)
#define RUNL(KK) { const int ph_ = 7 * lyr + (KK); if ((ONLY_K < 0 || (KK) == ONLY_K) && ph_lo <= ph_ && ph_ < ph_hi) { run_phase<(KK)>(lyr, lds_base, s_item); \
        if (ph_ == REP_PHASE) { GRID_BAR(); run_phase<(KK)>(lyr, lds_base, s_item, 1); } \
        if (ph_ + 1 < ph_hi) GRID_BAR(); } }
#pragma nounroll
    for (int lyr_ = 0; lyr_ < 2; ++lyr_) { int lyr = lyr_; asm volatile("" : "+s"(lyr)); RUNL(1) RUNL(2) RUNL(4) RUNL(5) RUNL(6) }
#undef RUNL
#else
    RUN(0) RUN(1) RUN(2) RUN(4) RUN(5) RUN(6) RUN(8) RUN(9) RUN(11) RUN(12) RUN(13)
#endif
#undef RUN
#undef GRID_BAR
}

extern "C" void kernel_launch(void* const* d_in, const int* in_sizes, int n_in, void* d_out, int out_size, void* d_ws, size_t ws_size, hipStream_t stream) {
    static int grid = 0;
    if (grid == 0) {
        if (n_in != 17 || out_size != MTOK * DM || ws_size < WS_END) { fprintf(stderr, "kernel_launch: unexpected shapes (n_in %d out %d ws %zu)\n", n_in, out_size, ws_size); grid = -1; return; }
        int dev = 0, cus = 0, per_cu = 0;
        hipGetDevice(&dev); hipDeviceGetAttribute(&cus, hipDeviceAttributeMultiprocessorCount, dev);
        if (hipFuncSetAttribute((const void*)hybrid_fwd, hipFuncAttributeMaxDynamicSharedMemorySize, LDS_BYTES) != hipSuccess) { fprintf(stderr, "kernel_launch: hipFuncSetAttribute failed\n"); grid = -1; return; }
        if (hipOccupancyMaxActiveBlocksPerMultiprocessor(&per_cu, (const void*)hybrid_fwd, NTHR, LDS_BYTES) != hipSuccess || per_cu < 1) { fprintf(stderr, "kernel_launch: occupancy query gives %d\n", per_cu); per_cu = 1; }
        (void)hipGetLastError();
        if (per_cu > 1) per_cu = 1;
        grid = cus * per_cu;
    }
    if (grid < 0) return;
    hipMemsetAsync((char*)d_ws + WS_CTL, 0, CTL_ZERO_BYTES, stream);
    Args a{};
    for (int i = 0; i < 17; ++i) a.in[i] = (const float*)d_in[i];
    a.out = (float*)d_out; a.ws = (unsigned char*)d_ws;
#if N_LAUNCH_MODE == 1
    a.ph_lo = 0; a.ph_hi = 14; a.coop = 1;
    void* kargs[] = {&a};
    hipError_t e = hipLaunchCooperativeKernel((const void*)hybrid_fwd, dim3(grid), dim3(NTHR), kargs, LDS_BYTES, stream);
    if (e != hipSuccess) fprintf(stderr, "cooperative launch failed: %s (grid %d)\n", hipGetErrorString(e), grid);
#else
    for (int ph = 0; ph < 14; ++ph) { a.ph_lo = ph; a.ph_hi = ph + 1; a.coop = 0;
        hipLaunchKernelGGL(hybrid_fwd, dim3(grid), dim3(NTHR), LDS_BYTES, stream, a); }
#endif
}
```
